# Optimizing an MI355X kernel written in HIP

```python
import jax
import jax.numpy as jnp
from jax import lax
import numpy as np


D_MODEL = 1024
BATCH = 8
SEQ = 2048
DEPTH = 2

GRID_W = 64
CTX_LEN = 256
HEAD_DIM = 64
A_Q_HEADS = 6
A_KV_HEADS = 2
A_WINDOW = 128
A_BLOCK = 128
ROPE_BASE = 10000.0
B_GROUPS = 4
B_CHUNK = 128
C_HEADS = 6
C_WIN_R = 8
C_WIN_C = 16
A_WIDTH = A_Q_HEADS * HEAD_DIM
B_WIDTH = B_GROUPS * HEAD_DIM
C_WIDTH = C_HEADS * HEAD_DIM
MIX_WIDTH = A_WIDTH + B_WIDTH + C_WIDTH
IN_SIZES = (A_WIDTH, A_KV_HEADS * HEAD_DIM, A_KV_HEADS * HEAD_DIM, B_WIDTH, B_WIDTH, C_WIDTH, C_WIDTH, C_WIDTH)
IN_WIDTH = sum(IN_SIZES)
IN_SPLITS = tuple(int(s) for s in np.cumsum(IN_SIZES)[:-1])
N_EXPERTS = 64
TOP_K = 8
N_GROUPS = 8
TOPK_GROUPS = 4
EXPERT_FF = 256
SHARED_FF = 256
ROUTED_SCALE = 2.5
MOE_BLOCK = 256
EPS = 1e-6
NEG = -1e30
SCALE = HEAD_DIM ** -0.5

kernel_name = 'hybrid_dit_block'


def rmsnorm(x, g):
    x32 = x.astype(jnp.float32)
    y = x32 * lax.rsqrt(jnp.mean(x32 * x32, axis=-1, keepdims=True) + EPS)
    return (y * g.astype(jnp.float32)).astype(x.dtype)


def modulate(x, shift, scale):
    return x * (1.0 + scale) + shift


def axial_rope_tables(n_tokens, dtype):
    t = jnp.arange(n_tokens)
    row = (t // GRID_W).astype(jnp.float32)
    col = (t % GRID_W).astype(jnp.float32)
    half = HEAD_DIM // 2
    inv = ROPE_BASE ** (-jnp.arange(0, half, 2, dtype=jnp.float32) / half)
    ang_r = row[:, None] * inv
    ang_c = col[:, None] * inv
    ang = jnp.concatenate([ang_r, ang_r, ang_c, ang_c], axis=-1)
    return jnp.cos(ang).astype(dtype), jnp.sin(ang).astype(dtype)


def apply_axial_rope(x, cos, sin):
    x1, x2, x3, x4 = jnp.split(x, 4, axis=-1)
    rot = jnp.concatenate([-x2, x1, -x4, x3], axis=-1)
    return x * cos[:, None, :] + rot * sin[:, None, :]


def split_heads(z):
    b, n, _ = z.shape
    qa, ka, va, ub, vb, qn, kn, vn = jnp.split(z, IN_SPLITS, axis=-1)
    hd = lambda t: t.reshape(b, n, -1, HEAD_DIM)
    return (hd(qa), hd(ka), hd(va), jax.nn.gelu(ub), jax.nn.gelu(vb), hd(qn), hd(kn), hd(vn))


def window_gqa_latent(q, k, v, k_ctx, v_ctx, sink):
    b, s_len, _, dh = q.shape
    nb = s_len // A_BLOCK
    g = A_Q_HEADS // A_KV_HEADS
    qb = q.reshape(b, nb, A_BLOCK, A_KV_HEADS, g, dh)
    pad = ((0, 0), (1, 1), (0, 0), (0, 0), (0, 0))
    kb = jnp.pad(k.reshape(b, nb, A_BLOCK, A_KV_HEADS, dh), pad)
    vb = jnp.pad(v.reshape(b, nb, A_BLOCK, A_KV_HEADS, dh), pad)
    k_band = jnp.concatenate([kb[:, :-2], kb[:, 1:-1], kb[:, 2:]], axis=2)
    v_band = jnp.concatenate([vb[:, :-2], vb[:, 1:-1], vb[:, 2:]], axis=2)
    qpos = np.arange(nb)[:, None] * A_BLOCK + np.arange(A_BLOCK)
    kpos = (np.arange(nb)[:, None] - 1) * A_BLOCK + np.arange(3 * A_BLOCK)
    kp = kpos[:, None, :]
    mask = (kp >= 0) & (kp < s_len) & (np.abs(kp - qpos[:, :, None]) <= A_WINDOW)
    s_band = jnp.einsum('bnqkgd,bnskd->bnkgqs', qb, k_band, preferred_element_type=jnp.float32) * SCALE
    s_band = jnp.where(mask[None, :, None, None], s_band, NEG)
    s_ctx = jnp.einsum('bnqkgd,bckd->bnkgqc', qb, k_ctx, preferred_element_type=jnp.float32) * SCALE
    s_sink = jnp.broadcast_to(sink.astype(jnp.float32).reshape(1, 1, A_KV_HEADS, g, 1, 1), s_ctx.shape[:-1] + (1,))
    p = jax.nn.softmax(jnp.concatenate([s_sink, s_ctx, s_band], axis=-1), axis=-1).astype(v.dtype)
    n_ctx = k_ctx.shape[1]
    out = (jnp.einsum('bnkgqc,bckd->bnqkgd', p[..., 1:1 + n_ctx], v_ctx)
           + jnp.einsum('bnkgqs,bnskd->bnqkgd', p[..., 1 + n_ctx:], v_band))
    return out.reshape(b, s_len, A_WIDTH)


def dense_gqa_context(q, k, v, sink):
    b, n, _, dh = q.shape
    g = A_Q_HEADS // A_KV_HEADS
    qg = q.reshape(b, n, A_KV_HEADS, g, dh)
    s = jnp.einsum('bqkgd,bskd->bkgqs', qg, k, preferred_element_type=jnp.float32) * SCALE
    s_sink = jnp.broadcast_to(sink.astype(jnp.float32).reshape(1, A_KV_HEADS, g, 1, 1), s.shape[:-1] + (1,))
    p = jax.nn.softmax(jnp.concatenate([s_sink, s], axis=-1), axis=-1)[..., 1:].astype(v.dtype)
    out = jnp.einsum('bkgqs,bskd->bqkgd', p, v)
    return out.reshape(b, n, A_WIDTH)


def chunk_sgu(u, v, norm_g, w_s, b_s):
    b, n, _ = u.shape
    nc = n // B_CHUNK
    vg = rmsnorm(v.reshape(b, n, B_GROUPS, HEAD_DIM), norm_g.reshape(B_GROUPS, HEAD_DIM))
    vg = vg.reshape(b, nc, B_CHUNK, B_GROUPS, HEAD_DIM)
    gate = jnp.einsum('gpq,bnqgd->bnpgd', w_s, vg) + b_s.T[:, :, None]
    return u * gate.reshape(b, n, B_WIDTH)


def neighbourhood_attention_latent(q, k, v, k_ctx, v_ctx, rpb):
    b, s_len, h, dh = q.shape
    rows = s_len // GRID_W
    kr = min(C_WIN_R, rows)
    r = np.arange(rows)
    row_idx = np.clip(r - kr // 2, 0, rows - kr)[:, None] + np.arange(kr)
    cq = np.arange(GRID_W)
    col_start = np.clip(cq - C_WIN_C // 2, 0, GRID_W - C_WIN_C)
    col_ok = (cq[None, :] >= col_start[:, None]) & (cq[None, :] < col_start[:, None] + C_WIN_C)
    mask = np.broadcast_to(col_ok[:, None, :], (GRID_W, kr, GRID_W)).reshape(GRID_W, kr * GRID_W)
    qg = q.reshape(b, rows, GRID_W, h, dh)
    kg = k.reshape(b, rows, GRID_W, h, dh)[:, row_idx].reshape(b, rows, kr * GRID_W, h, dh)
    vg = v.reshape(b, rows, GRID_W, h, dh)[:, row_idx].reshape(b, rows, kr * GRID_W, h, dh)
    dr = row_idx - r[:, None] + (C_WIN_R - 1)
    dc = np.clip(cq[None, :] - cq[:, None], -(C_WIN_C - 1), C_WIN_C - 1) + (C_WIN_C - 1)
    bias = rpb[:, dr[:, None, :, None], dc[None, :, None, :]]
    bias = bias.reshape(h, rows, GRID_W, kr * GRID_W).transpose(1, 0, 2, 3).astype(jnp.float32)
    s_nb = jnp.einsum('brqhd,brkhd->brhqk', qg, kg, preferred_element_type=jnp.float32) * SCALE + bias[None]
    s_nb = jnp.where(mask, s_nb, NEG)
    s_ctx = jnp.einsum('brqhd,bchd->brhqc', qg, k_ctx, preferred_element_type=jnp.float32) * SCALE
    p = jax.nn.softmax(jnp.concatenate([s_ctx, s_nb], axis=-1), axis=-1).astype(v.dtype)
    n_ctx = k_ctx.shape[1]
    out = (jnp.einsum('brhqc,bchd->brqhd', p[..., :n_ctx], v_ctx)
           + jnp.einsum('brhqk,brkhd->brqhd', p[..., n_ctx:], vg))
    return out.reshape(b, s_len, C_WIDTH)


def dense_mha_context(q, k, v):
    s = jnp.einsum('bqhd,bkhd->bhqk', q, k, preferred_element_type=jnp.float32) * SCALE
    p = jax.nn.softmax(s, axis=-1).astype(v.dtype)
    out = jnp.einsum('bhqk,bkhd->bqhd', p, v)
    return out.reshape(q.shape[0], q.shape[1], C_WIDTH)


def merge_heads(ya, yb, yc, g, w_out):
    ga, gb, gc = jnp.split(g, [A_WIDTH, A_WIDTH + B_WIDTH])
    y = jnp.concatenate([rmsnorm(ya, ga), rmsnorm(yb, gb), rmsnorm(yc, gc)], axis=-1)
    return y @ w_out


def moe_ffn(xf, router_w, router_bias, w_gate, w_up, w_down, s_gate, s_up, s_down):
    n, d = xf.shape
    scores = jax.nn.sigmoid((xf @ router_w).astype(jnp.float32))
    sel = scores + router_bias.astype(jnp.float32)
    grp = sel.reshape(n, N_GROUPS, N_EXPERTS // N_GROUPS)
    grp_score = lax.top_k(grp, 2)[0].sum(-1)
    gidx = lax.top_k(grp_score, TOPK_GROUPS)[1]
    gmask = jax.nn.one_hot(gidx, N_GROUPS).sum(1) > 0
    emask = jnp.repeat(gmask, N_EXPERTS // N_GROUPS, axis=1)
    eidx = lax.top_k(jnp.where(emask, sel, NEG), TOP_K)[1]
    w = jnp.take_along_axis(scores, eidx, axis=1)
    w = (w / jnp.sum(w, axis=-1, keepdims=True) * ROUTED_SCALE).astype(xf.dtype)
    n_assign = n * TOP_K
    e_flat = eidx.reshape(-1)
    t_flat = jnp.repeat(jnp.arange(n, dtype=jnp.int32), TOP_K)
    order = jnp.argsort(e_flat)
    e_s = e_flat[order]
    t_s = t_flat[order]
    w_s = w.reshape(-1)[order]
    counts = jnp.bincount(e_flat, length=N_EXPERTS)
    starts = jnp.cumsum(counts) - counts
    nblk = (counts + MOE_BLOCK - 1) // MOE_BLOCK
    blk_end = jnp.cumsum(nblk)
    pstart = (blk_end - nblk) * MOE_BLOCK
    dest = pstart[e_s] + (jnp.arange(n_assign) - starts[e_s])
    nb = (n_assign + MOE_BLOCK - 1) // MOE_BLOCK + N_EXPERTS
    tok_buf = jnp.full((nb * MOE_BLOCK,), n, jnp.int32).at[dest].set(t_s)
    w_buf = jnp.zeros((nb * MOE_BLOCK,), xf.dtype).at[dest].set(w_s)
    blk_expert = jnp.minimum(jnp.searchsorted(blk_end, jnp.arange(nb), side='right'), N_EXPERTS - 1)
    xpad = jnp.concatenate([xf, jnp.zeros((1, d), xf.dtype)], axis=0)

    def expert_block(args):
        e, toks, ws = args
        xb = xpad[toks]
        hb = jax.nn.silu(xb @ w_gate[e]) * (xb @ w_up[e])
        return (hb @ w_down[e]) * ws[:, None]

    y_blocks = lax.map(expert_block, (blk_expert, tok_buf.reshape(nb, MOE_BLOCK), w_buf.reshape(nb, MOE_BLOCK)))
    routed = jax.ops.segment_sum(y_blocks.reshape(-1, d), tok_buf, num_segments=n + 1)[:n]
    shared = (jax.nn.silu(xf @ s_gate) * (xf @ s_up)) @ s_down
    return shared + routed


def setup_inputs(seed: int = 0) -> dict:
    key = jax.random.key(seed)
    ks = jax.random.split(key, 32)
    f32 = jnp.float32
    nrm = lambda k, shape, s: jax.random.normal(k, shape, f32) * s
    D = D_MODEL
    L = DEPTH
    E = N_EXPERTS
    return {
        'x': nrm(ks[0], (BATCH, SEQ, D), 1.0),
        'c': nrm(ks[1], (BATCH, D), 1.0),
        'ctx': nrm(ks[2], (BATCH, CTX_LEN, D), 1.0),
        'c_ctx': nrm(ks[3], (D,), 1.0),
        'mod_w': nrm(ks[4], (L, D, 6 * D), 0.5 * D ** -0.5),
        'mod_b': nrm(ks[5], (L, 6 * D), 0.01),
        'norm1_g': 1.0 + nrm(ks[6], (L, D), 0.02),
        'w_in': nrm(ks[7], (L, D, IN_WIDTH), D ** -0.5),
        'attn_sink': nrm(ks[8], (L, A_Q_HEADS), 0.5),
        'sgu_norm_g': 1.0 + nrm(ks[9], (L, B_WIDTH), 0.02),
        'sgu_w': nrm(ks[10], (L, B_GROUPS, B_CHUNK, B_CHUNK), 0.5 * B_CHUNK ** -0.5),
        'sgu_b': 1.0 + nrm(ks[11], (L, B_GROUPS, B_CHUNK), 0.1),
        'na_rpb': nrm(ks[12], (L, C_HEADS, 2 * C_WIN_R - 1, 2 * C_WIN_C - 1), 0.1),
        'group_norm_g': 1.0 + nrm(ks[13], (L, MIX_WIDTH), 0.02),
        'w_out': nrm(ks[14], (L, MIX_WIDTH, D), MIX_WIDTH ** -0.5),
        'norm2_g': 1.0 + nrm(ks[15], (L, D), 0.02),
        'router_w': nrm(ks[16], (L, D, E), D ** -0.5),
        'router_bias': nrm(ks[17], (L, E), 0.01),
        'exp_w_gate': nrm(ks[18], (L, E, D, EXPERT_FF), D ** -0.5),
        'exp_w_up': nrm(ks[19], (L, E, D, EXPERT_FF), D ** -0.5),
        'exp_w_down': nrm(ks[20], (L, E, EXPERT_FF, D), EXPERT_FF ** -0.5),
        'shared_w_gate': nrm(ks[21], (L, D, SHARED_FF), D ** -0.5),
        'shared_w_up': nrm(ks[22], (L, D, SHARED_FF), D ** -0.5),
        'shared_w_down': nrm(ks[23], (L, SHARED_FF, D), SHARED_FF ** -0.5),
        'final_g': 1.0 + nrm(ks[24], (D,), 0.02),
    }


def reference(x, c, ctx, c_ctx, mod_w, mod_b, norm1_g, w_in, attn_sink, sgu_norm_g, sgu_w, sgu_b, na_rpb,
              group_norm_g, w_out, norm2_g, router_w, router_bias, exp_w_gate, exp_w_up, exp_w_down,
              shared_w_gate, shared_w_up, shared_w_down, final_g):
    b, s_len, d = x.shape
    n_ctx = ctx.shape[1]
    cos, sin = axial_rope_tables(s_len, x.dtype)
    for l in range(DEPTH):
        last = l == DEPTH - 1
        m_x = (jax.nn.silu(c) @ mod_w[l] + mod_b[l])[:, None, :]
        m_c = (jax.nn.silu(c_ctx) @ mod_w[l] + mod_b[l])[None, None, :]
        sh1, sc1, g1, sh2, sc2, g2 = jnp.split(m_x, 6, axis=-1)
        csh1, csc1, cg1, csh2, csc2, cg2 = jnp.split(m_c, 6, axis=-1)
        qa, ka, va, ub, vb, qn, kn, vn = split_heads(modulate(rmsnorm(x, norm1_g[l]), sh1, sc1) @ w_in[l])
        qa_c, ka_c, va_c, ub_c, vb_c, qn_c, kn_c, vn_c = split_heads(
            modulate(rmsnorm(ctx, norm1_g[l]), csh1, csc1) @ w_in[l])
        ya = window_gqa_latent(apply_axial_rope(qa, cos, sin), apply_axial_rope(ka, cos, sin), va,
                               ka_c, va_c, attn_sink[l])
        yb = chunk_sgu(ub, vb, sgu_norm_g[l], sgu_w[l], sgu_b[l])
        yc = neighbourhood_attention_latent(qn, kn, vn, kn_c, vn_c, na_rpb[l])
        x = x + g1 * merge_heads(ya, yb, yc, group_norm_g[l], w_out[l])
        if not last:
            ya_c = dense_gqa_context(qa_c, ka_c, va_c, attn_sink[l])
            yb_c = chunk_sgu(ub_c, vb_c, sgu_norm_g[l], sgu_w[l], sgu_b[l])
            yc_c = dense_mha_context(qn_c, kn_c, vn_c)
            ctx = ctx + cg1 * merge_heads(ya_c, yb_c, yc_c, group_norm_g[l], w_out[l])
        hx = modulate(rmsnorm(x, norm2_g[l]), sh2, sc2).reshape(b * s_len, d)
        if last:
            y = moe_ffn(hx, router_w[l], router_bias[l], exp_w_gate[l], exp_w_up[l], exp_w_down[l],
                        shared_w_gate[l], shared_w_up[l], shared_w_down[l])
            x = x + g2 * y.reshape(b, s_len, d)
        else:
            hc = modulate(rmsnorm(ctx, norm2_g[l]), csh2, csc2).reshape(b * n_ctx, d)
            y = moe_ffn(jnp.concatenate([hx, hc], axis=0), router_w[l], router_bias[l], exp_w_gate[l],
                        exp_w_up[l], exp_w_down[l], shared_w_gate[l], shared_w_up[l], shared_w_down[l])
            x = x + g2 * y[:b * s_len].reshape(b, s_len, d)
            ctx = ctx + cg2 * y[b * s_len:].reshape(b, n_ctx, d)
    return rmsnorm(x, final_g)
```

```cpp
#include <hip/hip_runtime.h>
#include <cstdio>
#include <cstdint>

#define LAS __attribute__((address_space(3)))
typedef unsigned short bf16_t;
typedef float f32x4 __attribute__((ext_vector_type(4)));
typedef float f32x2 __attribute__((ext_vector_type(2)));
typedef unsigned u32x4 __attribute__((ext_vector_type(4)));
typedef unsigned u32x2 __attribute__((ext_vector_type(2)));
typedef __bf16 bf16x2_t __attribute__((ext_vector_type(2)));

constexpr int D = 1024, NB = 8, SEQ = 2048, CTXL = 256, HD = 64, INW = 2304, NE = 64, FF = 256, DEPTH = 2;
constexpr int NLAT = NB * SEQ, NCTX = NB * CTXL, NTOK = NLAT + NCTX;
constexpr int QA = 0, KA = 384, VA = 512, UB = 640, VB = 896, QN = 1152, KN = 1536, VN = 1920;
constexpr float EPS = 1e-6f, NEGF = -1e30f;
constexpr int NWAVES = 8, NTHR = 512;
enum { IN_X = 0, IN_C, IN_CTX, IN_CCTX, IN_MODW, IN_MODB, IN_N1G, IN_WIN, IN_SINK, IN_SGUG, IN_SGUW, IN_SGUB, IN_RPB, IN_GNG, IN_WOUT, IN_N2G,
       IN_RW, IN_RB, IN_EG, IN_EU, IN_ED, IN_SG, IN_SU, IN_SD, IN_FG, N_IN };

constexpr size_t MiB = 1u << 20;
constexpr size_t WS_CTL = 0, CTL_ZERO_BYTES = 64 * 1024;
constexpr size_t WS_MOD = 1 * MiB;
constexpr size_t WS_ROPE = 1 * MiB + 512 * 1024;
constexpr size_t WS_WIN = 2 * MiB;
constexpr size_t WS_WOUT = 11 * MiB;
constexpr size_t WS_WSHGU = 15 * MiB;
constexpr size_t WS_WSHD = 17 * MiB;
constexpr size_t WS_XC = 18 * MiB;
constexpr size_t WS_LIST = 26 * MiB;
constexpr size_t WS_LISTW = 26 * MiB + 4608 * 1024;
constexpr size_t WS_H1 = 36 * MiB;
constexpr size_t WS_WEXPD = 72 * MiB;
constexpr size_t WS_ZH = 104 * MiB;
constexpr size_t WS_Y2 = 194 * MiB;
constexpr size_t WS_Y = WS_Y2;
constexpr size_t WS_SSQ = WS_Y2 + 36 * MiB;
constexpr size_t WS_WEXPGU = WS_Y2 + 38 * MiB;
constexpr size_t WS_END = WS_Y2 + 288 * MiB;
constexpr int LIST_CAP = NTOK;
constexpr int CW_BAR = 4096, CW_CNT = 8192;

constexpr int RING_BYTES = 131072, MISC_OFF = 131072 + 320, TOFF_OFF = 131072 + 1024, LDS_BYTES = 147456;

__device__ __forceinline__ unsigned pk2(float lo, float hi) { f32x2 v = {lo, hi}; bf16x2_t b = __builtin_convertvector(v, bf16x2_t); return __builtin_bit_cast(unsigned, b); }
__device__ __forceinline__ float bf_lo(unsigned w) { return __uint_as_float(w << 16); }
__device__ __forceinline__ float bf_hi(unsigned w) { return __uint_as_float(w & 0xffff0000u); }
__device__ __forceinline__ float wave_sum(float v) {
#pragma unroll
    for (int o = 1; o < 64; o <<= 1) v += __shfl_xor(v, o);
    return v;
}
__device__ __forceinline__ float gelu_tanh(float x) {
    const float u = 0.7978845608028654f * (x + 0.044715f * x * x * x);
    const float e = __expf(2.f * u);
    const float t = 1.f - 2.f / (e + 1.f);
    return 0.5f * x * (1.f + t);
}
__device__ __forceinline__ float silu_f(float x) { return x / (1.f + __expf(-x)); }

#define XB_TMO      128
#define XB_XCNT(j)  (256  + 64 * (j))
#define XB_XSUB(j)  (1280 + 64 * (j))
#define XB_XGEN(j)  (2304 + 64 * (j))
#define XB_TOP      3328
#define XB_TOPGEN   3392
#define XCD_BAR_WORDS 3456
#define XB_SPIN_CAP (1u << 18)
__device__ __forceinline__ unsigned xb_ld(unsigned* p)              { return __hip_atomic_load(p, __ATOMIC_RELAXED, __HIP_MEMORY_SCOPE_AGENT); }
__device__ __forceinline__ unsigned xb_add(unsigned* p, unsigned v) { return __hip_atomic_fetch_add(p, v, __ATOMIC_RELAXED, __HIP_MEMORY_SCOPE_AGENT); }
__device__ __forceinline__ unsigned xb_xcc_id() { return (unsigned)__builtin_amdgcn_s_getreg((3 << 11) | 20) & 0xFu; }
#define XB_SPIN(cond, bar) do { unsigned _sp = 0; while (cond) { __builtin_amdgcn_s_sleep(1); \
    if ((++_sp & 255u) == 0u) { if (xb_ld(&(bar)[XB_TMO])) break; if (_sp > XB_SPIN_CAP) { atomicAdd(&(bar)[XB_TMO], 1u); break; } } } } while (0)
struct XcdBarrier { unsigned* bar; unsigned x; volatile LAS unsigned* st; };
__device__ __forceinline__ XcdBarrier xcd_barrier_post(unsigned* bar, volatile LAS unsigned* st) {
    XcdBarrier b; b.bar = bar; b.x = xb_xcc_id(); b.st = st;
    if (threadIdx.x == 0) (void)xb_add(&bar[XB_XCNT(b.x)], 1u);
    return b;
}
__device__ __forceinline__ void xcd_barrier_complete(unsigned* bar, unsigned x, unsigned& nloc, unsigned& nx) {
    const unsigned G = gridDim.x * gridDim.y * gridDim.z;
    unsigned sum, cnt, mine, sp = 0u;
    for (;;) {
        sum = 0u; cnt = 0u; mine = 0u;
#pragma unroll
        for (unsigned j = 0; j < 16; ++j) { const unsigned c = xb_ld(&bar[XB_XCNT(j)]); sum += c; cnt += (c > 0u) ? 1u : 0u; mine = (j == x) ? c : mine; }
        if (sum == G) break;
        __builtin_amdgcn_s_sleep(1);
        if ((++sp & 255u) == 0u) { if (xb_ld(&bar[XB_TMO])) break; if (sp > XB_SPIN_CAP) { atomicAdd(&bar[XB_TMO], 1u); break; } }
    }
    nloc = mine > 0u ? mine : 1u; nx = cnt > 0u ? cnt : 1u;
}
__device__ __forceinline__ void xcd_barrier(const XcdBarrier& b) {
    asm volatile("s_waitcnt vmcnt(0)" ::: "memory");
    __syncthreads();
    if (threadIdx.x == 0) {
        unsigned* bar = b.bar;
        __builtin_amdgcn_s_waitcnt(0);
        unsigned nloc = b.st[0], nx = b.st[1];
        if (nloc == 0u) { xcd_barrier_complete(bar, b.x, nloc, nx); b.st[0] = nloc; b.st[1] = nx; }
        const unsigned old = xb_add(&bar[XB_XSUB(b.x)], 1u);
        const unsigned gen = old / nloc;
        if (old + 1u == (gen + 1u) * nloc) {
            __builtin_amdgcn_fence(__ATOMIC_RELEASE, "agent");
            asm volatile("s_waitcnt vmcnt(0)" ::: "memory");
            const unsigned og = xb_add(&bar[XB_TOP], 1u);
            const unsigned tg = og / nx;
            if (og + 1u == (tg + 1u) * nx) xb_add(&bar[XB_TOPGEN], 1u);
            else XB_SPIN(xb_ld(&bar[XB_TOPGEN]) == tg, bar);
            __builtin_amdgcn_fence(__ATOMIC_ACQUIRE, "agent");
            xb_add(&bar[XB_XGEN(b.x)], 1u);
            asm volatile("s_waitcnt vmcnt(0)" ::: "memory");
        } else {
            XB_SPIN(xb_ld(&bar[XB_XGEN(b.x)]) == gen, bar);
            __builtin_amdgcn_fence(__ATOMIC_ACQUIRE, "agent");
            asm volatile("s_waitcnt vmcnt(0)" ::: "memory");
        }
    }
    __syncthreads();
}

struct Params { const float* in[N_IN]; float* out; unsigned char* ws; };

struct Frame {
    unsigned char* lds;
    int tid, lane, wave, bid, G;
    const Params* P;
    __device__ __forceinline__ const float* inp(int i) const { return P->in[i]; }
    __device__ __forceinline__ float* outp() const { return P->out; }
    __device__ __forceinline__ unsigned char* wsb() const { return P->ws; }
    __device__ __forceinline__ unsigned* ctl() const { return (unsigned*)(P->ws + WS_CTL); }
    __device__ __forceinline__ float* MOD() const { return (float*)(P->ws + WS_MOD); }
    __device__ __forceinline__ float* ROPE() const { return (float*)(P->ws + WS_ROPE); }
    __device__ __forceinline__ bf16_t* WIN() const { return (bf16_t*)(P->ws + WS_WIN); }
    __device__ __forceinline__ bf16_t* WOUT() const { return (bf16_t*)(P->ws + WS_WOUT); }
    __device__ __forceinline__ bf16_t* WSHGU() const { return (bf16_t*)(P->ws + WS_WSHGU); }
    __device__ __forceinline__ bf16_t* WSHD() const { return (bf16_t*)(P->ws + WS_WSHD); }
    __device__ __forceinline__ bf16_t* WEXPGU() const { return (bf16_t*)(P->ws + WS_WEXPGU); }
    __device__ __forceinline__ bf16_t* WEXPD() const { return (bf16_t*)(P->ws + WS_WEXPD); }
    __device__ __forceinline__ bf16_t* H1() const { return (bf16_t*)(P->ws + WS_H1); }
    __device__ __forceinline__ bf16_t* Z() const { return (bf16_t*)(P->ws + WS_ZH); }
    __device__ __forceinline__ bf16_t* HB() const { return (bf16_t*)(P->ws + WS_ZH); }
    __device__ __forceinline__ bf16_t* Y() const { return (bf16_t*)(P->ws + WS_Y); }
    __device__ __forceinline__ bf16_t* Y2() const { return (bf16_t*)(P->ws + WS_Y2); }
    __device__ __forceinline__ float* XC() const { return (float*)(P->ws + WS_XC); }
    __device__ __forceinline__ float* SSQ() const { return (float*)(P->ws + WS_SSQ); }
    __device__ __forceinline__ float* LISTW() const { return (float*)(P->ws + WS_LISTW); }
    __device__ __forceinline__ unsigned* LIST() const { return (unsigned*)(P->ws + WS_LIST); }
};
__device__ __forceinline__ float* xa_row(const Frame& F, int r) { return r < NLAT ? F.outp() + (size_t)r * D : F.XC() + (size_t)(r - NLAT) * D; }
__device__ __forceinline__ int mod_row(int r) { return r < NLAT ? (r >> 11) : 8; }
__device__ __forceinline__ const float* mod_ptr(const Frame& F, int l, int r, int chunk) { return F.MOD() + ((size_t)(l * 9 + mod_row(r)) * 6 + chunk) * D; }
__device__ __forceinline__ unsigned* cnt_ptr(const Frame& F, int l, int e) { return F.ctl() + CW_CNT + (l * 64 + e) * 16; }

__device__ __forceinline__ void transpose_item(const float* W, int K, int N, bf16_t* WT, int k0, int n0, int rbase, float* scr, int lane) {
#pragma unroll 8
    for (int i = 0; i < 32; ++i) { const int kk = 2 * i + (lane >> 5); scr[kk * 33 + (lane & 31)] = W[(size_t)(k0 + kk) * N + n0 + (lane & 31)]; }
    asm volatile("s_waitcnt lgkmcnt(0)" ::: "memory");
    const int c = lane & 7;
#pragma unroll
    for (int j = 0; j < 4; ++j) { const int n = (lane >> 3) + 8 * j; const float* s = scr + (8 * c) * 33 + n;
        u32x4 o; o.x = pk2(s[0 * 33], s[1 * 33]); o.y = pk2(s[2 * 33], s[3 * 33]); o.z = pk2(s[4 * 33], s[5 * 33]); o.w = pk2(s[6 * 33], s[7 * 33]);
        *(u32x4*)(WT + (size_t)(rbase + n) * K + k0 + 8 * c) = o; }
    asm volatile("s_waitcnt lgkmcnt(0)" ::: "memory");
}
__device__ __forceinline__ void conv_weight(const float* W, int K, int N, bf16_t* WT, int gu, int item, float* scr, int lane) {
    const int nblk = N / 32, kb = item / nblk, nb = item % nblk, n0 = 32 * nb;
    const int rbase = gu == 0 ? n0 : ((n0 >> 7) * 256 + (n0 & 127) + (gu == 2 ? 128 : 0));
    transpose_item(W, K, N, WT, 64 * kb, n0, rbase, scr, lane);
}
__device__ __forceinline__ void conv_experts(Frame& F, int l) {
    float* scr = (float*)(F.lds + F.wave * 16384);
    const int gw = F.bid * NWAVES + F.wave, NGW = F.G * NWAVES;
    constexpr int IG = (D / 64) * (FF / 32), ID = (FF / 64) * (D / 32);
    constexpr int PER = 2 * IG + ID;
    for (int it = gw; it < NE * PER; it += NGW) {
        const int e = it / PER; int r = it % PER;
        const size_t eo = (size_t)(l * NE + e) * D * FF;
        if (r < IG) { conv_weight(F.inp(IN_EG) + eo, D, FF, F.WEXPGU() + (size_t)e * 512 * D, 1, r, scr, F.lane); continue; } r -= IG;
        if (r < IG) { conv_weight(F.inp(IN_EU) + eo, D, FF, F.WEXPGU() + (size_t)e * 512 * D, 2, r, scr, F.lane); continue; } r -= IG;
        conv_weight(F.inp(IN_ED) + eo, FF, D, F.WEXPD() + (size_t)e * D * FF, 0, r, scr, F.lane);
    }
}
__device__ __forceinline__ void p0_prologue(Frame& F) {
    if (F.bid == 0) {
        for (int i = F.tid; i < 64 * 16; i += NTHR) { const int pos = i >> 4, f = i & 15;
            const float inv = powf(10000.0f, -(float)(2 * f) / 32.0f); const float a = (float)pos * inv;
            F.ROPE()[i] = cosf(a); F.ROPE()[1024 + i] = sinf(a); }
    }
    {
        float* sl = (float*)F.lds;
        float* red = (float*)(F.lds + 40960);
        bool have = false;
        for (int it = F.bid; it < 2 * 96; it += F.G) {
            if (!have) {
                for (int i = F.tid; i < 9 * D; i += NTHR) { const int r = i >> 10, k = i & 1023; const float v = r < 8 ? F.inp(IN_C)[r * D + k] : F.inp(IN_CCTX)[k]; sl[i] = silu_f(v); }
                __syncthreads(); have = true;
            }
            const int l = it / 96, jc = it % 96, c = F.tid & 63, kg = F.tid >> 6;
            const float* W = F.inp(IN_MODW) + (size_t)l * D * 6144 + 64 * jc + c;
            float acc[9];
#pragma unroll
            for (int r = 0; r < 9; ++r) acc[r] = 0.f;
#pragma unroll 8
            for (int k = 128 * kg; k < 128 * kg + 128; ++k) { const float w = W[(size_t)k * 6144];
#pragma unroll
                for (int r = 0; r < 9; ++r) acc[r] += sl[r * D + k] * w; }
#pragma unroll
            for (int r = 0; r < 9; ++r) red[(kg * 9 + r) * 64 + c] = acc[r];
            __syncthreads();
            for (int i = F.tid; i < 9 * 64; i += NTHR) { const int r = i >> 6, cc = i & 63; float s = 0.f;
#pragma unroll
                for (int g = 0; g < 8; ++g) s += red[(g * 9 + r) * 64 + cc];
                F.MOD()[(size_t)(l * 9 + r) * 6144 + 64 * jc + cc] = s + F.inp(IN_MODB)[l * 6144 + 64 * jc + cc]; }
            __syncthreads();
        }
        __syncthreads();
    }
    {
        float* scr = (float*)(F.lds + F.wave * 16384);
        const int gw = F.bid * NWAVES + F.wave, NGW = F.G * NWAVES;
        constexpr int I_IN = (D / 64) * (INW / 32), I_OUT = (D / 64) * (D / 32), I_SG = (D / 64) * (FF / 32), I_SD = (FF / 64) * (D / 32);
        constexpr int PER = I_IN + I_OUT + 2 * I_SG + I_SD;
        for (int it = gw; it < 2 * PER; it += NGW) {
            const int l = it / PER; int r = it % PER;
            if (r < I_IN) { conv_weight(F.inp(IN_WIN) + (size_t)l * D * INW, D, INW, F.WIN() + (size_t)l * INW * D, 0, r, scr, F.lane); continue; } r -= I_IN;
            if (r < I_OUT) { conv_weight(F.inp(IN_WOUT) + (size_t)l * D * D, D, D, F.WOUT() + (size_t)l * D * D, 0, r, scr, F.lane); continue; } r -= I_OUT;
            if (r < I_SG) { conv_weight(F.inp(IN_SG) + (size_t)l * D * FF, D, FF, F.WSHGU() + (size_t)l * 512 * D, 1, r, scr, F.lane); continue; } r -= I_SG;
            if (r < I_SG) { conv_weight(F.inp(IN_SU) + (size_t)l * D * FF, D, FF, F.WSHGU() + (size_t)l * 512 * D, 2, r, scr, F.lane); continue; } r -= I_SG;
            conv_weight(F.inp(IN_SD) + (size_t)l * FF * D, FF, D, F.WSHD() + (size_t)l * D * FF, 0, r, scr, F.lane);
        }
    }
    conv_experts(F, 0);
}

__device__ __forceinline__ void load_row(const float* src, int lane, f32x4 (&v)[4]) {
#pragma unroll
    for (int j = 0; j < 4; ++j) v[j] = *(const f32x4*)(src + 4 * lane + 256 * j);
}
__device__ __forceinline__ float row_rstd(const f32x4 (&v)[4]) {
    float s = 0.f;
#pragma unroll
    for (int j = 0; j < 4; ++j) s += (v[j].x * v[j].x + v[j].y * v[j].y) + (v[j].z * v[j].z + v[j].w * v[j].w);
    return 1.0f / sqrtf(wave_sum(s) * (1.0f / D) + EPS);
}
__device__ __forceinline__ void norm_mod(const f32x4 (&v)[4], float rstd, const float* g, const float* sh, const float* sc, int lane, f32x4 (&h)[4]) {
#pragma unroll
    for (int j = 0; j < 4; ++j) { const int c = 4 * lane + 256 * j; const f32x4 gg = *(const f32x4*)(g + c), s1 = *(const f32x4*)(sh + c), s2 = *(const f32x4*)(sc + c);
        h[j] = v[j] * rstd * gg * (1.0f + s2) + s1; }
}
__device__ __forceinline__ void store_row_bf16(bf16_t* dst, int lane, const f32x4 (&h)[4]) {
#pragma unroll
    for (int j = 0; j < 4; ++j) { u32x2 w; w.x = pk2(h[j].x, h[j].y); w.y = pk2(h[j].z, h[j].w); *(u32x2*)(dst + 4 * lane + 256 * j) = w; }
}
__device__ __forceinline__ void phase_r1(Frame& F, int l) {
    const int gw = F.bid * NWAVES + F.wave, NGW = F.G * NWAVES;
    for (int r = gw; r < NTOK; r += NGW) {
        const float* src = (l == 0) ? (r < NLAT ? F.inp(IN_X) + (size_t)r * D : F.inp(IN_CTX) + (size_t)(r - NLAT) * D) : xa_row(F, r);
        f32x4 v[4], h[4]; load_row(src, F.lane, v);
        const float rstd = row_rstd(v);
        norm_mod(v, rstd, F.inp(IN_N1G) + l * D, mod_ptr(F, l, r, 0), mod_ptr(F, l, r, 1), F.lane, h);
        store_row_bf16(F.H1() + (size_t)r * D, F.lane, h);
    }
}
__device__ __forceinline__ void phase_nrm(Frame& F, int l, int nrows) {
    const int gw = F.bid * NWAVES + F.wave, NGW = F.G * NWAVES;
    for (int r = gw; r < nrows; r += NGW) {
        const float* sq = F.SSQ() + (size_t)r * 16;
        const float sA = sq[0] + sq[1] + sq[2] + sq[3] + sq[4] + sq[5], sB = sq[6] + sq[7] + sq[8] + sq[9], sC = sq[10] + sq[11] + sq[12] + sq[13] + sq[14] + sq[15];
        const float rA = 1.0f / sqrtf(sA * (1.0f / 384.0f) + EPS), rB = 1.0f / sqrtf(sB * (1.0f / 256.0f) + EPS), rC = 1.0f / sqrtf(sC * (1.0f / 384.0f) + EPS);
        bf16_t* yr = F.Y() + (size_t)r * D;
#pragma unroll
        for (int j = 0; j < 4; ++j) { const int c = 4 * F.lane + 256 * j; const float rs = c < 384 ? rA : (c < 640 ? rB : rC);
            const u32x2 w = *(const u32x2*)(yr + c); const f32x4 gg = *(const f32x4*)(F.inp(IN_GNG) + l * D + c);
            u32x2 o; o.x = pk2(bf_lo(w.x) * rs * gg.x, bf_hi(w.x) * rs * gg.y); o.y = pk2(bf_lo(w.y) * rs * gg.z, bf_hi(w.y) * rs * gg.w);
            *(u32x2*)(yr + c) = o; }
    }
}
__device__ __forceinline__ void phase_r2(Frame& F, int l, int nrows) {
    const int gw = F.bid * NWAVES + F.wave, NGW = F.G * NWAVES;
    float* hl = (float*)(F.lds + F.wave * 4096);
    const float* RW = F.inp(IN_RW) + (size_t)l * D * NE;
    const float rbias = F.inp(IN_RB)[l * NE + F.lane];
    for (int r = gw; r < nrows; r += NGW) {
        f32x4 v[4], h[4]; load_row(xa_row(F, r), F.lane, v);
        const float rstd = row_rstd(v);
        norm_mod(v, rstd, F.inp(IN_N2G) + l * D, mod_ptr(F, l, r, 3), mod_ptr(F, l, r, 4), F.lane, h);
        store_row_bf16(F.H1() + (size_t)r * D, F.lane, h);
#pragma unroll
        for (int j = 0; j < 4; ++j) *(f32x4*)(hl + 4 * F.lane + 256 * j) = h[j];
        asm volatile("s_waitcnt lgkmcnt(0)" ::: "memory");
        float logit = 0.f;
#pragma unroll 8
        for (int k = 0; k < D; ++k) logit += hl[k] * RW[k * NE + F.lane];
        const float score = 1.0f / (1.0f + expf(-logit));
        const float sel = score + rbias;
        float m1 = sel;
#pragma unroll
        for (int o = 1; o < 8; o <<= 1) m1 = fmaxf(m1, __shfl_xor(m1, o));
        const unsigned long long bal = __ballot(sel == m1);
        const unsigned gm = (unsigned)(bal >> (F.lane & ~7)) & 0xffu; const int first = __ffs(gm) - 1;
        float m2 = ((F.lane & 7) == first) ? -3.0e38f : sel;
#pragma unroll
        for (int o = 1; o < 8; o <<= 1) m2 = fmaxf(m2, __shfl_xor(m2, o));
        const float gs = m1 + m2; const int g = F.lane >> 3; int rank = 0;
#pragma unroll
        for (int j = 0; j < 8; ++j) { const float o = __shfl(gs, j * 8); rank += ((o > gs) || (o == gs && j < g)) ? 1 : 0; }
        const float msel = rank < 4 ? sel : NEGF;
        int r2 = 0;
#pragma unroll
        for (int j = 0; j < 64; ++j) { const float o = __shfl(msel, j); r2 += ((o > msel) || (o == msel && j < F.lane)) ? 1 : 0; }
        const bool chosen = r2 < 8;
        const float wsum = wave_sum(chosen ? score : 0.f);
        if (chosen) {
            const unsigned pos = atomicAdd(cnt_ptr(F, l, F.lane), 1u);
            F.LIST()[(size_t)F.lane * LIST_CAP + pos] = (unsigned)r | ((unsigned)r2 << 16);
            F.LISTW()[(size_t)F.lane * LIST_CAP + pos] = score / wsum * 2.5f;
        }
    }
}
__device__ __forceinline__ void phase_cmb(Frame& F, int l, int nrows) {
    const int gw = F.bid * NWAVES + F.wave, NGW = F.G * NWAVES;
    for (int r = gw; r < nrows; r += NGW) {
        float* xr = xa_row(F, r);
        f32x4 v[4]; load_row(xr, F.lane, v);
        f32x4 s[4];
#pragma unroll
        for (int j = 0; j < 4; ++j) s[j] = (f32x4){0.f, 0.f, 0.f, 0.f};
        const bf16_t* yb = F.Y2() + (size_t)r * 8 * D;
#pragma unroll
        for (int k = 0; k < 8; ++k)
#pragma unroll
            for (int j = 0; j < 4; ++j) { const u32x2 w = *(const u32x2*)(yb + (size_t)k * D + 4 * F.lane + 256 * j);
                s[j].x += bf_lo(w.x); s[j].y += bf_hi(w.x); s[j].z += bf_lo(w.y); s[j].w += bf_hi(w.y); }
        const float* g2 = mod_ptr(F, l, r, 5);
#pragma unroll
        for (int j = 0; j < 4; ++j) v[j] = v[j] + *(const f32x4*)(g2 + 4 * F.lane + 256 * j) * s[j];
        const float rstd = row_rstd(v);
        if (l == 0) {
#pragma unroll
            for (int j = 0; j < 4; ++j) *(f32x4*)(xr + 4 * F.lane + 256 * j) = v[j];
            f32x4 h[4];
            norm_mod(v, rstd, F.inp(IN_N1G) + D, mod_ptr(F, 1, r, 0), mod_ptr(F, 1, r, 1), F.lane, h);
            store_row_bf16(F.H1() + (size_t)r * D, F.lane, h);
        } else {
#pragma unroll
            for (int j = 0; j < 4; ++j) { const f32x4 gg = *(const f32x4*)(F.inp(IN_FG) + 4 * F.lane + 256 * j); *(f32x4*)(xr + 4 * F.lane + 256 * j) = v[j] * rstd * gg; }
        }
    }
}

struct Unit { int pm, pn, e, lt; };

struct SchedDense {
    const bf16_t* A; const bf16_t* Bt; int K, nM, nN, G, c;
    __device__ __forceinline__ bool next(int i, Unit& u) const {
        const int L = i * G + c; if (L >= nM * nN) return false;
        u.pn = L % nN; u.pm = L / nN; u.e = 0; u.lt = 0; return true;
    }
    __device__ __forceinline__ const bf16_t* a_row(const Unit& u, int r) const { return A + (size_t)(u.pm * 256 + r) * K; }
    __device__ __forceinline__ const bf16_t* b_row(const Unit& u, int c_) const { return Bt + (size_t)(u.pn * 256 + c_) * K; }
};
struct MoeTab { const int* toff; const int* cnt; };
__device__ __forceinline__ void moe_build_tab(Frame& F, int l, int nrows_shared) {
    int* toff = (int*)(F.lds + TOFF_OFF); int* cnt = toff + 72;
    __syncthreads();
    if (F.tid == 0) { int acc = 0;
        for (int e = 0; e < NE; ++e) { const int c = (int)__hip_atomic_load(cnt_ptr(F, l, e), __ATOMIC_RELAXED, __HIP_MEMORY_SCOPE_AGENT); cnt[e] = c; toff[e] = acc; acc += (c + 255) >> 8; }
        cnt[NE] = nrows_shared; toff[NE] = acc; acc += nrows_shared >> 8; toff[NE + 1] = acc; }
    __syncthreads();
}
__device__ __forceinline__ void moe_find(const MoeTab& T, int tg, Unit& u) {
    int e = 0;
#pragma unroll 1
    for (int j = 1; j <= NE; ++j) e = (T.toff[j] <= tg) ? j : e;
    u.pm = tg; u.e = e; u.lt = tg - T.toff[e];
}
struct SchedE1 {
    MoeTab T; const unsigned* LIST; const bf16_t* H1; const bf16_t* WGU; const bf16_t* WSH; int G, c;
    __device__ __forceinline__ bool next(int i, Unit& u) const {
        const int L = i * G + c; if (L >= T.toff[NE + 1] * 2) return false;
        u.pn = L & 1; moe_find(T, L >> 1, u); return true;
    }
    __device__ __forceinline__ int token(const Unit& u, int r) const {
        const int idx = u.lt * 256 + r;
        if (u.e == NE) return idx;
        return idx < T.cnt[u.e] ? (int)(LIST[(size_t)u.e * LIST_CAP + idx] & 0xffffu) : 0;
    }
    __device__ __forceinline__ const bf16_t* a_row(const Unit& u, int r) const { return H1 + (size_t)token(u, r) * D; }
    __device__ __forceinline__ const bf16_t* b_row(const Unit& u, int c_) const { return (u.e == NE ? WSH : WGU + (size_t)u.e * 512 * D) + (size_t)(u.pn * 256 + c_) * D; }
};
struct SchedE2 {
    MoeTab T; const bf16_t* HB; const bf16_t* WD; const bf16_t* WSH; int G, c;
    __device__ __forceinline__ bool next(int i, Unit& u) const {
        const int L = i * G + c; if (L >= T.toff[NE + 1] * 4) return false;
        u.pn = L & 3; moe_find(T, L >> 2, u); return true;
    }
    __device__ __forceinline__ const bf16_t* a_row(const Unit& u, int r) const { return HB + (size_t)(u.pm * 256 + r) * FF; }
    __device__ __forceinline__ const bf16_t* b_row(const Unit& u, int c_) const { return (u.e == NE ? WSH : WD + (size_t)u.e * D * FF) + (size_t)(u.pn * 256 + c_) * FF; }
};

struct EpiG1 {
    bf16_t* Z; const float* ROPE;
    __device__ __forceinline__ void row(const Unit& u, int r, int cbase, const f32x4 (&v)[2][2]) const {
        const int grow = u.pm * 256 + r;
#pragma unroll
        for (int bj = 0; bj < 2; ++bj) {
            const int col0 = u.pn * 256 + bj * 128 + cbase;
            f32x4 a = v[bj][0], b = v[bj][1];
            const bool is_rope = (col0 < VA) && (grow < NLAT);
            if (is_rope) {
                const int t = grow & (SEQ - 1); const int pos = ((col0 & 32) == 0) ? (t >> 6) : (t & 63);
                const int f0 = col0 & 15;
                const f32x4 cs = *(const f32x4*)(ROPE + pos * 16 + f0), sn = *(const f32x4*)(ROPE + 1024 + pos * 16 + f0);
                const f32x4 a2 = a * cs - b * sn, b2 = b * cs + a * sn; a = a2; b = b2;
            }
            if (col0 < KA || (col0 >= QN && col0 < KN)) { a = a * 0.125f; b = b * 0.125f; }
            if (col0 >= UB && col0 < QN) {
                a = (f32x4){gelu_tanh(a.x), gelu_tanh(a.y), gelu_tanh(a.z), gelu_tanh(a.w)};
                b = (f32x4){gelu_tanh(b.x), gelu_tanh(b.y), gelu_tanh(b.z), gelu_tanh(b.w)};
            }
            bf16_t* zr = Z + (size_t)grow * INW + col0;
            u32x2 w0, w1; w0.x = pk2(a.x, a.y); w0.y = pk2(a.z, a.w); w1.x = pk2(b.x, b.y); w1.y = pk2(b.z, b.w);
            *(u32x2*)zr = w0; *(u32x2*)(zr + 16) = w1;
        }
    }
};
struct EpiG2 {
    const float* xlat; const float* xctx; float* out; float* XC; const float* MOD; int l;
    __device__ __forceinline__ void row(const Unit& u, int r, int cbase, const f32x4 (&v)[2][2]) const {
        const int grow = u.pm * 256 + r;
        const float* src = grow < NLAT ? xlat + (size_t)grow * D : xctx + (size_t)(grow - NLAT) * D;
        float* dst = grow < NLAT ? out + (size_t)grow * D : XC + (size_t)(grow - NLAT) * D;
        const float* g1 = MOD + ((size_t)(l * 9 + mod_row(grow)) * 6 + 2) * D;
#pragma unroll
        for (int bj = 0; bj < 2; ++bj)
#pragma unroll
            for (int n = 0; n < 2; ++n) { const int c = u.pn * 256 + bj * 128 + cbase + 16 * n;
                *(f32x4*)(dst + c) = *(const f32x4*)(src + c) + *(const f32x4*)(g1 + c) * v[bj][n]; }
    }
};
struct EpiE1 {
    bf16_t* HB;
    __device__ __forceinline__ void row(const Unit& u, int r, int cbase, const f32x4 (&v)[2][2]) const {
        bf16_t* hr = HB + (size_t)(u.pm * 256 + r) * FF + u.pn * 128 + cbase;
#pragma unroll
        for (int n = 0; n < 2; ++n) { const f32x4 g = v[0][n], up = v[1][n];
            u32x2 w; w.x = pk2(silu_f(g.x) * up.x, silu_f(g.y) * up.y); w.y = pk2(silu_f(g.z) * up.z, silu_f(g.w) * up.w);
            *(u32x2*)(hr + 16 * n) = w; }
    }
};
struct EpiE2 {
    MoeTab T; const unsigned* LIST; const float* LISTW; bf16_t* Y2; float* out; float* XC; const float* MOD; int l;
    __device__ __forceinline__ void row(const Unit& u, int r, int cbase, const f32x4 (&v)[2][2]) const {
        const int idx = u.lt * 256 + r;
        if (u.e == NE) {
            float* dst = idx < NLAT ? out + (size_t)idx * D : XC + (size_t)(idx - NLAT) * D;
            const float* g2 = MOD + ((size_t)(l * 9 + mod_row(idx)) * 6 + 5) * D;
#pragma unroll
            for (int bj = 0; bj < 2; ++bj)
#pragma unroll
                for (int n = 0; n < 2; ++n) { const int c = u.pn * 256 + bj * 128 + cbase + 16 * n;
                    *(f32x4*)(dst + c) = *(const f32x4*)(dst + c) + *(const f32x4*)(g2 + c) * v[bj][n]; }
        } else if (idx < T.cnt[u.e]) {
            const unsigned ent = LIST[(size_t)u.e * LIST_CAP + idx]; const float w = LISTW[(size_t)u.e * LIST_CAP + idx];
            bf16_t* yr = Y2 + ((size_t)(ent & 0xffffu) * 8 + (ent >> 16)) * D + u.pn * 256 + cbase;
#pragma unroll
            for (int bj = 0; bj < 2; ++bj)
#pragma unroll
                for (int n = 0; n < 2; ++n) { const f32x4 x = v[bj][n] * w; u32x2 o; o.x = pk2(x.x, x.y); o.y = pk2(x.z, x.w); *(u32x2*)(yr + bj * 128 + 16 * n) = o; }
        }
    }
};

template <class Sched, class Epi>
__device__ __forceinline__ void gemm_simple(Frame& F, const Sched& S, const Epi& E, int K) {
    float* As = (float*)F.lds;
    float* Bs = (float*)(F.lds + 32 * 132 * 4);
    const int tid = F.tid, cg = tid & 15, rg = tid >> 4, wc = cg >> 2, fq = cg & 3, cbase = 32 * wc + 4 * fq;
    Unit u;
    for (int i = 0; S.next(i, u); ++i) {
        const bf16_t* bp = S.b_row(u, tid >> 1) + 16 * (tid & 1);
        for (int ai = 0; ai < 2; ++ai) {
            const bf16_t* ap = S.a_row(u, ai * 128 + (tid >> 2)) + 8 * (tid & 3);
            f32x4 acc[4][2][2];
#pragma unroll
            for (int a = 0; a < 4; ++a)
#pragma unroll
                for (int b = 0; b < 2; ++b)
#pragma unroll
                    for (int n = 0; n < 2; ++n) acc[a][b][n] = (f32x4){0.f, 0.f, 0.f, 0.f};
            for (int k0 = 0; k0 < K; k0 += 32) {
                const u32x4 wa = *(const u32x4*)(ap + k0);
                const u32x4 wb0 = *(const u32x4*)(bp + k0), wb1 = *(const u32x4*)(bp + k0 + 8);
                __syncthreads();
                { const int row = tid >> 2, kc = 8 * (tid & 3);
                  As[(kc + 0) * 132 + row] = bf_lo(wa.x); As[(kc + 1) * 132 + row] = bf_hi(wa.x); As[(kc + 2) * 132 + row] = bf_lo(wa.y); As[(kc + 3) * 132 + row] = bf_hi(wa.y);
                  As[(kc + 4) * 132 + row] = bf_lo(wa.z); As[(kc + 5) * 132 + row] = bf_hi(wa.z); As[(kc + 6) * 132 + row] = bf_lo(wa.w); As[(kc + 7) * 132 + row] = bf_hi(wa.w); }
                { const int col = tid >> 1, kc = 16 * (tid & 1);
                  Bs[(kc + 0) * 260 + col] = bf_lo(wb0.x); Bs[(kc + 1) * 260 + col] = bf_hi(wb0.x); Bs[(kc + 2) * 260 + col] = bf_lo(wb0.y); Bs[(kc + 3) * 260 + col] = bf_hi(wb0.y);
                  Bs[(kc + 4) * 260 + col] = bf_lo(wb0.z); Bs[(kc + 5) * 260 + col] = bf_hi(wb0.z); Bs[(kc + 6) * 260 + col] = bf_lo(wb0.w); Bs[(kc + 7) * 260 + col] = bf_hi(wb0.w);
                  Bs[(kc + 8) * 260 + col] = bf_lo(wb1.x); Bs[(kc + 9) * 260 + col] = bf_hi(wb1.x); Bs[(kc + 10) * 260 + col] = bf_lo(wb1.y); Bs[(kc + 11) * 260 + col] = bf_hi(wb1.y);
                  Bs[(kc + 12) * 260 + col] = bf_lo(wb1.z); Bs[(kc + 13) * 260 + col] = bf_hi(wb1.z); Bs[(kc + 14) * 260 + col] = bf_lo(wb1.w); Bs[(kc + 15) * 260 + col] = bf_hi(wb1.w); }
                __syncthreads();
#pragma unroll 4
                for (int kk = 0; kk < 32; ++kk) {
                    const f32x4 a = *(const f32x4*)(As + kk * 132 + 4 * rg);
                    f32x4 b[2][2];
#pragma unroll
                    for (int bj = 0; bj < 2; ++bj)
#pragma unroll
                        for (int n = 0; n < 2; ++n) b[bj][n] = *(const f32x4*)(Bs + kk * 260 + 128 * bj + cbase + 16 * n);
#pragma unroll
                    for (int bj = 0; bj < 2; ++bj)
#pragma unroll
                        for (int n = 0; n < 2; ++n) { acc[0][bj][n] += a.x * b[bj][n]; acc[1][bj][n] += a.y * b[bj][n]; acc[2][bj][n] += a.z * b[bj][n]; acc[3][bj][n] += a.w * b[bj][n]; }
                }
            }
#pragma unroll
            for (int a = 0; a < 4; ++a) E.row(u, ai * 128 + 4 * rg + a, cbase, acc[a]);
        }
    }
    __syncthreads();
}

__device__ __forceinline__ void load_q64(const bf16_t* p, float (&q)[64]) {
#pragma unroll
    for (int c = 0; c < 8; ++c) { const u32x4 w = *(const u32x4*)(p + 8 * c);
        q[8 * c + 0] = bf_lo(w.x); q[8 * c + 1] = bf_hi(w.x); q[8 * c + 2] = bf_lo(w.y); q[8 * c + 3] = bf_hi(w.y);
        q[8 * c + 4] = bf_lo(w.z); q[8 * c + 5] = bf_hi(w.z); q[8 * c + 6] = bf_lo(w.w); q[8 * c + 7] = bf_hi(w.w); }
}
__device__ __forceinline__ void attn_key(const float (&q)[64], const bf16_t* kp, const bf16_t* vp, float bias, float& m, float& l, float (&o)[64]) {
    float s0 = bias, s1 = 0.f;
#pragma unroll
    for (int c = 0; c < 8; ++c) { const u32x4 w = *(const u32x4*)(kp + 8 * c);
        s0 += q[8 * c + 0] * bf_lo(w.x) + q[8 * c + 2] * bf_lo(w.y) + q[8 * c + 4] * bf_lo(w.z) + q[8 * c + 6] * bf_lo(w.w);
        s1 += q[8 * c + 1] * bf_hi(w.x) + q[8 * c + 3] * bf_hi(w.y) + q[8 * c + 5] * bf_hi(w.z) + q[8 * c + 7] * bf_hi(w.w); }
    const float s = s0 + s1;
    const float mn = fmaxf(m, s), sc = __expf(m - mn), p = __expf(s - mn);
    l = l * sc + p; m = mn;
#pragma unroll
    for (int c = 0; c < 8; ++c) { const u32x4 w = *(const u32x4*)(vp + 8 * c);
        o[8 * c + 0] = o[8 * c + 0] * sc + p * bf_lo(w.x); o[8 * c + 1] = o[8 * c + 1] * sc + p * bf_hi(w.x);
        o[8 * c + 2] = o[8 * c + 2] * sc + p * bf_lo(w.y); o[8 * c + 3] = o[8 * c + 3] * sc + p * bf_hi(w.y);
        o[8 * c + 4] = o[8 * c + 4] * sc + p * bf_lo(w.z); o[8 * c + 5] = o[8 * c + 5] * sc + p * bf_hi(w.z);
        o[8 * c + 6] = o[8 * c + 6] * sc + p * bf_lo(w.w); o[8 * c + 7] = o[8 * c + 7] * sc + p * bf_hi(w.w); }
}
__device__ __forceinline__ void attn_finish(Frame& F, int r, int ycol, int slot, float l, float (&o)[64]) {
    const float inv = 1.0f / l; float ss = 0.f;
    bf16_t* yp = F.Y() + (size_t)r * D + ycol;
#pragma unroll
    for (int c = 0; c < 8; ++c) { float t[8];
#pragma unroll
        for (int j = 0; j < 8; ++j) { t[j] = o[8 * c + j] * inv; ss += t[j] * t[j]; }
        u32x4 w; w.x = pk2(t[0], t[1]); w.y = pk2(t[2], t[3]); w.z = pk2(t[4], t[5]); w.w = pk2(t[6], t[7]);
        *(u32x4*)(yp + 8 * c) = w; }
    F.SSQ()[(size_t)r * 16 + slot] = ss;
}
__device__ __forceinline__ void attn_item(Frame& F, int l, int variant, int qb, int h) {
    const bool latent = variant < 2; const bool isA = (variant == 0 || variant == 2);
    const int r = (latent ? 0 : NLAT) + qb * NTHR + F.tid;
    const int b = latent ? (r >> 11) : ((r - NLAT) >> 8);
    const int qcol = isA ? QA + 64 * h : QN + 64 * h;
    const int kcol = isA ? KA + 64 * (h / 3) : KN + 64 * h, vcol = isA ? VA + 64 * (h / 3) : VN + 64 * h;
    float q[64], o[64];
    load_q64(F.Z() + (size_t)r * INW + qcol, q);
#pragma unroll
    for (int i = 0; i < 64; ++i) o[i] = 0.f;
    float m, ls;
    if (isA) { m = F.inp(IN_SINK)[l * 6 + h]; ls = 1.0f; } else { m = NEGF; ls = 0.f; }
    const bf16_t* zc = F.Z() + (size_t)(NLAT + b * CTXL) * INW;
#pragma unroll 1
    for (int c = 0; c < CTXL; ++c) attn_key(q, zc + (size_t)c * INW + kcol, zc + (size_t)c * INW + vcol, 0.f, m, ls, o);
    if (variant == 0) {
        const int t = r & (SEQ - 1); const int lo = max(0, t - 128), hi = min(SEQ - 1, t + 128);
        const bf16_t* zb = F.Z() + (size_t)(b * SEQ) * INW;
#pragma unroll 1
        for (int kp = lo; kp <= hi; ++kp) attn_key(q, zb + (size_t)kp * INW + kcol, zb + (size_t)kp * INW + vcol, 0.f, m, ls, o);
    } else if (variant == 1) {
        const int t = r & (SEQ - 1), row = t >> 6, col = t & 63;
        const int rs = min(max(row - 4, 0), 24), cs = min(max(col - 8, 0), 48);
        const bf16_t* zb = F.Z() + (size_t)(b * SEQ) * INW;
        const float* rpb = F.inp(IN_RPB) + (size_t)(l * 6 + h) * 15 * 31;
#pragma unroll 1
        for (int j = 0; j < 8; ++j)
#pragma unroll 1
            for (int cc = 0; cc < 16; ++cc) { const int kr = rs + j, kc = cs + cc; const size_t ko = (size_t)(kr * 64 + kc) * INW;
                const float bias = rpb[(kr - row + 7) * 31 + (kc - col + 15)];
                attn_key(q, zb + ko + kcol, zb + ko + vcol, bias, m, ls, o); }
    }
    attn_finish(F, r, (isA ? 0 : 640) + 64 * h, (isA ? 0 : 10) + h, ls, o);
}
__device__ __forceinline__ void sgu_item(Frame& F, int l, int ch, int g) {
    float* vg = (float*)F.lds;
    const int row0 = ch < 128 ? ch * 128 : NLAT + (ch - 128) * 128;
    const int p = F.tid >> 2, dq = F.tid & 3;
    __syncthreads();
    {
        const bf16_t* zp = F.Z() + (size_t)(row0 + p) * INW + VB + 64 * g + 16 * dq;
        const u32x4 w0 = *(const u32x4*)zp, w1 = *(const u32x4*)(zp + 8);
        float t[16] = {bf_lo(w0.x), bf_hi(w0.x), bf_lo(w0.y), bf_hi(w0.y), bf_lo(w0.z), bf_hi(w0.z), bf_lo(w0.w), bf_hi(w0.w),
                       bf_lo(w1.x), bf_hi(w1.x), bf_lo(w1.y), bf_hi(w1.y), bf_lo(w1.z), bf_hi(w1.z), bf_lo(w1.w), bf_hi(w1.w)};
        float ss = 0.f;
#pragma unroll
        for (int i = 0; i < 16; ++i) ss += t[i] * t[i];
        ss += __shfl_xor(ss, 1); ss += __shfl_xor(ss, 2);
        const float rstd = 1.0f / sqrtf(ss * (1.0f / 64.0f) + EPS);
        const float* ng = F.inp(IN_SGUG) + l * 256 + 64 * g + 16 * dq;
#pragma unroll
        for (int i = 0; i < 16; ++i) vg[p * 65 + 16 * dq + i] = t[i] * rstd * ng[i];
    }
    __syncthreads();
    float acc[16];
#pragma unroll
    for (int i = 0; i < 16; ++i) acc[i] = 0.f;
    const float* ws = F.inp(IN_SGUW) + ((size_t)(l * 4 + g) * 128 + p) * 128;
#pragma unroll 4
    for (int qq = 0; qq < 128; ++qq) { const float w = ws[qq];
#pragma unroll
        for (int i = 0; i < 16; ++i) acc[i] += w * vg[qq * 65 + 16 * dq + i]; }
    const float bs = F.inp(IN_SGUB)[(l * 4 + g) * 128 + p];
    const bf16_t* up = F.Z() + (size_t)(row0 + p) * INW + UB + 64 * g + 16 * dq;
    const u32x4 u0 = *(const u32x4*)up, u1 = *(const u32x4*)(up + 8);
    const float uu[16] = {bf_lo(u0.x), bf_hi(u0.x), bf_lo(u0.y), bf_hi(u0.y), bf_lo(u0.z), bf_hi(u0.z), bf_lo(u0.w), bf_hi(u0.w),
                          bf_lo(u1.x), bf_hi(u1.x), bf_lo(u1.y), bf_hi(u1.y), bf_lo(u1.z), bf_hi(u1.z), bf_lo(u1.w), bf_hi(u1.w)};
    float ss = 0.f;
#pragma unroll
    for (int i = 0; i < 16; ++i) { acc[i] = uu[i] * (acc[i] + bs); ss += acc[i] * acc[i]; }
    ss += __shfl_xor(ss, 1); ss += __shfl_xor(ss, 2);
    bf16_t* yp = F.Y() + (size_t)(row0 + p) * D + 384 + 64 * g + 16 * dq;
    u32x4 o0, o1; o0.x = pk2(acc[0], acc[1]); o0.y = pk2(acc[2], acc[3]); o0.z = pk2(acc[4], acc[5]); o0.w = pk2(acc[6], acc[7]);
    o1.x = pk2(acc[8], acc[9]); o1.y = pk2(acc[10], acc[11]); o1.z = pk2(acc[12], acc[13]); o1.w = pk2(acc[14], acc[15]);
    *(u32x4*)yp = o0; *(u32x4*)(yp + 8) = o1;
    if (dq == 0) F.SSQ()[(size_t)(row0 + p) * 16 + 6 + g] = ss;
}
__device__ __forceinline__ void phase_mix(Frame& F, int l) {
    const int nA = 192, nC = 192, nS = 512, nAc = (l == 0) ? 24 : 0, nCc = nAc, nSc = (l == 0) ? 64 : 0;
    const int total = nA + nC + nS + nAc + nCc + nSc;
    for (int it = F.bid; it < total; it += F.G) {
        int r = it;
        if (r < nA) { attn_item(F, l, 0, r / 6, r % 6); continue; } r -= nA;
        if (r < nC) { attn_item(F, l, 1, r / 6, r % 6); continue; } r -= nC;
        if (r < nS) { sgu_item(F, l, r >> 2, r & 3); continue; } r -= nS;
        if (r < nAc) { attn_item(F, l, 2, r / 6, r % 6); continue; } r -= nAc;
        if (r < nCc) { attn_item(F, l, 3, r / 6, r % 6); continue; } r -= nCc;
        sgu_item(F, l, 128 + (r >> 2), r & 3);
    }
    __syncthreads();
}

__global__ void __launch_bounds__(NTHR, 2) mk_fwd(Params P) {
    extern __shared__ __attribute__((aligned(16))) unsigned char lds[];
    Frame F;
    F.lds = lds; F.tid = threadIdx.x; F.lane = F.tid & 63; F.wave = __builtin_amdgcn_readfirstlane(F.tid >> 6); F.bid = blockIdx.x; F.G = gridDim.x;
    F.P = &P;
    volatile LAS unsigned* MISC = (volatile LAS unsigned*)((LAS unsigned char*)lds + MISC_OFF);
    for (int u = F.tid; u < (LDS_BYTES - RING_BYTES) / 4; u += NTHR) ((LAS unsigned*)((LAS unsigned char*)lds + RING_BYTES))[u] = 0u;
    __syncthreads();
    XcdBarrier bar = xcd_barrier_post(F.ctl() + CW_BAR, MISC + 8);
#define LAUNDER() do { asm volatile("" : "+v"(F.tid)); asm volatile("" : "+v"(F.lane)); } while (0)
#define GRID_BAR() do { xcd_barrier(bar); LAUNDER(); } while (0)

    p0_prologue(F);
    GRID_BAR();
    phase_r1(F, 0);
    GRID_BAR();
#pragma unroll 1
    for (int l = 0; l < DEPTH; ++l) {
        const int nrows = (l == 0) ? NTOK : NLAT;
        {
            SchedDense S{F.H1(), F.WIN() + (size_t)l * INW * D, D, NTOK / 256, INW / 256, F.G, F.bid};
            EpiG1 E{F.Z(), F.ROPE()};
            gemm_simple(F, S, E, D);
            if (l == 1) conv_experts(F, 1);
        }
        GRID_BAR();
        phase_mix(F, l);
        GRID_BAR();
        phase_nrm(F, l, nrows);
        GRID_BAR();
        {
            SchedDense S{F.Y(), F.WOUT() + (size_t)l * D * D, D, nrows / 256, D / 256, F.G, F.bid};
            EpiG2 E{l == 0 ? F.inp(IN_X) : F.outp(), l == 0 ? F.inp(IN_CTX) : F.XC(), F.outp(), F.XC(), F.MOD(), l};
            gemm_simple(F, S, E, D);
        }
        GRID_BAR();
        phase_r2(F, l, nrows);
        GRID_BAR();
        moe_build_tab(F, l, nrows); LAUNDER();
        const MoeTab T{(const int*)(F.lds + TOFF_OFF), (const int*)(F.lds + TOFF_OFF) + 72};
        {
            SchedE1 S{T, F.LIST(), F.H1(), F.WEXPGU(), F.WSHGU() + (size_t)l * 512 * D, F.G, F.bid};
            EpiE1 E{F.HB()};
            gemm_simple(F, S, E, D);
        }
        GRID_BAR();
        {
            SchedE2 S{T, F.HB(), F.WEXPD(), F.WSHD() + (size_t)l * D * FF, F.G, F.bid};
            EpiE2 E{T, F.LIST(), F.LISTW(), F.Y2(), F.outp(), F.XC(), F.MOD(), l};
            gemm_simple(F, S, E, FF);
        }
        GRID_BAR();
        phase_cmb(F, l, nrows);
        if (l == 0) GRID_BAR();
    }
}

extern "C" void kernel_launch(void* const* d_in, const int* in_sizes, int n_in, void* d_out, int out_size, void* d_ws, size_t ws_size, hipStream_t stream) {
    static int grid = 0;
    if (grid == 0) {
        if (n_in != N_IN || in_sizes[0] != NLAT * D || out_size != NLAT * D || ws_size < WS_END) {
            fprintf(stderr, "kernel_launch: unexpected shapes / workspace (n_in %d, in0 %d, out %d, ws %zu need %zu); nothing launched\n", n_in, n_in > 0 ? in_sizes[0] : -1, out_size, ws_size, (size_t)WS_END);
            grid = -1; return; }
        int dev = 0, cus = 0, per_cu = 0;
        if (hipGetDevice(&dev) != hipSuccess || hipDeviceGetAttribute(&cus, hipDeviceAttributeMultiprocessorCount, dev) != hipSuccess) { grid = -1; return; }
        if (hipFuncSetAttribute((const void*)mk_fwd, hipFuncAttributeMaxDynamicSharedMemorySize, LDS_BYTES) != hipSuccess) { fprintf(stderr, "kernel_launch: hipFuncSetAttribute failed\n"); grid = -1; return; }
        if (hipOccupancyMaxActiveBlocksPerMultiprocessor(&per_cu, (const void*)mk_fwd, NTHR, LDS_BYTES) != hipSuccess || per_cu < 1) { fprintf(stderr, "kernel_launch: occupancy query says %d blocks/CU; nothing launched\n", per_cu); grid = -1; return; }
        (void)hipGetLastError();
        grid = cus;
    }
    if (grid < 0) return;
    if (hipMemsetAsync((char*)d_ws + WS_CTL, 0, CTL_ZERO_BYTES, stream) != hipSuccess) return;
    Params p{};
    for (int i = 0; i < N_IN; ++i) p.in[i] = (const float*)d_in[i];
    p.out = (float*)d_out; p.ws = (unsigned char*)d_ws;
    hipLaunchKernelGGL(mk_fwd, dim3(grid), dim3(NTHR), LDS_BYTES, stream, p);
}
```

```cpp
#include <hip/hip_runtime.h>
#include <cstdio>
#include <cstdint>

#define LAS __attribute__((address_space(3)))
typedef unsigned short bf16_t;
typedef float f32x4 __attribute__((ext_vector_type(4)));
typedef float f32x2 __attribute__((ext_vector_type(2)));
typedef unsigned u32x4 __attribute__((ext_vector_type(4)));
typedef unsigned u32x2 __attribute__((ext_vector_type(2)));
typedef __bf16 bf16x2_t __attribute__((ext_vector_type(2)));

constexpr int D = 1024, NB = 8, SEQ = 2048, CTXL = 256, HD = 64, INW = 2304, NE = 64, FF = 256, DEPTH = 2;
constexpr int NLAT = NB * SEQ, NCTX = NB * CTXL, NTOK = NLAT + NCTX;
constexpr int QA = 0, KA = 384, VA = 512, UB = 640, VB = 896, QN = 1152, KN = 1536, VN = 1920;
constexpr float EPS = 1e-6f, NEGF = -1e30f;
constexpr int NWAVES = 8, NTHR = 512;
enum { IN_X = 0, IN_C, IN_CTX, IN_CCTX, IN_MODW, IN_MODB, IN_N1G, IN_WIN, IN_SINK, IN_SGUG, IN_SGUW, IN_SGUB, IN_RPB, IN_GNG, IN_WOUT, IN_N2G,
       IN_RW, IN_RB, IN_EG, IN_EU, IN_ED, IN_SG, IN_SU, IN_SD, IN_FG, N_IN };

constexpr size_t MiB = 1u << 20;
constexpr size_t WS_CTL = 0, CTL_ZERO_BYTES = 64 * 1024;
constexpr size_t WS_MOD = 1 * MiB;
constexpr size_t WS_ROPE = 1 * MiB + 512 * 1024;
constexpr size_t WS_WIN = 2 * MiB;
constexpr size_t WS_WOUT = 11 * MiB;
constexpr size_t WS_WSHGU = 15 * MiB;
constexpr size_t WS_WSHD = 17 * MiB;
constexpr size_t WS_XC = 18 * MiB;
constexpr size_t WS_LIST = 26 * MiB;
constexpr size_t WS_LISTW = 26 * MiB + 4608 * 1024;
constexpr size_t WS_H1 = 36 * MiB;
constexpr size_t WS_WEXPD = 72 * MiB;
constexpr size_t WS_ZH = 104 * MiB;
constexpr size_t WS_Y2 = 194 * MiB;
constexpr size_t WS_Y = WS_Y2;
constexpr size_t WS_SSQ = WS_Y2 + 36 * MiB;
constexpr size_t WS_WEXPGU = WS_Y2 + 38 * MiB;
constexpr size_t WS_END = WS_Y2 + 288 * MiB;
constexpr int LIST_CAP = NTOK;
constexpr int CW_BAR = 4096, CW_CNT = 8192;

constexpr int RING_BYTES = 131072, MISC_OFF = 131072 + 320, TOFF_OFF = 131072 + 1024, LDS_BYTES = 147456;

__device__ __forceinline__ unsigned pk2(float lo, float hi) { f32x2 v = {lo, hi}; bf16x2_t b = __builtin_convertvector(v, bf16x2_t); return __builtin_bit_cast(unsigned, b); }
__device__ __forceinline__ float bf_lo(unsigned w) { return __uint_as_float(w << 16); }
__device__ __forceinline__ float bf_hi(unsigned w) { return __uint_as_float(w & 0xffff0000u); }
__device__ __forceinline__ float wave_sum(float v) {
#pragma unroll
    for (int o = 1; o < 64; o <<= 1) v += __shfl_xor(v, o);
    return v;
}
__device__ __forceinline__ float gelu_tanh(float x) {
    const float u = 0.7978845608028654f * (x + 0.044715f * x * x * x);
    const float e = __expf(2.f * u);
    const float t = 1.f - 2.f / (e + 1.f);
    return 0.5f * x * (1.f + t);
}
__device__ __forceinline__ float silu_f(float x) { return x / (1.f + __expf(-x)); }

#define XB_TMO      128
#define XB_XCNT(j)  (256  + 64 * (j))
#define XB_XSUB(j)  (1280 + 64 * (j))
#define XB_XGEN(j)  (2304 + 64 * (j))
#define XB_TOP      3328
#define XB_TOPGEN   3392
#define XCD_BAR_WORDS 3456
#define XB_SPIN_CAP (1u << 18)
__device__ __forceinline__ unsigned xb_ld(unsigned* p)              { return __hip_atomic_load(p, __ATOMIC_RELAXED, __HIP_MEMORY_SCOPE_AGENT); }
__device__ __forceinline__ unsigned xb_add(unsigned* p, unsigned v) { return __hip_atomic_fetch_add(p, v, __ATOMIC_RELAXED, __HIP_MEMORY_SCOPE_AGENT); }
__device__ __forceinline__ unsigned xb_xcc_id() { return (unsigned)__builtin_amdgcn_s_getreg((3 << 11) | 20) & 0xFu; }
#define XB_SPIN(cond, bar) do { unsigned _sp = 0; while (cond) { __builtin_amdgcn_s_sleep(1); \
    if ((++_sp & 255u) == 0u) { if (xb_ld(&(bar)[XB_TMO])) break; if (_sp > XB_SPIN_CAP) { atomicAdd(&(bar)[XB_TMO], 1u); break; } } } } while (0)
struct XcdBarrier { unsigned* bar; unsigned x; volatile LAS unsigned* st; };
__device__ __forceinline__ XcdBarrier xcd_barrier_post(unsigned* bar, volatile LAS unsigned* st) {
    XcdBarrier b; b.bar = bar; b.x = xb_xcc_id(); b.st = st;
    if (threadIdx.x == 0) (void)xb_add(&bar[XB_XCNT(b.x)], 1u);
    return b;
}
__device__ __forceinline__ void xcd_barrier_complete(unsigned* bar, unsigned x, unsigned& nloc, unsigned& nx) {
    const unsigned G = gridDim.x * gridDim.y * gridDim.z;
    unsigned sum, cnt, mine, sp = 0u;
    for (;;) {
        sum = 0u; cnt = 0u; mine = 0u;
#pragma unroll 1
        for (unsigned j = 0; j < 16; ++j) { const unsigned c = xb_ld(&bar[XB_XCNT(j)]); sum += c; cnt += (c > 0u) ? 1u : 0u; mine = (j == x) ? c : mine; }
        if (sum == G) break;
        __builtin_amdgcn_s_sleep(1);
        if ((++sp & 255u) == 0u) { if (xb_ld(&bar[XB_TMO])) break; if (sp > XB_SPIN_CAP) { atomicAdd(&bar[XB_TMO], 1u); break; } }
    }
    nloc = mine > 0u ? mine : 1u; nx = cnt > 0u ? cnt : 1u;
}
__device__ __forceinline__ void xcd_barrier(const XcdBarrier& b) {
    asm volatile("s_waitcnt vmcnt(0)" ::: "memory");
    __syncthreads();
    if (threadIdx.x == 0) {
        unsigned* bar = b.bar;
        __builtin_amdgcn_s_waitcnt(0);
        unsigned nloc = b.st[0], nx = b.st[1];
        if (nloc == 0u) { xcd_barrier_complete(bar, b.x, nloc, nx); b.st[0] = nloc; b.st[1] = nx; }
        const unsigned old = xb_add(&bar[XB_XSUB(b.x)], 1u);
        const unsigned gen = old / nloc;
        if (old + 1u == (gen + 1u) * nloc) {
            __builtin_amdgcn_fence(__ATOMIC_RELEASE, "agent");
            asm volatile("s_waitcnt vmcnt(0)" ::: "memory");
            const unsigned og = xb_add(&bar[XB_TOP], 1u);
            const unsigned tg = og / nx;
            if (og + 1u == (tg + 1u) * nx) xb_add(&bar[XB_TOPGEN], 1u);
            else XB_SPIN(xb_ld(&bar[XB_TOPGEN]) == tg, bar);
            __builtin_amdgcn_fence(__ATOMIC_ACQUIRE, "agent");
            xb_add(&bar[XB_XGEN(b.x)], 1u);
            asm volatile("s_waitcnt vmcnt(0)" ::: "memory");
        } else {
            XB_SPIN(xb_ld(&bar[XB_XGEN(b.x)]) == gen, bar);
            __builtin_amdgcn_fence(__ATOMIC_ACQUIRE, "agent");
            asm volatile("s_waitcnt vmcnt(0)" ::: "memory");
        }
    }
    __syncthreads();
}

struct Params { const float* in[N_IN]; float* out; unsigned char* ws; };

struct Frame {
    unsigned char* lds;
    int tid, lane, wave, bid, G;
    const Params* P;
    __device__ __forceinline__ const float* inp(int i) const { return P->in[i]; }
    __device__ __forceinline__ float* outp() const { return P->out; }
    __device__ __forceinline__ unsigned char* wsb() const { return P->ws; }
    __device__ __forceinline__ unsigned* ctl() const { return (unsigned*)(P->ws + WS_CTL); }
    __device__ __forceinline__ float* MOD() const { return (float*)(P->ws + WS_MOD); }
    __device__ __forceinline__ float* ROPE() const { return (float*)(P->ws + WS_ROPE); }
    __device__ __forceinline__ bf16_t* WIN() const { return (bf16_t*)(P->ws + WS_WIN); }
    __device__ __forceinline__ bf16_t* WOUT() const { return (bf16_t*)(P->ws + WS_WOUT); }
    __device__ __forceinline__ bf16_t* WSHGU() const { return (bf16_t*)(P->ws + WS_WSHGU); }
    __device__ __forceinline__ bf16_t* WSHD() const { return (bf16_t*)(P->ws + WS_WSHD); }
    __device__ __forceinline__ bf16_t* WEXPGU() const { return (bf16_t*)(P->ws + WS_WEXPGU); }
    __device__ __forceinline__ bf16_t* WEXPD() const { return (bf16_t*)(P->ws + WS_WEXPD); }
    __device__ __forceinline__ bf16_t* H1() const { return (bf16_t*)(P->ws + WS_H1); }
    __device__ __forceinline__ bf16_t* Z() const { return (bf16_t*)(P->ws + WS_ZH); }
    __device__ __forceinline__ bf16_t* HB() const { return (bf16_t*)(P->ws + WS_ZH); }
    __device__ __forceinline__ bf16_t* Y() const { return (bf16_t*)(P->ws + WS_Y); }
    __device__ __forceinline__ bf16_t* Y2() const { return (bf16_t*)(P->ws + WS_Y2); }
    __device__ __forceinline__ float* XC() const { return (float*)(P->ws + WS_XC); }
    __device__ __forceinline__ float* SSQ() const { return (float*)(P->ws + WS_SSQ); }
    __device__ __forceinline__ float* LISTW() const { return (float*)(P->ws + WS_LISTW); }
    __device__ __forceinline__ unsigned* LIST() const { return (unsigned*)(P->ws + WS_LIST); }
};
__device__ __forceinline__ float* xa_row(const Frame& F, int r) { return r < NLAT ? F.outp() + (size_t)r * D : F.XC() + (size_t)(r - NLAT) * D; }
__device__ __forceinline__ int mod_row(int r) { return r < NLAT ? (r >> 11) : 8; }
__device__ __forceinline__ const float* mod_ptr(const Frame& F, int l, int r, int chunk) { return F.MOD() + ((size_t)(l * 9 + mod_row(r)) * 6 + chunk) * D; }
__device__ __forceinline__ unsigned* cnt_ptr(const Frame& F, int l, int e) { return F.ctl() + CW_CNT + (l * 64 + e) * 16; }

__device__ __forceinline__ void transpose_item(const float* W, int K, int N, bf16_t* WT, int k0, int n0, int rbase, float* scr, int lane) {
#pragma unroll 8
    for (int i = 0; i < 32; ++i) { const int kk = 2 * i + (lane >> 5); scr[kk * 33 + (lane & 31)] = W[(size_t)(k0 + kk) * N + n0 + (lane & 31)]; }
    asm volatile("s_waitcnt lgkmcnt(0)" ::: "memory");
    const int c = lane & 7;
#pragma unroll
    for (int j = 0; j < 4; ++j) { const int n = (lane >> 3) + 8 * j; const float* s = scr + (8 * c) * 33 + n;
        u32x4 o; o.x = pk2(s[0 * 33], s[1 * 33]); o.y = pk2(s[2 * 33], s[3 * 33]); o.z = pk2(s[4 * 33], s[5 * 33]); o.w = pk2(s[6 * 33], s[7 * 33]);
        *(u32x4*)(WT + (size_t)(rbase + n) * K + k0 + 8 * c) = o; }
    asm volatile("s_waitcnt lgkmcnt(0)" ::: "memory");
}
__device__ __forceinline__ void conv_weight(const float* W, int K, int N, bf16_t* WT, int gu, int item, float* scr, int lane) {
    const int nblk = N / 32, kb = item / nblk, nb = item % nblk, n0 = 32 * nb;
    const int rbase = gu == 0 ? n0 : ((n0 >> 7) * 256 + (n0 & 127) + (gu == 2 ? 128 : 0));
    transpose_item(W, K, N, WT, 64 * kb, n0, rbase, scr, lane);
}
__device__ __forceinline__ void conv_experts(Frame& F, int l) {
    float* scr = (float*)(F.lds + F.wave * 16384);
    const int gw = F.bid * NWAVES + F.wave, NGW = F.G * NWAVES;
    constexpr int IG = (D / 64) * (FF / 32), ID = (FF / 64) * (D / 32);
    constexpr int PER = 2 * IG + ID;
    for (int it = gw; it < NE * PER; it += NGW) {
        const int e = it / PER; int r = it % PER;
        const size_t eo = (size_t)(l * NE + e) * D * FF;
        if (r < IG) { conv_weight(F.inp(IN_EG) + eo, D, FF, F.WEXPGU() + (size_t)e * 512 * D, 1, r, scr, F.lane); continue; } r -= IG;
        if (r < IG) { conv_weight(F.inp(IN_EU) + eo, D, FF, F.WEXPGU() + (size_t)e * 512 * D, 2, r, scr, F.lane); continue; } r -= IG;
        conv_weight(F.inp(IN_ED) + eo, FF, D, F.WEXPD() + (size_t)e * D * FF, 0, r, scr, F.lane);
    }
}
__device__ __forceinline__ void p0_prologue(Frame& F) {
    if (F.bid == 0) {
        for (int i = F.tid; i < 64 * 16; i += NTHR) { const int pos = i >> 4, f = i & 15;
            const float inv = powf(10000.0f, -(float)(2 * f) / 32.0f); const float a = (float)pos * inv;
            F.ROPE()[i] = cosf(a); F.ROPE()[1024 + i] = sinf(a); }
    }
    {
        float* sl = (float*)F.lds;
        float* red = (float*)(F.lds + 40960);
        bool have = false;
        for (int it = F.bid; it < 2 * 96; it += F.G) {
            if (!have) {
                for (int i = F.tid; i < 9 * D; i += NTHR) { const int r = i >> 10, k = i & 1023; const float v = r < 8 ? F.inp(IN_C)[r * D + k] : F.inp(IN_CCTX)[k]; sl[i] = silu_f(v); }
                __syncthreads(); have = true;
            }
            const int l = it / 96, jc = it % 96, c = F.tid & 63, kg = F.tid >> 6;
            const float* W = F.inp(IN_MODW) + (size_t)l * D * 6144 + 64 * jc + c;
            float acc[9];
#pragma unroll
            for (int r = 0; r < 9; ++r) acc[r] = 0.f;
#pragma unroll 8
            for (int k = 128 * kg; k < 128 * kg + 128; ++k) { const float w = W[(size_t)k * 6144];
#pragma unroll
                for (int r = 0; r < 9; ++r) acc[r] += sl[r * D + k] * w; }
#pragma unroll
            for (int r = 0; r < 9; ++r) red[(kg * 9 + r) * 64 + c] = acc[r];
            __syncthreads();
            for (int i = F.tid; i < 9 * 64; i += NTHR) { const int r = i >> 6, cc = i & 63; float s = 0.f;
#pragma unroll
                for (int g = 0; g < 8; ++g) s += red[(g * 9 + r) * 64 + cc];
                F.MOD()[(size_t)(l * 9 + r) * 6144 + 64 * jc + cc] = s + F.inp(IN_MODB)[l * 6144 + 64 * jc + cc]; }
            __syncthreads();
        }
        __syncthreads();
    }
    {
        float* scr = (float*)(F.lds + F.wave * 16384);
        const int gw = F.bid * NWAVES + F.wave, NGW = F.G * NWAVES;
        constexpr int I_IN = (D / 64) * (INW / 32), I_OUT = (D / 64) * (D / 32), I_SG = (D / 64) * (FF / 32), I_SD = (FF / 64) * (D / 32);
        constexpr int PER = I_IN + I_OUT + 2 * I_SG + I_SD;
        for (int it = gw; it < 2 * PER; it += NGW) {
            const int l = it / PER; int r = it % PER;
            if (r < I_IN) { conv_weight(F.inp(IN_WIN) + (size_t)l * D * INW, D, INW, F.WIN() + (size_t)l * INW * D, 0, r, scr, F.lane); continue; } r -= I_IN;
            if (r < I_OUT) { conv_weight(F.inp(IN_WOUT) + (size_t)l * D * D, D, D, F.WOUT() + (size_t)l * D * D, 0, r, scr, F.lane); continue; } r -= I_OUT;
            if (r < I_SG) { conv_weight(F.inp(IN_SG) + (size_t)l * D * FF, D, FF, F.WSHGU() + (size_t)l * 512 * D, 1, r, scr, F.lane); continue; } r -= I_SG;
            if (r < I_SG) { conv_weight(F.inp(IN_SU) + (size_t)l * D * FF, D, FF, F.WSHGU() + (size_t)l * 512 * D, 2, r, scr, F.lane); continue; } r -= I_SG;
            conv_weight(F.inp(IN_SD) + (size_t)l * FF * D, FF, D, F.WSHD() + (size_t)l * D * FF, 0, r, scr, F.lane);
        }
    }
    conv_experts(F, 0);
}

__device__ __forceinline__ void load_row(const float* src, int lane, f32x4 (&v)[4]) {
#pragma unroll
    for (int j = 0; j < 4; ++j) v[j] = *(const f32x4*)(src + 4 * lane + 256 * j);
}
__device__ __forceinline__ float row_rstd(const f32x4 (&v)[4]) {
    float s = 0.f;
#pragma unroll
    for (int j = 0; j < 4; ++j) s += (v[j].x * v[j].x + v[j].y * v[j].y) + (v[j].z * v[j].z + v[j].w * v[j].w);
    return 1.0f / sqrtf(wave_sum(s) * (1.0f / D) + EPS);
}
__device__ __forceinline__ void norm_mod(const f32x4 (&v)[4], float rstd, const float* g, const float* sh, const float* sc, int lane, f32x4 (&h)[4]) {
#pragma unroll
    for (int j = 0; j < 4; ++j) { const int c = 4 * lane + 256 * j; const f32x4 gg = *(const f32x4*)(g + c), s1 = *(const f32x4*)(sh + c), s2 = *(const f32x4*)(sc + c);
        h[j] = v[j] * rstd * gg * (1.0f + s2) + s1; }
}
__device__ __forceinline__ void store_row_bf16(bf16_t* dst, int lane, const f32x4 (&h)[4]) {
#pragma unroll
    for (int j = 0; j < 4; ++j) { u32x2 w; w.x = pk2(h[j].x, h[j].y); w.y = pk2(h[j].z, h[j].w); *(u32x2*)(dst + 4 * lane + 256 * j) = w; }
}
__device__ __forceinline__ void phase_r1(Frame& F, int l) {
    const int gw = F.bid * NWAVES + F.wave, NGW = F.G * NWAVES;
    for (int r = gw; r < NTOK; r += NGW) {
        const float* src = (l == 0) ? (r < NLAT ? F.inp(IN_X) + (size_t)r * D : F.inp(IN_CTX) + (size_t)(r - NLAT) * D) : xa_row(F, r);
        f32x4 v[4], h[4]; load_row(src, F.lane, v);
        const float rstd = row_rstd(v);
        norm_mod(v, rstd, F.inp(IN_N1G) + l * D, mod_ptr(F, l, r, 0), mod_ptr(F, l, r, 1), F.lane, h);
        store_row_bf16(F.H1() + (size_t)r * D, F.lane, h);
    }
}
__device__ __forceinline__ void phase_nrm(Frame& F, int l, int nrows) {
    const int gw = F.bid * NWAVES + F.wave, NGW = F.G * NWAVES;
    for (int r = gw; r < nrows; r += NGW) {
        const float* sq = F.SSQ() + (size_t)r * 16;
        const float sA = sq[0] + sq[1] + sq[2] + sq[3] + sq[4] + sq[5], sB = sq[6] + sq[7] + sq[8] + sq[9], sC = sq[10] + sq[11] + sq[12] + sq[13] + sq[14] + sq[15];
        const float rA = 1.0f / sqrtf(sA * (1.0f / 384.0f) + EPS), rB = 1.0f / sqrtf(sB * (1.0f / 256.0f) + EPS), rC = 1.0f / sqrtf(sC * (1.0f / 384.0f) + EPS);
        bf16_t* yr = F.Y() + (size_t)r * D;
#pragma unroll
        for (int j = 0; j < 4; ++j) { const int c = 4 * F.lane + 256 * j; const float rs = c < 384 ? rA : (c < 640 ? rB : rC);
            const u32x2 w = *(const u32x2*)(yr + c); const f32x4 gg = *(const f32x4*)(F.inp(IN_GNG) + l * D + c);
            u32x2 o; o.x = pk2(bf_lo(w.x) * rs * gg.x, bf_hi(w.x) * rs * gg.y); o.y = pk2(bf_lo(w.y) * rs * gg.z, bf_hi(w.y) * rs * gg.w);
            *(u32x2*)(yr + c) = o; }
    }
}
__device__ __forceinline__ void phase_r2(Frame& F, int l, int nrows) {
    const int gw = F.bid * NWAVES + F.wave, NGW = F.G * NWAVES;
    float* hl = (float*)(F.lds + F.wave * 4096);
    const float* RW = F.inp(IN_RW) + (size_t)l * D * NE;
    const float rbias = F.inp(IN_RB)[l * NE + F.lane];
    for (int r = gw; r < nrows; r += NGW) {
        f32x4 v[4], h[4]; load_row(xa_row(F, r), F.lane, v);
        const float rstd = row_rstd(v);
        norm_mod(v, rstd, F.inp(IN_N2G) + l * D, mod_ptr(F, l, r, 3), mod_ptr(F, l, r, 4), F.lane, h);
        store_row_bf16(F.H1() + (size_t)r * D, F.lane, h);
#pragma unroll
        for (int j = 0; j < 4; ++j) *(f32x4*)(hl + 4 * F.lane + 256 * j) = h[j];
        asm volatile("s_waitcnt lgkmcnt(0)" ::: "memory");
        float logit = 0.f;
#pragma unroll 8
        for (int k = 0; k < D; ++k) logit += hl[k] * RW[k * NE + F.lane];
        const float score = 1.0f / (1.0f + expf(-logit));
        const float sel = score + rbias;
        float m1 = sel;
#pragma unroll
        for (int o = 1; o < 8; o <<= 1) m1 = fmaxf(m1, __shfl_xor(m1, o));
        const unsigned long long bal = __ballot(sel == m1);
        const unsigned gm = (unsigned)(bal >> (F.lane & ~7)) & 0xffu; const int first = __ffs(gm) - 1;
        float m2 = ((F.lane & 7) == first) ? -3.0e38f : sel;
#pragma unroll
        for (int o = 1; o < 8; o <<= 1) m2 = fmaxf(m2, __shfl_xor(m2, o));
        const float gs = m1 + m2; const int g = F.lane >> 3; int rank = 0;
#pragma unroll
        for (int j = 0; j < 8; ++j) { const float o = __shfl(gs, j * 8); rank += ((o > gs) || (o == gs && j < g)) ? 1 : 0; }
        const float msel = rank < 4 ? sel : NEGF;
        int r2 = 0;
#pragma unroll
        for (int j = 0; j < 64; ++j) { const float o = __shfl(msel, j); r2 += ((o > msel) || (o == msel && j < F.lane)) ? 1 : 0; }
        const bool chosen = r2 < 8;
        const float wsum = wave_sum(chosen ? score : 0.f);
        if (chosen) {
            const unsigned pos = atomicAdd(cnt_ptr(F, l, F.lane), 1u);
            F.LIST()[(size_t)F.lane * LIST_CAP + pos] = (unsigned)r | ((unsigned)r2 << 16);
            F.LISTW()[(size_t)F.lane * LIST_CAP + pos] = score / wsum * 2.5f;
        }
    }
}
__device__ __forceinline__ void phase_cmb(Frame& F, int l, int nrows) {
    const int gw = F.bid * NWAVES + F.wave, NGW = F.G * NWAVES;
    for (int r = gw; r < nrows; r += NGW) {
        float* xr = xa_row(F, r);
        f32x4 v[4]; load_row(xr, F.lane, v);
        f32x4 s[4];
#pragma unroll
        for (int j = 0; j < 4; ++j) s[j] = (f32x4){0.f, 0.f, 0.f, 0.f};
        const bf16_t* yb = F.Y2() + (size_t)r * 8 * D;
#pragma unroll
        for (int k = 0; k < 8; ++k)
#pragma unroll
            for (int j = 0; j < 4; ++j) { const u32x2 w = *(const u32x2*)(yb + (size_t)k * D + 4 * F.lane + 256 * j);
                s[j].x += bf_lo(w.x); s[j].y += bf_hi(w.x); s[j].z += bf_lo(w.y); s[j].w += bf_hi(w.y); }
        const float* g2 = mod_ptr(F, l, r, 5);
#pragma unroll
        for (int j = 0; j < 4; ++j) v[j] = v[j] + *(const f32x4*)(g2 + 4 * F.lane + 256 * j) * s[j];
        const float rstd = row_rstd(v);
        if (l == 0) {
#pragma unroll
            for (int j = 0; j < 4; ++j) *(f32x4*)(xr + 4 * F.lane + 256 * j) = v[j];
            f32x4 h[4];
            norm_mod(v, rstd, F.inp(IN_N1G) + D, mod_ptr(F, 1, r, 0), mod_ptr(F, 1, r, 1), F.lane, h);
            store_row_bf16(F.H1() + (size_t)r * D, F.lane, h);
        } else {
#pragma unroll
            for (int j = 0; j < 4; ++j) { const f32x4 gg = *(const f32x4*)(F.inp(IN_FG) + 4 * F.lane + 256 * j); *(f32x4*)(xr + 4 * F.lane + 256 * j) = v[j] * rstd * gg; }
        }
    }
}

struct Unit { int pm, pn, e, lt; };

struct SchedDense {
    const bf16_t* A; const bf16_t* Bt; int K, nM, nN, G, c;
    __device__ __forceinline__ bool next(int i, Unit& u) const {
        const int L = i * G + c; if (L >= nM * nN) return false;
        u.pn = __builtin_amdgcn_readfirstlane(L % nN); u.pm = __builtin_amdgcn_readfirstlane(L / nN); u.e = 0; u.lt = 0; return true;
    }
    __device__ __forceinline__ const bf16_t* a_row(const Unit& u, int r) const { return A + (size_t)(u.pm * 256 + r) * K; }
    __device__ __forceinline__ const bf16_t* b_row(const Unit& u, int c_) const { return Bt + (size_t)(u.pn * 256 + c_) * K; }
    const unsigned char* ws;
    __device__ __forceinline__ unsigned a_off(const Unit& u) const { return (unsigned)((const unsigned char*)A - ws) + (unsigned)u.pm * (unsigned)(512 * K); }
    __device__ __forceinline__ unsigned b_off(const Unit& u) const { return (unsigned)((const unsigned char*)Bt - ws) + (unsigned)u.pn * (unsigned)(512 * K); }
};
struct MoeTab { const int* toff; const int* cnt; };
__device__ __forceinline__ void moe_build_tab(Frame& F, int l, int nrows_shared) {
    int* toff = (int*)(F.lds + TOFF_OFF); int* cnt = toff + 72;
    __syncthreads();
    if (F.tid == 0) { int acc = 0;
        for (int e = 0; e < NE; ++e) { const int c = (int)__hip_atomic_load(cnt_ptr(F, l, e), __ATOMIC_RELAXED, __HIP_MEMORY_SCOPE_AGENT); cnt[e] = c; toff[e] = acc; acc += (c + 255) >> 8; }
        cnt[NE] = nrows_shared; toff[NE] = acc; acc += nrows_shared >> 8; toff[NE + 1] = acc; }
    __syncthreads();
}
__device__ __forceinline__ void moe_find(const MoeTab& T, int tg, Unit& u) {
    int e = 0;
#pragma unroll 1
    for (int j = 1; j <= NE; ++j) e = (T.toff[j] <= tg) ? j : e;
    u.pm = __builtin_amdgcn_readfirstlane(tg); u.e = __builtin_amdgcn_readfirstlane(e); u.lt = __builtin_amdgcn_readfirstlane(tg - T.toff[e]);
}
struct SchedE1 {
    MoeTab T; const unsigned* LIST; const bf16_t* H1; const bf16_t* WGU; const bf16_t* WSH; int G, c;
    __device__ __forceinline__ bool next(int i, Unit& u) const {
        const int L = i * G + c; if (L >= __builtin_amdgcn_readfirstlane(T.toff[NE + 1]) * 2) return false;
        u.pn = __builtin_amdgcn_readfirstlane(L & 1); moe_find(T, L >> 1, u); return true;
    }
    __device__ __forceinline__ int token(const Unit& u, int r) const {
        const int idx = u.lt * 256 + r;
        if (u.e == NE) return idx;
        return idx < T.cnt[u.e] ? (int)(LIST[(size_t)u.e * LIST_CAP + idx] & 0xffffu) : 0;
    }
    __device__ __forceinline__ const bf16_t* a_row(const Unit& u, int r) const { return H1 + (size_t)token(u, r) * D; }
    __device__ __forceinline__ const bf16_t* b_row(const Unit& u, int c_) const { return (u.e == NE ? WSH : WGU + (size_t)u.e * 512 * D) + (size_t)(u.pn * 256 + c_) * D; }
    const unsigned char* ws;
    __device__ __forceinline__ unsigned a_org() const { return (unsigned)((const unsigned char*)H1 - ws); }
    __device__ __forceinline__ unsigned a_rowoff(const Unit& u, int r) const { return (unsigned)token(u, r) * (unsigned)(D * 2); }
    __device__ __forceinline__ unsigned b_off(const Unit& u) const {
        const unsigned sh = (unsigned)((const unsigned char*)WSH - ws), ex = (unsigned)((const unsigned char*)WGU - ws) + (unsigned)u.e * (unsigned)(512 * D * 2);
        return (u.e == NE ? sh : ex) + (unsigned)u.pn * (unsigned)(256 * D * 2); }
};
struct SchedE2 {
    MoeTab T; const bf16_t* HB; const bf16_t* WD; const bf16_t* WSH; int G, c;
    __device__ __forceinline__ bool next(int i, Unit& u) const {
        const int L = i * G + c; if (L >= __builtin_amdgcn_readfirstlane(T.toff[NE + 1]) * 4) return false;
        u.pn = __builtin_amdgcn_readfirstlane(L & 3); moe_find(T, L >> 2, u); return true;
    }
    __device__ __forceinline__ const bf16_t* a_row(const Unit& u, int r) const { return HB + (size_t)(u.pm * 256 + r) * FF; }
    __device__ __forceinline__ const bf16_t* b_row(const Unit& u, int c_) const { return (u.e == NE ? WSH : WD + (size_t)u.e * D * FF) + (size_t)(u.pn * 256 + c_) * FF; }
    const unsigned char* ws;
    __device__ __forceinline__ unsigned a_off(const Unit& u) const { return (unsigned)((const unsigned char*)HB - ws) + (unsigned)u.pm * (unsigned)(256 * FF * 2); }
    __device__ __forceinline__ unsigned b_off(const Unit& u) const {
        const unsigned sh = (unsigned)((const unsigned char*)WSH - ws), ex = (unsigned)((const unsigned char*)WD - ws) + (unsigned)u.e * (unsigned)(D * FF * 2);
        return (u.e == NE ? sh : ex) + (unsigned)u.pn * (unsigned)(256 * FF * 2); }
};

struct EpiG1 {
    bf16_t* Z; const float* ROPE;
    __device__ __forceinline__ void row(const Unit& u, int r, int cbase, const f32x4 (&v)[2][2]) const {
        const int grow = u.pm * 256 + r;
#pragma unroll
        for (int bj = 0; bj < 2; ++bj) {
            const int col0 = u.pn * 256 + bj * 128 + cbase;
            f32x4 a = v[bj][0], b = v[bj][1];
            const bool is_rope = (col0 < VA) && (grow < NLAT);
            if (is_rope) {
                const int t = grow & (SEQ - 1); const int pos = ((col0 & 32) == 0) ? (t >> 6) : (t & 63);
                const int f0 = col0 & 15;
                const f32x4 cs = *(const f32x4*)(ROPE + pos * 16 + f0), sn = *(const f32x4*)(ROPE + 1024 + pos * 16 + f0);
                const f32x4 a2 = a * cs - b * sn, b2 = b * cs + a * sn; a = a2; b = b2;
            }
            if (col0 < KA || (col0 >= QN && col0 < KN)) { a = a * 0.125f; b = b * 0.125f; }
            if (col0 >= UB && col0 < QN) {
                a = (f32x4){gelu_tanh(a.x), gelu_tanh(a.y), gelu_tanh(a.z), gelu_tanh(a.w)};
                b = (f32x4){gelu_tanh(b.x), gelu_tanh(b.y), gelu_tanh(b.z), gelu_tanh(b.w)};
            }
            bf16_t* zr = Z + (size_t)grow * INW + col0;
            u32x2 w0, w1; w0.x = pk2(a.x, a.y); w0.y = pk2(a.z, a.w); w1.x = pk2(b.x, b.y); w1.y = pk2(b.z, b.w);
            *(u32x2*)zr = w0; *(u32x2*)(zr + 16) = w1;
        }
    }
};
struct EpiG2 {
    const float* xlat; const float* xctx; float* out; float* XC; const float* MOD; int l;
    __device__ __forceinline__ void row(const Unit& u, int r, int cbase, const f32x4 (&v)[2][2]) const {
        const int grow = u.pm * 256 + r;
        const float* src = grow < NLAT ? xlat + (size_t)grow * D : xctx + (size_t)(grow - NLAT) * D;
        float* dst = grow < NLAT ? out + (size_t)grow * D : XC + (size_t)(grow - NLAT) * D;
        const float* g1 = MOD + ((size_t)(l * 9 + mod_row(grow)) * 6 + 2) * D;
#pragma unroll
        for (int bj = 0; bj < 2; ++bj)
#pragma unroll
            for (int n = 0; n < 2; ++n) { const int c = u.pn * 256 + bj * 128 + cbase + 16 * n;
                *(f32x4*)(dst + c) = *(const f32x4*)(src + c) + *(const f32x4*)(g1 + c) * v[bj][n]; }
    }
};
struct EpiE1 {
    bf16_t* HB;
    __device__ __forceinline__ void row(const Unit& u, int r, int cbase, const f32x4 (&v)[2][2]) const {
        bf16_t* hr = HB + (size_t)(u.pm * 256 + r) * FF + u.pn * 128 + cbase;
#pragma unroll
        for (int n = 0; n < 2; ++n) { const f32x4 g = v[0][n], up = v[1][n];
            u32x2 w; w.x = pk2(silu_f(g.x) * up.x, silu_f(g.y) * up.y); w.y = pk2(silu_f(g.z) * up.z, silu_f(g.w) * up.w);
            *(u32x2*)(hr + 16 * n) = w; }
    }
};
struct EpiE2 {
    MoeTab T; const unsigned* LIST; const float* LISTW; bf16_t* Y2; float* out; float* XC; const float* MOD; int l;
    __device__ __forceinline__ void row(const Unit& u, int r, int cbase, const f32x4 (&v)[2][2]) const {
        const int idx = u.lt * 256 + r;
        if (u.e == NE) {
            float* dst = idx < NLAT ? out + (size_t)idx * D : XC + (size_t)(idx - NLAT) * D;
            const float* g2 = MOD + ((size_t)(l * 9 + mod_row(idx)) * 6 + 5) * D;
#pragma unroll
            for (int bj = 0; bj < 2; ++bj)
#pragma unroll
                for (int n = 0; n < 2; ++n) { const int c = u.pn * 256 + bj * 128 + cbase + 16 * n;
                    *(f32x4*)(dst + c) = *(const f32x4*)(dst + c) + *(const f32x4*)(g2 + c) * v[bj][n]; }
        } else if (idx < T.cnt[u.e]) {
            const unsigned ent = LIST[(size_t)u.e * LIST_CAP + idx]; const float w = LISTW[(size_t)u.e * LIST_CAP + idx];
            bf16_t* yr = Y2 + ((size_t)(ent & 0xffffu) * 8 + (ent >> 16)) * D + u.pn * 256 + cbase;
#pragma unroll
            for (int bj = 0; bj < 2; ++bj)
#pragma unroll
                for (int n = 0; n < 2; ++n) { const f32x4 x = v[bj][n] * w; u32x2 o; o.x = pk2(x.x, x.y); o.y = pk2(x.z, x.w); *(u32x2*)(yr + bj * 128 + 16 * n) = o; }
        }
    }
};

template <class Sched, class Epi>
__device__ __forceinline__ void gemm_simple(Frame& F, const Sched& S, const Epi& E, int K) {
    float* As = (float*)F.lds;
    float* Bs = (float*)(F.lds + 32 * 132 * 4);
    const int tid = F.tid, cg = tid & 15, rg = tid >> 4, wc = cg >> 2, fq = cg & 3, cbase = 32 * wc + 4 * fq;
    Unit u;
    for (int i = 0; S.next(i, u); ++i) {
        const bf16_t* bp = S.b_row(u, tid >> 1) + 16 * (tid & 1);
        for (int ai = 0; ai < 2; ++ai) {
            const bf16_t* ap = S.a_row(u, ai * 128 + (tid >> 2)) + 8 * (tid & 3);
            f32x4 acc[4][2][2];
#pragma unroll
            for (int a = 0; a < 4; ++a)
#pragma unroll
                for (int b = 0; b < 2; ++b)
#pragma unroll
                    for (int n = 0; n < 2; ++n) acc[a][b][n] = (f32x4){0.f, 0.f, 0.f, 0.f};
            for (int k0 = 0; k0 < K; k0 += 32) {
                const u32x4 wa = *(const u32x4*)(ap + k0);
                const u32x4 wb0 = *(const u32x4*)(bp + k0), wb1 = *(const u32x4*)(bp + k0 + 8);
                __syncthreads();
                { const int row = tid >> 2, kc = 8 * (tid & 3);
                  As[(kc + 0) * 132 + row] = bf_lo(wa.x); As[(kc + 1) * 132 + row] = bf_hi(wa.x); As[(kc + 2) * 132 + row] = bf_lo(wa.y); As[(kc + 3) * 132 + row] = bf_hi(wa.y);
                  As[(kc + 4) * 132 + row] = bf_lo(wa.z); As[(kc + 5) * 132 + row] = bf_hi(wa.z); As[(kc + 6) * 132 + row] = bf_lo(wa.w); As[(kc + 7) * 132 + row] = bf_hi(wa.w); }
                { const int col = tid >> 1, kc = 16 * (tid & 1);
                  Bs[(kc + 0) * 260 + col] = bf_lo(wb0.x); Bs[(kc + 1) * 260 + col] = bf_hi(wb0.x); Bs[(kc + 2) * 260 + col] = bf_lo(wb0.y); Bs[(kc + 3) * 260 + col] = bf_hi(wb0.y);
                  Bs[(kc + 4) * 260 + col] = bf_lo(wb0.z); Bs[(kc + 5) * 260 + col] = bf_hi(wb0.z); Bs[(kc + 6) * 260 + col] = bf_lo(wb0.w); Bs[(kc + 7) * 260 + col] = bf_hi(wb0.w);
                  Bs[(kc + 8) * 260 + col] = bf_lo(wb1.x); Bs[(kc + 9) * 260 + col] = bf_hi(wb1.x); Bs[(kc + 10) * 260 + col] = bf_lo(wb1.y); Bs[(kc + 11) * 260 + col] = bf_hi(wb1.y);
                  Bs[(kc + 12) * 260 + col] = bf_lo(wb1.z); Bs[(kc + 13) * 260 + col] = bf_hi(wb1.z); Bs[(kc + 14) * 260 + col] = bf_lo(wb1.w); Bs[(kc + 15) * 260 + col] = bf_hi(wb1.w); }
                __syncthreads();
#pragma unroll 4
                for (int kk = 0; kk < 32; ++kk) {
                    const f32x4 a = *(const f32x4*)(As + kk * 132 + 4 * rg);
                    f32x4 b[2][2];
#pragma unroll
                    for (int bj = 0; bj < 2; ++bj)
#pragma unroll
                        for (int n = 0; n < 2; ++n) b[bj][n] = *(const f32x4*)(Bs + kk * 260 + 128 * bj + cbase + 16 * n);
#pragma unroll
                    for (int bj = 0; bj < 2; ++bj)
#pragma unroll
                        for (int n = 0; n < 2; ++n) { acc[0][bj][n] += a.x * b[bj][n]; acc[1][bj][n] += a.y * b[bj][n]; acc[2][bj][n] += a.z * b[bj][n]; acc[3][bj][n] += a.w * b[bj][n]; }
                }
            }
#pragma unroll
            for (int a = 0; a < 4; ++a) E.row(u, ai * 128 + 4 * rg + a, cbase, acc[a]);
        }
    }
    __syncthreads();
}


namespace pg8 {
typedef short bf16x8 __attribute__((ext_vector_type(8)));
constexpr int BM = 256, BK = 64, HALF = 128, HTB = HALF * BK * 2, STAGE_BYTES = 8 * HTB;
__device__ __forceinline__ int lds_byte(int r, int c) { const int st = (r >> 4) * 2 + (c >> 5), rr = r & 15, cc = c & 31, ob = rr * 64 + cc * 2; return st * 1024 + (ob ^ (((ob >> 9) & 1) << 5)); }
__device__ __forceinline__ void stage_rc(int b, int& R, int& C) { const int st = b / 1024, sb = b % 1024, swz = sb ^ (((sb >> 9) & 1) << 5); R = (st >> 1) * 16 + swz / 64; C = (st & 1) * 32 + (swz % 64) / 2; }

template <class Sched, class REpi, bool GATHER, bool ALIGN_EPI, bool SP2>
__device__ __forceinline__ void gemm_phase(LAS unsigned char* lds, const unsigned char* wsbase, const Sched& S, const REpi& RE, const int K, const int tid, const int wid) {
    const int lane = tid & 63, wr = wid >> 2, wc = wid & 3, fr = lane & 15, fq = lane >> 4;
    const int nt = K / BK;
    const __amdgpu_buffer_rsrc_t rsrc = __builtin_amdgcn_make_buffer_rsrc((void*)wsbase, 0, 0x7fffffff, 0x00020000);
    int R0, C0; stage_rc(tid * 16, R0, C0);
    const unsigned vo0 = (unsigned)(R0 * K + C0) * 2u, vo1 = (unsigned)((R0 + 64) * K + C0) * 2u;
    const unsigned kstep = (unsigned)(BK * 2), hstep = (unsigned)(HALF * K * 2);
    const unsigned ldsw = (unsigned)wid * 1024u;
    const int aoff = lds_byte(wr * 64 + fr, fq * 8), boff = lds_byte(wc * 32 + fr, fq * 8);
#define PG8_SA(b, h) (((b) * 2 + (h)) * HTB)
#define PG8_SB(b, h) ((4 + (b) * 2 + (h)) * HTB)
#define PG8_STAGE2(bufoff, soff, o0, o1) do { \
        const int _so = __builtin_amdgcn_readfirstlane((int)(soff)); \
        __builtin_amdgcn_raw_ptr_buffer_load_lds(rsrc, (LAS void*)(lds + (bufoff) + ldsw), 16, (int)(o0), _so, 0, 0); \
        __builtin_amdgcn_raw_ptr_buffer_load_lds(rsrc, (LAS void*)(lds + (bufoff) + ldsw + 8192), 16, (int)(o1), _so, 0, 0); } while (0)
#define PG8_STAGEB(bufoff, soff) PG8_STAGE2(bufoff, soff, vo0, vo1)
#define PG8_STAGEA(bufoff, soff, h, G) do { if constexpr (GATHER) PG8_STAGE2(bufoff, soff, (G)[h][0], (G)[h][1]); else PG8_STAGE2(bufoff, (soff) + (h) * hstep, vo0, vo1); } while (0)
#define PG8_LDA(dst, b, h) do { _Pragma("unroll") for (int m = 0; m < 4; ++m) _Pragma("unroll") for (int k = 0; k < 2; ++k) dst[m][k] = *(const LAS bf16x8*)(lds + PG8_SA(b, h) + aoff + m * 2048 + k * 1024); } while (0)
#define PG8_LDB(dst, b, h) do { _Pragma("unroll") for (int n = 0; n < 2; ++n) _Pragma("unroll") for (int k = 0; k < 2; ++k) dst[n][k] = *(const LAS bf16x8*)(lds + PG8_SB(b, h) + boff + n * 2048 + k * 1024); } while (0)
#define PG8_MMA(ai, bj, At, Bt) do { __builtin_amdgcn_s_setprio(1); _Pragma("unroll") for (int m = 0; m < 4; ++m) _Pragma("unroll") for (int n = 0; n < 2; ++n) _Pragma("unroll") for (int k = 0; k < 2; ++k) \
        acc[ai][bj][m][n] = __builtin_amdgcn_mfma_f32_16x16x32_bf16(Bt[n][k], At[m][k], acc[ai][bj][m][n], 0, 0, 0); __builtin_amdgcn_s_setprio(0); } while (0)
#define PG8_WAIT_V(n) asm volatile("s_waitcnt vmcnt(" #n ")" ::: "memory")
#define PG8_WAIT_L(n) asm volatile("s_waitcnt lgkmcnt(" #n ")" ::: "memory")
#define PG8_BAR __builtin_amdgcn_s_barrier()
#define PG8_SCHED __builtin_amdgcn_sched_barrier(0)
    Unit cur, nxt; int ui = 0;
    if (!S.next(0, cur)) return;
    f32x4 acc[2][2][4][2];
#pragma unroll
    for (int a = 0; a < 2; ++a)
#pragma unroll
        for (int b = 0; b < 2; ++b)
#pragma unroll
            for (int m = 0; m < 4; ++m)
#pragma unroll
                for (int n = 0; n < 2; ++n) acc[a][b][m][n] = (f32x4){0.f, 0.f, 0.f, 0.f};
    bf16x8 At[4][2], B0[2][2], B1[2][2];
    unsigned gc[2][2], gn[2][2];
    unsigned cA, cB = S.b_off(cur);
    if constexpr (GATHER) { cA = S.a_org();
#pragma unroll
        for (int h = 0; h < 2; ++h)
#pragma unroll
            for (int i = 0; i < 2; ++i) gc[h][i] = S.a_rowoff(cur, h * HALF + R0 + 64 * i) + (unsigned)C0 * 2u;
        asm volatile("s_waitcnt vmcnt(0) lgkmcnt(0)" : "+v"(gc[0][0]), "+v"(gc[0][1]), "+v"(gc[1][0]), "+v"(gc[1][1]) :: "memory");
    } else { cA = S.a_off(cur); gc[0][0] = gc[0][1] = gc[1][0] = gc[1][1] = 0u; }
    if constexpr (SP2) {
        PG8_STAGEB(PG8_SB(0, 0), cB); PG8_STAGEB(PG8_SB(0, 1), cB + hstep); PG8_STAGEA(PG8_SA(0, 0), cA, 0, gc); PG8_STAGEA(PG8_SA(0, 1), cA, 1, gc);
        if (wr == 1) PG8_BAR;
        PG8_WAIT_V(2); PG8_BAR;
        PG8_STAGEB(PG8_SB(1, 0), cB + kstep); PG8_STAGEA(PG8_SA(1, 0), cA + kstep, 0, gc); PG8_STAGEB(PG8_SB(1, 1), cB + hstep + kstep);
        PG8_WAIT_V(6); PG8_BAR;
    } else {
        PG8_STAGEB(PG8_SB(0, 0), cB); PG8_STAGEA(PG8_SA(0, 0), cA, 0, gc); PG8_STAGEB(PG8_SB(0, 1), cB + hstep); PG8_STAGEA(PG8_SA(0, 1), cA, 1, gc);
        if (wr == 1) PG8_BAR;
        PG8_WAIT_V(4); PG8_BAR;
        PG8_STAGEB(PG8_SB(1, 0), cB + kstep); PG8_STAGEA(PG8_SA(1, 0), cA + kstep, 0, gc); PG8_STAGEB(PG8_SB(1, 1), cB + hstep + kstep);
        PG8_WAIT_V(6); PG8_BAR;
    }
    for (;;) {
        const bool has_next = S.next(ui + 1, nxt);
        unsigned nA; const unsigned nB = has_next ? S.b_off(nxt) : cB;
        if constexpr (GATHER) { nA = cA;
#pragma unroll
            for (int h = 0; h < 2; ++h)
#pragma unroll
                for (int i = 0; i < 2; ++i) gn[h][i] = has_next ? S.a_rowoff(nxt, h * HALF + R0 + 64 * i) + (unsigned)C0 * 2u : gc[h][i];
            asm volatile("s_waitcnt vmcnt(0) lgkmcnt(0)" : "+v"(gn[0][0]), "+v"(gn[0][1]), "+v"(gn[1][0]), "+v"(gn[1][1]) :: "memory");
        } else { nA = has_next ? S.a_off(nxt) : cA; }
#pragma unroll 1
        for (int t = 0; t < nt; t += 2) {
            const bool last = (t == nt - 2);
            const unsigned a1 = cA + (unsigned)(t + 1) * kstep;
            unsigned a2; const unsigned b2 = last ? nB : cB + (unsigned)(t + 2) * kstep;
            unsigned g2[2][2];
            if constexpr (GATHER) { a2 = last ? cA : cA + (unsigned)(t + 2) * kstep;
#pragma unroll
                for (int h = 0; h < 2; ++h)
#pragma unroll
                    for (int i = 0; i < 2; ++i) g2[h][i] = last ? gn[h][i] : gc[h][i];
            } else { a2 = last ? nA : cA + (unsigned)(t + 2) * kstep; g2[0][0] = g2[0][1] = g2[1][0] = g2[1][1] = 0u; }
            const unsigned a3 = a2 + kstep, b3 = b2 + kstep;
            if constexpr (SP2) {
            PG8_LDB(B0, 0, 0); PG8_LDB(B1, 0, 1); PG8_SCHED; PG8_LDA(At, 0, 0); PG8_STAGEA(PG8_SA(1, 1), a1, 1, gc);
            PG8_WAIT_V(8); PG8_WAIT_L(0); PG8_BAR; PG8_MMA(0, 0, At, B0); PG8_MMA(0, 1, At, B1); PG8_BAR; PG8_SCHED;
            PG8_LDA(At, 0, 1); PG8_STAGEB(PG8_SB(0, 0), b2); PG8_STAGEB(PG8_SB(0, 1), b2 + hstep); PG8_STAGEA(PG8_SA(0, 0), a2, 0, g2);
            PG8_WAIT_V(8); PG8_WAIT_L(0); PG8_BAR; PG8_MMA(1, 0, At, B0); PG8_MMA(1, 1, At, B1); PG8_BAR; PG8_SCHED;
            PG8_LDB(B0, 1, 0); PG8_LDB(B1, 1, 1); PG8_SCHED; PG8_LDA(At, 1, 0); PG8_STAGEA(PG8_SA(0, 1), a2, 1, g2);
            PG8_WAIT_V(8); PG8_WAIT_L(0); PG8_BAR; PG8_MMA(0, 0, At, B0); PG8_MMA(0, 1, At, B1); PG8_BAR; PG8_SCHED;
            PG8_LDA(At, 1, 1); PG8_STAGEB(PG8_SB(1, 0), b3); PG8_STAGEB(PG8_SB(1, 1), b3 + hstep); PG8_STAGEA(PG8_SA(1, 0), a3, 0, g2);
            PG8_WAIT_V(8); PG8_WAIT_L(0); PG8_BAR; PG8_MMA(1, 0, At, B0); PG8_MMA(1, 1, At, B1); PG8_BAR; PG8_SCHED;
            } else {
            PG8_LDB(B0, 0, 0); PG8_SCHED; PG8_LDA(At, 0, 0); PG8_STAGEA(PG8_SA(1, 1), a1, 1, gc);
            PG8_WAIT_L(8); PG8_BAR; PG8_WAIT_L(0); PG8_MMA(0, 0, At, B0); PG8_BAR; PG8_SCHED;
            PG8_LDB(B1, 0, 1); PG8_STAGEB(PG8_SB(0, 0), b2);
            PG8_BAR; PG8_WAIT_L(0); PG8_MMA(0, 1, At, B1); PG8_BAR;
            PG8_LDA(At, 0, 1); PG8_STAGEA(PG8_SA(0, 0), a2, 0, g2);
            PG8_BAR; PG8_WAIT_L(0); PG8_MMA(1, 0, At, B0); PG8_BAR; PG8_SCHED;
            PG8_STAGEB(PG8_SB(0, 1), b2 + hstep);
            PG8_WAIT_V(6); PG8_BAR; PG8_MMA(1, 1, At, B1); PG8_BAR;
            PG8_LDB(B0, 1, 0); PG8_SCHED; PG8_LDA(At, 1, 0); PG8_STAGEA(PG8_SA(0, 1), a2, 1, g2);
            PG8_WAIT_L(8); PG8_BAR; PG8_WAIT_L(0); PG8_MMA(0, 0, At, B0); PG8_BAR; PG8_SCHED;
            PG8_LDB(B1, 1, 1); PG8_STAGEB(PG8_SB(1, 0), b3);
            PG8_BAR; PG8_WAIT_L(0); PG8_MMA(0, 1, At, B1); PG8_BAR;
            PG8_LDA(At, 1, 1); PG8_STAGEA(PG8_SA(1, 0), a3, 0, g2);
            PG8_BAR; PG8_WAIT_L(0); PG8_MMA(1, 0, At, B0); PG8_BAR; PG8_SCHED;
            PG8_STAGEB(PG8_SB(1, 1), b3 + hstep);
            PG8_WAIT_V(6); PG8_BAR; PG8_MMA(1, 1, At, B1); PG8_BAR;
            }
        }
        if constexpr (ALIGN_EPI) { if (wr == 0) PG8_BAR; }
        {
#pragma unroll
            for (int ai = 0; ai < 2; ++ai)
#pragma unroll
                for (int m = 0; m < 4; ++m) { const f32x4 v[2][2] = {{acc[ai][0][m][0], acc[ai][0][m][1]}, {acc[ai][1][m][0], acc[ai][1][m][1]}};
                    RE.row(cur, ai * HALF + wr * 64 + m * 16 + fr, wc * 32 + 4 * fq, v); asm volatile("" ::: "memory"); }
        }
        if (!has_next) break;
#pragma unroll
        for (int a = 0; a < 2; ++a)
#pragma unroll
            for (int b = 0; b < 2; ++b)
#pragma unroll
                for (int m = 0; m < 4; ++m)
#pragma unroll
                    for (int n = 0; n < 2; ++n) acc[a][b][m][n] = (f32x4){0.f, 0.f, 0.f, 0.f};
        cur = nxt; cA = nA; cB = nB; ++ui;
        if constexpr (GATHER) {
#pragma unroll
            for (int h = 0; h < 2; ++h)
#pragma unroll
                for (int i = 0; i < 2; ++i) gc[h][i] = gn[h][i];
        }
        if constexpr (ALIGN_EPI) { if (wr == 1) PG8_BAR; }
    }
    PG8_WAIT_V(0);
    if constexpr (!ALIGN_EPI) { if (wr == 0) PG8_BAR; }
    PG8_BAR;
#undef PG8_SA
#undef PG8_SB
#undef PG8_STAGE2
#undef PG8_STAGEB
#undef PG8_STAGEA
#undef PG8_LDA
#undef PG8_LDB
#undef PG8_MMA
#undef PG8_WAIT_V
#undef PG8_WAIT_L
#undef PG8_BAR
#undef PG8_SCHED
}
}
#ifndef MK_SP2
#define MK_SP2 true
#endif
#ifndef MK_ALIGN
#define MK_ALIGN true
#endif
#ifndef MK_MFMA
#define MK_MFMA 0xF
#endif
template <bool GATHER, class Sched, class Epi>
__device__ __forceinline__ void run_gemm(Frame& F, bool mfma, const Sched& S, const Epi& E, int K) {
    if (mfma) pg8::gemm_phase<Sched, Epi, GATHER, MK_ALIGN, MK_SP2>((LAS unsigned char*)F.lds, F.wsb(), S, E, K, F.tid, F.wave);
    else gemm_simple(F, S, E, K);
}

__device__ __forceinline__ void load_q64(const bf16_t* p, float (&q)[64]) {
#pragma unroll
    for (int c = 0; c < 8; ++c) { const u32x4 w = *(const u32x4*)(p + 8 * c);
        q[8 * c + 0] = bf_lo(w.x); q[8 * c + 1] = bf_hi(w.x); q[8 * c + 2] = bf_lo(w.y); q[8 * c + 3] = bf_hi(w.y);
        q[8 * c + 4] = bf_lo(w.z); q[8 * c + 5] = bf_hi(w.z); q[8 * c + 6] = bf_lo(w.w); q[8 * c + 7] = bf_hi(w.w); }
}
__device__ __forceinline__ void attn_key(const float (&q)[64], const bf16_t* kp, const bf16_t* vp, float bias, float& m, float& l, float (&o)[64]) {
    float s0 = bias, s1 = 0.f;
#pragma unroll
    for (int c = 0; c < 8; ++c) { const u32x4 w = *(const u32x4*)(kp + 8 * c);
        s0 += q[8 * c + 0] * bf_lo(w.x) + q[8 * c + 2] * bf_lo(w.y) + q[8 * c + 4] * bf_lo(w.z) + q[8 * c + 6] * bf_lo(w.w);
        s1 += q[8 * c + 1] * bf_hi(w.x) + q[8 * c + 3] * bf_hi(w.y) + q[8 * c + 5] * bf_hi(w.z) + q[8 * c + 7] * bf_hi(w.w); }
    const float s = s0 + s1;
    const float mn = fmaxf(m, s), sc = __expf(m - mn), p = __expf(s - mn);
    l = l * sc + p; m = mn;
#pragma unroll
    for (int c = 0; c < 8; ++c) { const u32x4 w = *(const u32x4*)(vp + 8 * c);
        o[8 * c + 0] = o[8 * c + 0] * sc + p * bf_lo(w.x); o[8 * c + 1] = o[8 * c + 1] * sc + p * bf_hi(w.x);
        o[8 * c + 2] = o[8 * c + 2] * sc + p * bf_lo(w.y); o[8 * c + 3] = o[8 * c + 3] * sc + p * bf_hi(w.y);
        o[8 * c + 4] = o[8 * c + 4] * sc + p * bf_lo(w.z); o[8 * c + 5] = o[8 * c + 5] * sc + p * bf_hi(w.z);
        o[8 * c + 6] = o[8 * c + 6] * sc + p * bf_lo(w.w); o[8 * c + 7] = o[8 * c + 7] * sc + p * bf_hi(w.w); }
}
__device__ __forceinline__ void attn_finish(Frame& F, int r, int ycol, int slot, float l, float (&o)[64]) {
    const float inv = 1.0f / l; float ss = 0.f;
    bf16_t* yp = F.Y() + (size_t)r * D + ycol;
#pragma unroll
    for (int c = 0; c < 8; ++c) { float t[8];
#pragma unroll
        for (int j = 0; j < 8; ++j) { t[j] = o[8 * c + j] * inv; ss += t[j] * t[j]; }
        u32x4 w; w.x = pk2(t[0], t[1]); w.y = pk2(t[2], t[3]); w.z = pk2(t[4], t[5]); w.w = pk2(t[6], t[7]);
        *(u32x4*)(yp + 8 * c) = w; }
    F.SSQ()[(size_t)r * 16 + slot] = ss;
}
__device__ __forceinline__ void attn_item(Frame& F, int l, int variant, int qb, int h) {
    const bool latent = variant < 2; const bool isA = (variant == 0 || variant == 2);
    const int r = (latent ? 0 : NLAT) + qb * NTHR + F.tid;
    const int b = latent ? (r >> 11) : ((r - NLAT) >> 8);
    const int qcol = isA ? QA + 64 * h : QN + 64 * h;
    const int kcol = isA ? KA + 64 * (h / 3) : KN + 64 * h, vcol = isA ? VA + 64 * (h / 3) : VN + 64 * h;
    float q[64], o[64];
    load_q64(F.Z() + (size_t)r * INW + qcol, q);
#pragma unroll
    for (int i = 0; i < 64; ++i) o[i] = 0.f;
    float m, ls;
    if (isA) { m = F.inp(IN_SINK)[l * 6 + h]; ls = 1.0f; } else { m = NEGF; ls = 0.f; }
    const bf16_t* zc = F.Z() + (size_t)(NLAT + b * CTXL) * INW;
#pragma unroll 1
    for (int c = 0; c < CTXL; ++c) attn_key(q, zc + (size_t)c * INW + kcol, zc + (size_t)c * INW + vcol, 0.f, m, ls, o);
    if (variant == 0) {
        const int t = r & (SEQ - 1); const int lo = max(0, t - 128), hi = min(SEQ - 1, t + 128);
        const bf16_t* zb = F.Z() + (size_t)(b * SEQ) * INW;
#pragma unroll 1
        for (int kp = lo; kp <= hi; ++kp) attn_key(q, zb + (size_t)kp * INW + kcol, zb + (size_t)kp * INW + vcol, 0.f, m, ls, o);
    } else if (variant == 1) {
        const int t = r & (SEQ - 1), row = t >> 6, col = t & 63;
        const int rs = min(max(row - 4, 0), 24), cs = min(max(col - 8, 0), 48);
        const bf16_t* zb = F.Z() + (size_t)(b * SEQ) * INW;
        const float* rpb = F.inp(IN_RPB) + (size_t)(l * 6 + h) * 15 * 31;
#pragma unroll 1
        for (int j = 0; j < 8; ++j)
#pragma unroll 1
            for (int cc = 0; cc < 16; ++cc) { const int kr = rs + j, kc = cs + cc; const size_t ko = (size_t)(kr * 64 + kc) * INW;
                const float bias = rpb[(kr - row + 7) * 31 + (kc - col + 15)];
                attn_key(q, zb + ko + kcol, zb + ko + vcol, bias, m, ls, o); }
    }
    attn_finish(F, r, (isA ? 0 : 640) + 64 * h, (isA ? 0 : 10) + h, ls, o);
}
__device__ __forceinline__ void sgu_item(Frame& F, int l, int ch, int g) {
    float* vg = (float*)F.lds;
    const int row0 = ch < 128 ? ch * 128 : NLAT + (ch - 128) * 128;
    const int p = F.tid >> 2, dq = F.tid & 3;
    __syncthreads();
    {
        const bf16_t* zp = F.Z() + (size_t)(row0 + p) * INW + VB + 64 * g + 16 * dq;
        const u32x4 w0 = *(const u32x4*)zp, w1 = *(const u32x4*)(zp + 8);
        float t[16] = {bf_lo(w0.x), bf_hi(w0.x), bf_lo(w0.y), bf_hi(w0.y), bf_lo(w0.z), bf_hi(w0.z), bf_lo(w0.w), bf_hi(w0.w),
                       bf_lo(w1.x), bf_hi(w1.x), bf_lo(w1.y), bf_hi(w1.y), bf_lo(w1.z), bf_hi(w1.z), bf_lo(w1.w), bf_hi(w1.w)};
        float ss = 0.f;
#pragma unroll
        for (int i = 0; i < 16; ++i) ss += t[i] * t[i];
        ss += __shfl_xor(ss, 1); ss += __shfl_xor(ss, 2);
        const float rstd = 1.0f / sqrtf(ss * (1.0f / 64.0f) + EPS);
        const float* ng = F.inp(IN_SGUG) + l * 256 + 64 * g + 16 * dq;
#pragma unroll
        for (int i = 0; i < 16; ++i) vg[p * 65 + 16 * dq + i] = t[i] * rstd * ng[i];
    }
    __syncthreads();
    float acc[16];
#pragma unroll
    for (int i = 0; i < 16; ++i) acc[i] = 0.f;
    const float* ws = F.inp(IN_SGUW) + ((size_t)(l * 4 + g) * 128 + p) * 128;
#pragma unroll 4
    for (int qq = 0; qq < 128; ++qq) { const float w = ws[qq];
#pragma unroll
        for (int i = 0; i < 16; ++i) acc[i] += w * vg[qq * 65 + 16 * dq + i]; }
    const float bs = F.inp(IN_SGUB)[(l * 4 + g) * 128 + p];
    const bf16_t* up = F.Z() + (size_t)(row0 + p) * INW + UB + 64 * g + 16 * dq;
    const u32x4 u0 = *(const u32x4*)up, u1 = *(const u32x4*)(up + 8);
    const float uu[16] = {bf_lo(u0.x), bf_hi(u0.x), bf_lo(u0.y), bf_hi(u0.y), bf_lo(u0.z), bf_hi(u0.z), bf_lo(u0.w), bf_hi(u0.w),
                          bf_lo(u1.x), bf_hi(u1.x), bf_lo(u1.y), bf_hi(u1.y), bf_lo(u1.z), bf_hi(u1.z), bf_lo(u1.w), bf_hi(u1.w)};
    float ss = 0.f;
#pragma unroll
    for (int i = 0; i < 16; ++i) { acc[i] = uu[i] * (acc[i] + bs); ss += acc[i] * acc[i]; }
    ss += __shfl_xor(ss, 1); ss += __shfl_xor(ss, 2);
    bf16_t* yp = F.Y() + (size_t)(row0 + p) * D + 384 + 64 * g + 16 * dq;
    u32x4 o0, o1; o0.x = pk2(acc[0], acc[1]); o0.y = pk2(acc[2], acc[3]); o0.z = pk2(acc[4], acc[5]); o0.w = pk2(acc[6], acc[7]);
    o1.x = pk2(acc[8], acc[9]); o1.y = pk2(acc[10], acc[11]); o1.z = pk2(acc[12], acc[13]); o1.w = pk2(acc[14], acc[15]);
    *(u32x4*)yp = o0; *(u32x4*)(yp + 8) = o1;
    if (dq == 0) F.SSQ()[(size_t)(row0 + p) * 16 + 6 + g] = ss;
}
__device__ __forceinline__ void phase_mix(Frame& F, int l) {
    const int nA = 192, nC = 192, nS = 512, nAc = (l == 0) ? 24 : 0, nCc = nAc, nSc = (l == 0) ? 64 : 0;
    const int total = nA + nC + nS + nAc + nCc + nSc;
    for (int it = F.bid; it < total; it += F.G) {
        int r = it;
        if (r < nA) { attn_item(F, l, 0, r / 6, r % 6); continue; } r -= nA;
        if (r < nC) { attn_item(F, l, 1, r / 6, r % 6); continue; } r -= nC;
        if (r < nS) { sgu_item(F, l, r >> 2, r & 3); continue; } r -= nS;
        if (r < nAc) { attn_item(F, l, 2, r / 6, r % 6); continue; } r -= nAc;
        if (r < nCc) { attn_item(F, l, 3, r / 6, r % 6); continue; } r -= nCc;
        sgu_item(F, l, 128 + (r >> 2), r & 3);
    }
    __syncthreads();
}

__global__ void __launch_bounds__(NTHR, 2) mk_fwd(Params P) {
    extern __shared__ __attribute__((aligned(16))) unsigned char lds[];
    Frame F;
    F.lds = lds; F.tid = threadIdx.x; F.lane = F.tid & 63; F.wave = __builtin_amdgcn_readfirstlane(F.tid >> 6); F.bid = blockIdx.x; F.G = gridDim.x;
    F.P = &P;
    volatile LAS unsigned* MISC = (volatile LAS unsigned*)((LAS unsigned char*)lds + MISC_OFF);
    for (int u = F.tid; u < (LDS_BYTES - RING_BYTES) / 4; u += NTHR) ((LAS unsigned*)((LAS unsigned char*)lds + RING_BYTES))[u] = 0u;
    __syncthreads();
    XcdBarrier bar = xcd_barrier_post(F.ctl() + CW_BAR, MISC + 8);
#define LAUNDER() do { asm volatile("" : "+v"(F.tid)); asm volatile("" : "+v"(F.lane)); asm volatile("" : "+s"(F.bid)); asm volatile("" : "+s"(F.wave)); } while (0)

#pragma unroll 1
    for (int ph = 0; ph < 18; ++ph) {
        LAUNDER();
        const int l = ph < 2 ? 0 : (ph - 2) >> 3;
        const int k = ph < 2 ? ph - 2 : (ph - 2) & 7;
        const int nrows = (l == 0) ? NTOK : NLAT;
        if (k == -2) p0_prologue(F);
        else if (k == -1) phase_r1(F, 0);
        else if (k == 0) {
            SchedDense S{F.H1(), F.WIN() + (size_t)l * INW * D, D, NTOK / 256, INW / 256, F.G, F.bid, F.wsb()};
            EpiG1 E{F.Z(), F.ROPE()};
            run_gemm<false>(F, (MK_MFMA & 1) != 0, S, E, D);
            if (l == 1) conv_experts(F, 1);
        } else if (k == 1) phase_mix(F, l);
        else if (k == 2) phase_nrm(F, l, nrows);
        else if (k == 3) {
            SchedDense S{F.Y(), F.WOUT() + (size_t)l * D * D, D, nrows / 256, D / 256, F.G, F.bid, F.wsb()};
            EpiG2 E{l == 0 ? F.inp(IN_X) : F.outp(), l == 0 ? F.inp(IN_CTX) : F.XC(), F.outp(), F.XC(), F.MOD(), l};
            run_gemm<false>(F, (MK_MFMA & 2) != 0, S, E, D);
        } else if (k == 4) phase_r2(F, l, nrows);
        else if (k == 5) {
            moe_build_tab(F, l, nrows);
            const MoeTab T{(const int*)(F.lds + TOFF_OFF), (const int*)(F.lds + TOFF_OFF) + 72};
            SchedE1 S{T, F.LIST(), F.H1(), F.WEXPGU(), F.WSHGU() + (size_t)l * 512 * D, F.G, F.bid, F.wsb()};
            EpiE1 E{F.HB()};
            run_gemm<true>(F, (MK_MFMA & 4) != 0, S, E, D);
        } else if (k == 6) {
            moe_build_tab(F, l, nrows);
            const MoeTab T{(const int*)(F.lds + TOFF_OFF), (const int*)(F.lds + TOFF_OFF) + 72};
            SchedE2 S{T, F.HB(), F.WEXPD(), F.WSHD() + (size_t)l * D * FF, F.G, F.bid, F.wsb()};
            EpiE2 E{T, F.LIST(), F.LISTW(), F.Y2(), F.outp(), F.XC(), F.MOD(), l};
            run_gemm<false>(F, (MK_MFMA & 8) != 0, S, E, FF);
        } else phase_cmb(F, l, nrows);
        if (ph != 17) xcd_barrier(bar);
    }
}

extern "C" void kernel_launch(void* const* d_in, const int* in_sizes, int n_in, void* d_out, int out_size, void* d_ws, size_t ws_size, hipStream_t stream) {
    static int grid = 0;
    if (grid == 0) {
        if (n_in != N_IN || in_sizes[0] != NLAT * D || out_size != NLAT * D || ws_size < WS_END) {
            fprintf(stderr, "kernel_launch: unexpected shapes / workspace (n_in %d, in0 %d, out %d, ws %zu need %zu); nothing launched\n", n_in, n_in > 0 ? in_sizes[0] : -1, out_size, ws_size, (size_t)WS_END);
            grid = -1; return; }
        int dev = 0, cus = 0, per_cu = 0;
        if (hipGetDevice(&dev) != hipSuccess || hipDeviceGetAttribute(&cus, hipDeviceAttributeMultiprocessorCount, dev) != hipSuccess) { grid = -1; return; }
        if (hipFuncSetAttribute((const void*)mk_fwd, hipFuncAttributeMaxDynamicSharedMemorySize, LDS_BYTES) != hipSuccess) { fprintf(stderr, "kernel_launch: hipFuncSetAttribute failed\n"); grid = -1; return; }
        if (hipOccupancyMaxActiveBlocksPerMultiprocessor(&per_cu, (const void*)mk_fwd, NTHR, LDS_BYTES) != hipSuccess || per_cu < 1) { fprintf(stderr, "kernel_launch: occupancy query says %d blocks/CU; nothing launched\n", per_cu); grid = -1; return; }
        (void)hipGetLastError();
        grid = cus;
    }
    if (grid < 0) return;
    if (hipMemsetAsync((char*)d_ws + WS_CTL, 0, CTL_ZERO_BYTES, stream) != hipSuccess) return;
    Params p{};
    for (int i = 0; i < N_IN; ++i) p.in[i] = (const float*)d_in[i];
    p.out = (float*)d_out; p.ws = (unsigned char*)d_ws;
    hipLaunchKernelGGL(mk_fwd, dim3(grid), dim3(NTHR), LDS_BYTES, stream, p);
}
```

```cpp
#include <hip/hip_runtime.h>
#include <cstdio>
#include <cstdint>

#define LAS __attribute__((address_space(3)))
typedef unsigned short bf16_t;
typedef float f32x4 __attribute__((ext_vector_type(4)));
typedef float f32x2 __attribute__((ext_vector_type(2)));
typedef unsigned u32x4 __attribute__((ext_vector_type(4)));
typedef unsigned u32x2 __attribute__((ext_vector_type(2)));
typedef __bf16 bf16x2_t __attribute__((ext_vector_type(2)));

constexpr int D = 1024, NB = 8, SEQ = 2048, CTXL = 256, HD = 64, INW = 2304, NE = 64, FF = 256, DEPTH = 2;
constexpr int NLAT = NB * SEQ, NCTX = NB * CTXL, NTOK = NLAT + NCTX;
constexpr int QA = 0, KA = 384, VA = 512, UB = 640, VB = 896, QN = 1152, KN = 1536, VN = 1920;
constexpr float EPS = 1e-6f, NEGF = -1e30f;
constexpr int NWAVES = 8, NTHR = 512;
enum { IN_X = 0, IN_C, IN_CTX, IN_CCTX, IN_MODW, IN_MODB, IN_N1G, IN_WIN, IN_SINK, IN_SGUG, IN_SGUW, IN_SGUB, IN_RPB, IN_GNG, IN_WOUT, IN_N2G,
       IN_RW, IN_RB, IN_EG, IN_EU, IN_ED, IN_SG, IN_SU, IN_SD, IN_FG, N_IN };

constexpr size_t MiB = 1u << 20;
constexpr size_t WS_CTL = 0, CTL_ZERO_BYTES = 64 * 1024;
constexpr size_t WS_MOD = 1 * MiB;
constexpr size_t WS_ROPE = 1 * MiB + 512 * 1024;
constexpr size_t WS_WIN = 2 * MiB;
constexpr size_t WS_WOUT = 11 * MiB;
constexpr size_t WS_WSHGU = 15 * MiB;
constexpr size_t WS_WSHD = 17 * MiB;
constexpr size_t WS_XC = 18 * MiB;
constexpr size_t WS_LIST = 26 * MiB;
constexpr size_t WS_LISTW = 26 * MiB + 4608 * 1024;
constexpr size_t WS_H1 = 36 * MiB;
constexpr size_t WS_WEXPD = 72 * MiB;
constexpr size_t WS_ZH = 104 * MiB;
constexpr size_t WS_Y2 = 194 * MiB;
constexpr size_t WS_Y = WS_Y2;
constexpr size_t WS_SSQ = WS_Y2 + 36 * MiB;
constexpr size_t WS_WEXPGU = WS_Y2 + 38 * MiB;
constexpr size_t WS_END = WS_Y2 + 288 * MiB;
constexpr int LIST_CAP = NTOK;
constexpr int CW_BAR = 4096, CW_CNT = 8192;

constexpr int RING_BYTES = 131072, MISC_OFF = 131072 + 320, TOFF_OFF = 131072 + 1024, LDS_BYTES = 147456;

__device__ __forceinline__ unsigned pk2(float lo, float hi) { f32x2 v = {lo, hi}; bf16x2_t b = __builtin_convertvector(v, bf16x2_t); return __builtin_bit_cast(unsigned, b); }
__device__ __forceinline__ float bf_lo(unsigned w) { return __uint_as_float(w << 16); }
__device__ __forceinline__ float bf_hi(unsigned w) { return __uint_as_float(w & 0xffff0000u); }
__device__ __forceinline__ float wave_sum(float v) {
#pragma unroll
    for (int o = 1; o < 64; o <<= 1) v += __shfl_xor(v, o);
    return v;
}
__device__ __forceinline__ float gelu_tanh(float x) {
    const float u = 0.7978845608028654f * (x + 0.044715f * x * x * x);
    const float e = __expf(2.f * u);
    const float t = 1.f - 2.f / (e + 1.f);
    return 0.5f * x * (1.f + t);
}
__device__ __forceinline__ float silu_f(float x) { return x / (1.f + __expf(-x)); }

#define XB_TMO      128
#define XB_XCNT(j)  (256  + 64 * (j))
#define XB_XSUB(j)  (1280 + 64 * (j))
#define XB_XGEN(j)  (2304 + 64 * (j))
#define XB_TOP      3328
#define XB_TOPGEN   3392
#define XCD_BAR_WORDS 3456
#define XB_SPIN_CAP (1u << 18)
__device__ __forceinline__ unsigned xb_ld(unsigned* p)              { return __hip_atomic_load(p, __ATOMIC_RELAXED, __HIP_MEMORY_SCOPE_AGENT); }
__device__ __forceinline__ unsigned xb_add(unsigned* p, unsigned v) { return __hip_atomic_fetch_add(p, v, __ATOMIC_RELAXED, __HIP_MEMORY_SCOPE_AGENT); }
__device__ __forceinline__ unsigned xb_xcc_id() { return (unsigned)__builtin_amdgcn_s_getreg((3 << 11) | 20) & 0xFu; }
#define XB_SPIN(cond, bar) do { unsigned _sp = 0; while (cond) { __builtin_amdgcn_s_sleep(1); \
    if ((++_sp & 255u) == 0u) { if (xb_ld(&(bar)[XB_TMO])) break; if (_sp > XB_SPIN_CAP) { atomicAdd(&(bar)[XB_TMO], 1u); break; } } } } while (0)
struct XcdBarrier { unsigned* bar; unsigned x; volatile LAS unsigned* st; };
__device__ __forceinline__ XcdBarrier xcd_barrier_post(unsigned* bar, volatile LAS unsigned* st) {
    XcdBarrier b; b.bar = bar; b.x = xb_xcc_id(); b.st = st;
    if (threadIdx.x == 0) (void)xb_add(&bar[XB_XCNT(b.x)], 1u);
    return b;
}
__device__ __forceinline__ void xcd_barrier_complete(unsigned* bar, unsigned x, unsigned& nloc, unsigned& nx) {
    const unsigned G = gridDim.x * gridDim.y * gridDim.z;
    unsigned sum, cnt, mine, sp = 0u;
    for (;;) {
        sum = 0u; cnt = 0u; mine = 0u;
#pragma unroll 1
        for (unsigned j = 0; j < 16; ++j) { const unsigned c = xb_ld(&bar[XB_XCNT(j)]); sum += c; cnt += (c > 0u) ? 1u : 0u; mine = (j == x) ? c : mine; }
        if (sum == G) break;
        __builtin_amdgcn_s_sleep(1);
        if ((++sp & 255u) == 0u) { if (xb_ld(&bar[XB_TMO])) break; if (sp > XB_SPIN_CAP) { atomicAdd(&bar[XB_TMO], 1u); break; } }
    }
    nloc = mine > 0u ? mine : 1u; nx = cnt > 0u ? cnt : 1u;
}
__device__ __forceinline__ void xcd_barrier(const XcdBarrier& b) {
    asm volatile("s_waitcnt vmcnt(0)" ::: "memory");
    __syncthreads();
    if (threadIdx.x == 0) {
        unsigned* bar = b.bar;
        __builtin_amdgcn_s_waitcnt(0);
        unsigned nloc = b.st[0], nx = b.st[1];
        if (nloc == 0u) { xcd_barrier_complete(bar, b.x, nloc, nx); b.st[0] = nloc; b.st[1] = nx; }
        const unsigned old = xb_add(&bar[XB_XSUB(b.x)], 1u);
        const unsigned gen = old / nloc;
        if (old + 1u == (gen + 1u) * nloc) {
            __builtin_amdgcn_fence(__ATOMIC_RELEASE, "agent");
            asm volatile("s_waitcnt vmcnt(0)" ::: "memory");
            const unsigned og = xb_add(&bar[XB_TOP], 1u);
            const unsigned tg = og / nx;
            if (og + 1u == (tg + 1u) * nx) xb_add(&bar[XB_TOPGEN], 1u);
            else XB_SPIN(xb_ld(&bar[XB_TOPGEN]) == tg, bar);
            __builtin_amdgcn_fence(__ATOMIC_ACQUIRE, "agent");
            xb_add(&bar[XB_XGEN(b.x)], 1u);
            asm volatile("s_waitcnt vmcnt(0)" ::: "memory");
        } else {
            XB_SPIN(xb_ld(&bar[XB_XGEN(b.x)]) == gen, bar);
            __builtin_amdgcn_fence(__ATOMIC_ACQUIRE, "agent");
            asm volatile("s_waitcnt vmcnt(0)" ::: "memory");
        }
    }
    __syncthreads();
}

struct Params { const float* in[N_IN]; float* out; unsigned char* ws; };

struct Frame {
    unsigned char* lds;
    int tid, lane, wave, bid, G;
    const Params* P;
    __device__ __forceinline__ const float* inp(int i) const { return P->in[i]; }
    __device__ __forceinline__ float* outp() const { return P->out; }
    __device__ __forceinline__ unsigned char* wsb() const { return P->ws; }
    __device__ __forceinline__ unsigned* ctl() const { return (unsigned*)(P->ws + WS_CTL); }
    __device__ __forceinline__ float* MOD() const { return (float*)(P->ws + WS_MOD); }
    __device__ __forceinline__ float* ROPE() const { return (float*)(P->ws + WS_ROPE); }
    __device__ __forceinline__ bf16_t* WIN() const { return (bf16_t*)(P->ws + WS_WIN); }
    __device__ __forceinline__ bf16_t* WOUT() const { return (bf16_t*)(P->ws + WS_WOUT); }
    __device__ __forceinline__ bf16_t* WSHGU() const { return (bf16_t*)(P->ws + WS_WSHGU); }
    __device__ __forceinline__ bf16_t* WSHD() const { return (bf16_t*)(P->ws + WS_WSHD); }
    __device__ __forceinline__ bf16_t* WEXPGU() const { return (bf16_t*)(P->ws + WS_WEXPGU); }
    __device__ __forceinline__ bf16_t* WEXPD() const { return (bf16_t*)(P->ws + WS_WEXPD); }
    __device__ __forceinline__ bf16_t* H1() const { return (bf16_t*)(P->ws + WS_H1); }
    __device__ __forceinline__ bf16_t* Z() const { return (bf16_t*)(P->ws + WS_ZH); }
    __device__ __forceinline__ bf16_t* HB() const { return (bf16_t*)(P->ws + WS_ZH); }
    __device__ __forceinline__ bf16_t* Y() const { return (bf16_t*)(P->ws + WS_Y); }
    __device__ __forceinline__ bf16_t* Y2() const { return (bf16_t*)(P->ws + WS_Y2); }
    __device__ __forceinline__ float* XC() const { return (float*)(P->ws + WS_XC); }
    __device__ __forceinline__ float* SSQ() const { return (float*)(P->ws + WS_SSQ); }
    __device__ __forceinline__ float* LISTW() const { return (float*)(P->ws + WS_LISTW); }
    __device__ __forceinline__ unsigned* LIST() const { return (unsigned*)(P->ws + WS_LIST); }
};
__device__ __forceinline__ float* xa_row(const Frame& F, int r) { return r < NLAT ? F.outp() + (size_t)r * D : F.XC() + (size_t)(r - NLAT) * D; }
__device__ __forceinline__ int mod_row(int r) { return r < NLAT ? (r >> 11) : 8; }
__device__ __forceinline__ const float* mod_ptr(const Frame& F, int l, int r, int chunk) { return F.MOD() + ((size_t)(l * 9 + mod_row(r)) * 6 + chunk) * D; }
__device__ __forceinline__ unsigned* cnt_ptr(const Frame& F, int l, int e) { return F.ctl() + CW_CNT + (l * 64 + e) * 16; }

__device__ __forceinline__ void transpose_item(const float* W, int K, int N, bf16_t* WT, int k0, int n0, int rbase, float* scr, int lane) {
#pragma unroll 8
    for (int i = 0; i < 32; ++i) { const int kk = 2 * i + (lane >> 5); scr[kk * 33 + (lane & 31)] = W[(size_t)(k0 + kk) * N + n0 + (lane & 31)]; }
    asm volatile("s_waitcnt lgkmcnt(0)" ::: "memory");
    const int c = lane & 7;
#pragma unroll
    for (int j = 0; j < 4; ++j) { const int n = (lane >> 3) + 8 * j; const float* s = scr + (8 * c) * 33 + n;
        u32x4 o; o.x = pk2(s[0 * 33], s[1 * 33]); o.y = pk2(s[2 * 33], s[3 * 33]); o.z = pk2(s[4 * 33], s[5 * 33]); o.w = pk2(s[6 * 33], s[7 * 33]);
        *(u32x4*)(WT + (size_t)(rbase + n) * K + k0 + 8 * c) = o; }
    asm volatile("s_waitcnt lgkmcnt(0)" ::: "memory");
}
__device__ __forceinline__ void conv_weight(const float* W, int K, int N, bf16_t* WT, int gu, int item, float* scr, int lane) {
    const int nblk = N / 32, kb = item / nblk, nb = item % nblk, n0 = 32 * nb;
    const int rbase = gu == 0 ? n0 : ((n0 >> 7) * 256 + (n0 & 127) + (gu == 2 ? 128 : 0));
    transpose_item(W, K, N, WT, 64 * kb, n0, rbase, scr, lane);
}
__device__ __forceinline__ void conv_experts(Frame& F, int l) {
    float* scr = (float*)(F.lds + F.wave * 16384);
    const int gw = F.bid * NWAVES + F.wave, NGW = F.G * NWAVES;
    constexpr int IG = (D / 64) * (FF / 32), ID = (FF / 64) * (D / 32);
    constexpr int PER = 2 * IG + ID;
    for (int it = gw; it < NE * PER; it += NGW) {
        const int e = it / PER; int r = it % PER;
        const size_t eo = (size_t)(l * NE + e) * D * FF;
        if (r < IG) { conv_weight(F.inp(IN_EG) + eo, D, FF, F.WEXPGU() + (size_t)e * 512 * D, 1, r, scr, F.lane); continue; } r -= IG;
        if (r < IG) { conv_weight(F.inp(IN_EU) + eo, D, FF, F.WEXPGU() + (size_t)e * 512 * D, 2, r, scr, F.lane); continue; } r -= IG;
        conv_weight(F.inp(IN_ED) + eo, FF, D, F.WEXPD() + (size_t)e * D * FF, 0, r, scr, F.lane);
    }
}
__device__ __forceinline__ void p0_prologue(Frame& F) {
    if (F.bid == 0) {
        for (int i = F.tid; i < 64 * 16; i += NTHR) { const int pos = i >> 4, f = i & 15;
            const float inv = powf(10000.0f, -(float)(2 * f) / 32.0f); const float a = (float)pos * inv;
            F.ROPE()[i] = cosf(a); F.ROPE()[1024 + i] = sinf(a); }
    }
    {
        float* sl = (float*)F.lds;
        float* red = (float*)(F.lds + 40960);
        bool have = false;
        for (int it = F.bid; it < 2 * 96; it += F.G) {
            if (!have) {
                for (int i = F.tid; i < 9 * D; i += NTHR) { const int r = i >> 10, k = i & 1023; const float v = r < 8 ? F.inp(IN_C)[r * D + k] : F.inp(IN_CCTX)[k]; sl[i] = silu_f(v); }
                __syncthreads(); have = true;
            }
            const int l = it / 96, jc = it % 96, c = F.tid & 63, kg = F.tid >> 6;
            const float* W = F.inp(IN_MODW) + (size_t)l * D * 6144 + 64 * jc + c;
            float acc[9];
#pragma unroll
            for (int r = 0; r < 9; ++r) acc[r] = 0.f;
#pragma unroll 8
            for (int k = 128 * kg; k < 128 * kg + 128; ++k) { const float w = W[(size_t)k * 6144];
#pragma unroll
                for (int r = 0; r < 9; ++r) acc[r] += sl[r * D + k] * w; }
#pragma unroll
            for (int r = 0; r < 9; ++r) red[(kg * 9 + r) * 64 + c] = acc[r];
            __syncthreads();
            for (int i = F.tid; i < 9 * 64; i += NTHR) { const int r = i >> 6, cc = i & 63; float s = 0.f;
#pragma unroll
                for (int g = 0; g < 8; ++g) s += red[(g * 9 + r) * 64 + cc];
                F.MOD()[(size_t)(l * 9 + r) * 6144 + 64 * jc + cc] = s + F.inp(IN_MODB)[l * 6144 + 64 * jc + cc]; }
            __syncthreads();
        }
        __syncthreads();
    }
    {
        float* scr = (float*)(F.lds + F.wave * 16384);
        const int gw = F.bid * NWAVES + F.wave, NGW = F.G * NWAVES;
        constexpr int I_IN = (D / 64) * (INW / 32), I_OUT = (D / 64) * (D / 32), I_SG = (D / 64) * (FF / 32), I_SD = (FF / 64) * (D / 32);
        constexpr int PER = I_IN + I_OUT + 2 * I_SG + I_SD;
        for (int it = gw; it < 2 * PER; it += NGW) {
            const int l = it / PER; int r = it % PER;
            if (r < I_IN) { conv_weight(F.inp(IN_WIN) + (size_t)l * D * INW, D, INW, F.WIN() + (size_t)l * INW * D, 0, r, scr, F.lane); continue; } r -= I_IN;
            if (r < I_OUT) { conv_weight(F.inp(IN_WOUT) + (size_t)l * D * D, D, D, F.WOUT() + (size_t)l * D * D, 0, r, scr, F.lane); continue; } r -= I_OUT;
            if (r < I_SG) { conv_weight(F.inp(IN_SG) + (size_t)l * D * FF, D, FF, F.WSHGU() + (size_t)l * 512 * D, 1, r, scr, F.lane); continue; } r -= I_SG;
            if (r < I_SG) { conv_weight(F.inp(IN_SU) + (size_t)l * D * FF, D, FF, F.WSHGU() + (size_t)l * 512 * D, 2, r, scr, F.lane); continue; } r -= I_SG;
            conv_weight(F.inp(IN_SD) + (size_t)l * FF * D, FF, D, F.WSHD() + (size_t)l * D * FF, 0, r, scr, F.lane);
        }
    }
    conv_experts(F, 0);
}

__device__ __forceinline__ void load_row(const float* src, int lane, f32x4 (&v)[4]) {
#pragma unroll
    for (int j = 0; j < 4; ++j) v[j] = *(const f32x4*)(src + 4 * lane + 256 * j);
}
__device__ __forceinline__ float row_rstd(const f32x4 (&v)[4]) {
    float s = 0.f;
#pragma unroll
    for (int j = 0; j < 4; ++j) s += (v[j].x * v[j].x + v[j].y * v[j].y) + (v[j].z * v[j].z + v[j].w * v[j].w);
    return 1.0f / sqrtf(wave_sum(s) * (1.0f / D) + EPS);
}
__device__ __forceinline__ void norm_mod(const f32x4 (&v)[4], float rstd, const float* g, const float* sh, const float* sc, int lane, f32x4 (&h)[4]) {
#pragma unroll
    for (int j = 0; j < 4; ++j) { const int c = 4 * lane + 256 * j; const f32x4 gg = *(const f32x4*)(g + c), s1 = *(const f32x4*)(sh + c), s2 = *(const f32x4*)(sc + c);
        h[j] = v[j] * rstd * gg * (1.0f + s2) + s1; }
}
__device__ __forceinline__ void store_row_bf16(bf16_t* dst, int lane, const f32x4 (&h)[4]) {
#pragma unroll
    for (int j = 0; j < 4; ++j) { u32x2 w; w.x = pk2(h[j].x, h[j].y); w.y = pk2(h[j].z, h[j].w); *(u32x2*)(dst + 4 * lane + 256 * j) = w; }
}
__device__ __forceinline__ void phase_r1(Frame& F, int l) {
    const int gw = F.bid * NWAVES + F.wave, NGW = F.G * NWAVES;
    for (int r = gw; r < NTOK; r += NGW) {
        const float* src = (l == 0) ? (r < NLAT ? F.inp(IN_X) + (size_t)r * D : F.inp(IN_CTX) + (size_t)(r - NLAT) * D) : xa_row(F, r);
        f32x4 v[4], h[4]; load_row(src, F.lane, v);
        const float rstd = row_rstd(v);
        norm_mod(v, rstd, F.inp(IN_N1G) + l * D, mod_ptr(F, l, r, 0), mod_ptr(F, l, r, 1), F.lane, h);
        store_row_bf16(F.H1() + (size_t)r * D, F.lane, h);
    }
}
__device__ __forceinline__ void phase_nrm(Frame& F, int l, int nrows) {
    const int gw = F.bid * NWAVES + F.wave, NGW = F.G * NWAVES;
    for (int r = gw; r < nrows; r += NGW) {
        const float* sq = F.SSQ() + (size_t)r * 16;
        const float sA = sq[0] + sq[1] + sq[2] + sq[3] + sq[4] + sq[5], sB = sq[6] + sq[7] + sq[8] + sq[9], sC = sq[10] + sq[11] + sq[12] + sq[13] + sq[14] + sq[15];
        const float rA = 1.0f / sqrtf(sA * (1.0f / 384.0f) + EPS), rB = 1.0f / sqrtf(sB * (1.0f / 256.0f) + EPS), rC = 1.0f / sqrtf(sC * (1.0f / 384.0f) + EPS);
        bf16_t* yr = F.Y() + (size_t)r * D;
#pragma unroll
        for (int j = 0; j < 4; ++j) { const int c = 4 * F.lane + 256 * j; const float rs = c < 384 ? rA : (c < 640 ? rB : rC);
            const u32x2 w = *(const u32x2*)(yr + c); const f32x4 gg = *(const f32x4*)(F.inp(IN_GNG) + l * D + c);
            u32x2 o; o.x = pk2(bf_lo(w.x) * rs * gg.x, bf_hi(w.x) * rs * gg.y); o.y = pk2(bf_lo(w.y) * rs * gg.z, bf_hi(w.y) * rs * gg.w);
            *(u32x2*)(yr + c) = o; }
    }
}
__device__ __forceinline__ void phase_r2(Frame& F, int l, int nrows) {
    const int gw = F.bid * NWAVES + F.wave, NGW = F.G * NWAVES;
    float* hl = (float*)(F.lds + F.wave * 4096);
    const float* RW = F.inp(IN_RW) + (size_t)l * D * NE;
    const float rbias = F.inp(IN_RB)[l * NE + F.lane];
    for (int r = gw; r < nrows; r += NGW) {
        f32x4 v[4], h[4]; load_row(xa_row(F, r), F.lane, v);
        const float rstd = row_rstd(v);
        norm_mod(v, rstd, F.inp(IN_N2G) + l * D, mod_ptr(F, l, r, 3), mod_ptr(F, l, r, 4), F.lane, h);
        store_row_bf16(F.H1() + (size_t)r * D, F.lane, h);
#pragma unroll
        for (int j = 0; j < 4; ++j) *(f32x4*)(hl + 4 * F.lane + 256 * j) = h[j];
        asm volatile("s_waitcnt lgkmcnt(0)" ::: "memory");
        float logit = 0.f;
#pragma unroll 8
        for (int k = 0; k < D; ++k) logit += hl[k] * RW[k * NE + F.lane];
        const float score = 1.0f / (1.0f + expf(-logit));
        const float sel = score + rbias;
        float m1 = sel;
#pragma unroll
        for (int o = 1; o < 8; o <<= 1) m1 = fmaxf(m1, __shfl_xor(m1, o));
        const unsigned long long bal = __ballot(sel == m1);
        const unsigned gm = (unsigned)(bal >> (F.lane & ~7)) & 0xffu; const int first = __ffs(gm) - 1;
        float m2 = ((F.lane & 7) == first) ? -3.0e38f : sel;
#pragma unroll
        for (int o = 1; o < 8; o <<= 1) m2 = fmaxf(m2, __shfl_xor(m2, o));
        const float gs = m1 + m2; const int g = F.lane >> 3; int rank = 0;
#pragma unroll
        for (int j = 0; j < 8; ++j) { const float o = __shfl(gs, j * 8); rank += ((o > gs) || (o == gs && j < g)) ? 1 : 0; }
        const float msel = rank < 4 ? sel : NEGF;
        int r2 = 0;
#pragma unroll
        for (int j = 0; j < 64; ++j) { const float o = __shfl(msel, j); r2 += ((o > msel) || (o == msel && j < F.lane)) ? 1 : 0; }
        const bool chosen = r2 < 8;
        const float wsum = wave_sum(chosen ? score : 0.f);
        if (chosen) {
            const unsigned pos = atomicAdd(cnt_ptr(F, l, F.lane), 1u);
            F.LIST()[(size_t)F.lane * LIST_CAP + pos] = (unsigned)r | ((unsigned)r2 << 16);
            F.LISTW()[(size_t)F.lane * LIST_CAP + pos] = score / wsum * 2.5f;
        }
    }
}
__device__ __forceinline__ void phase_cmb(Frame& F, int l, int nrows) {
    const int gw = F.bid * NWAVES + F.wave, NGW = F.G * NWAVES;
    for (int r = gw; r < nrows; r += NGW) {
        float* xr = xa_row(F, r);
        f32x4 v[4]; load_row(xr, F.lane, v);
        f32x4 s[4];
#pragma unroll
        for (int j = 0; j < 4; ++j) s[j] = (f32x4){0.f, 0.f, 0.f, 0.f};
        const bf16_t* yb = F.Y2() + (size_t)r * 8 * D;
#pragma unroll
        for (int k = 0; k < 8; ++k)
#pragma unroll
            for (int j = 0; j < 4; ++j) { const u32x2 w = *(const u32x2*)(yb + (size_t)k * D + 4 * F.lane + 256 * j);
                s[j].x += bf_lo(w.x); s[j].y += bf_hi(w.x); s[j].z += bf_lo(w.y); s[j].w += bf_hi(w.y); }
        const float* g2 = mod_ptr(F, l, r, 5);
#pragma unroll
        for (int j = 0; j < 4; ++j) v[j] = v[j] + *(const f32x4*)(g2 + 4 * F.lane + 256 * j) * s[j];
        const float rstd = row_rstd(v);
        if (l == 0) {
#pragma unroll
            for (int j = 0; j < 4; ++j) *(f32x4*)(xr + 4 * F.lane + 256 * j) = v[j];
            f32x4 h[4];
            norm_mod(v, rstd, F.inp(IN_N1G) + D, mod_ptr(F, 1, r, 0), mod_ptr(F, 1, r, 1), F.lane, h);
            store_row_bf16(F.H1() + (size_t)r * D, F.lane, h);
        } else {
#pragma unroll
            for (int j = 0; j < 4; ++j) { const f32x4 gg = *(const f32x4*)(F.inp(IN_FG) + 4 * F.lane + 256 * j); *(f32x4*)(xr + 4 * F.lane + 256 * j) = v[j] * rstd * gg; }
        }
    }
}

struct Unit { int pm, pn, e, lt; };

struct SchedDense {
    const bf16_t* A; const bf16_t* Bt; int K, nM, nN, G, c;
    __device__ __forceinline__ bool next(int i, Unit& u) const {
        const int L = i * G + c; if (L >= nM * nN) return false;
        u.pn = __builtin_amdgcn_readfirstlane(L % nN); u.pm = __builtin_amdgcn_readfirstlane(L / nN); u.e = 0; u.lt = 0; return true;
    }
    __device__ __forceinline__ const bf16_t* a_row(const Unit& u, int r) const { return A + (size_t)(u.pm * 256 + r) * K; }
    __device__ __forceinline__ const bf16_t* b_row(const Unit& u, int c_) const { return Bt + (size_t)(u.pn * 256 + c_) * K; }
    const unsigned char* ws;
    __device__ __forceinline__ unsigned a_off(const Unit& u) const { return (unsigned)((const unsigned char*)A - ws) + (unsigned)u.pm * (unsigned)(512 * K); }
    __device__ __forceinline__ unsigned b_off(const Unit& u) const { return (unsigned)((const unsigned char*)Bt - ws) + (unsigned)u.pn * (unsigned)(512 * K); }
};
struct MoeTab { const int* toff; const int* cnt; };
__device__ __forceinline__ void moe_build_tab(Frame& F, int l, int nrows_shared) {
    int* toff = (int*)(F.lds + TOFF_OFF); int* cnt = toff + 72;
    __syncthreads();
    if (F.tid == 0) { int acc = 0;
        for (int e = 0; e < NE; ++e) { const int c = (int)__hip_atomic_load(cnt_ptr(F, l, e), __ATOMIC_RELAXED, __HIP_MEMORY_SCOPE_AGENT); cnt[e] = c; toff[e] = acc; acc += (c + 255) >> 8; }
        cnt[NE] = nrows_shared; toff[NE] = acc; acc += nrows_shared >> 8; toff[NE + 1] = acc; }
    __syncthreads();
}
__device__ __forceinline__ void moe_find(const MoeTab& T, int tg, Unit& u) {
    int e = 0;
#pragma unroll 1
    for (int j = 1; j <= NE; ++j) e = (T.toff[j] <= tg) ? j : e;
    u.pm = __builtin_amdgcn_readfirstlane(tg); u.e = __builtin_amdgcn_readfirstlane(e); u.lt = __builtin_amdgcn_readfirstlane(tg - T.toff[e]);
}
struct SchedE1 {
    MoeTab T; const unsigned* LIST; const bf16_t* H1; const bf16_t* WGU; const bf16_t* WSH; int G, c;
    __device__ __forceinline__ bool next(int i, Unit& u) const {
        const int L = i * G + c; if (L >= __builtin_amdgcn_readfirstlane(T.toff[NE + 1]) * 2) return false;
        u.pn = __builtin_amdgcn_readfirstlane(L & 1); moe_find(T, L >> 1, u); return true;
    }
    __device__ __forceinline__ int token(const Unit& u, int r) const {
        const int idx = u.lt * 256 + r;
        if (u.e == NE) return idx;
        return idx < T.cnt[u.e] ? (int)(LIST[(size_t)u.e * LIST_CAP + idx] & 0xffffu) : 0;
    }
    __device__ __forceinline__ const bf16_t* a_row(const Unit& u, int r) const { return H1 + (size_t)token(u, r) * D; }
    __device__ __forceinline__ const bf16_t* b_row(const Unit& u, int c_) const { return (u.e == NE ? WSH : WGU + (size_t)u.e * 512 * D) + (size_t)(u.pn * 256 + c_) * D; }
    const unsigned char* ws;
    __device__ __forceinline__ unsigned a_org() const { return (unsigned)((const unsigned char*)H1 - ws); }
    __device__ __forceinline__ unsigned a_rowoff(const Unit& u, int r) const { return (unsigned)token(u, r) * (unsigned)(D * 2); }
    __device__ __forceinline__ unsigned b_off(const Unit& u) const {
        const unsigned sh = (unsigned)((const unsigned char*)WSH - ws), ex = (unsigned)((const unsigned char*)WGU - ws) + (unsigned)u.e * (unsigned)(512 * D * 2);
        return (u.e == NE ? sh : ex) + (unsigned)u.pn * (unsigned)(256 * D * 2); }
};
struct SchedE2 {
    MoeTab T; const bf16_t* HB; const bf16_t* WD; const bf16_t* WSH; int G, c;
    __device__ __forceinline__ bool next(int i, Unit& u) const {
        const int L = i * G + c; if (L >= __builtin_amdgcn_readfirstlane(T.toff[NE + 1]) * 4) return false;
        u.pn = __builtin_amdgcn_readfirstlane(L & 3); moe_find(T, L >> 2, u); return true;
    }
    __device__ __forceinline__ const bf16_t* a_row(const Unit& u, int r) const { return HB + (size_t)(u.pm * 256 + r) * FF; }
    __device__ __forceinline__ const bf16_t* b_row(const Unit& u, int c_) const { return (u.e == NE ? WSH : WD + (size_t)u.e * D * FF) + (size_t)(u.pn * 256 + c_) * FF; }
    const unsigned char* ws;
    __device__ __forceinline__ unsigned a_off(const Unit& u) const { return (unsigned)((const unsigned char*)HB - ws) + (unsigned)u.pm * (unsigned)(256 * FF * 2); }
    __device__ __forceinline__ unsigned b_off(const Unit& u) const {
        const unsigned sh = (unsigned)((const unsigned char*)WSH - ws), ex = (unsigned)((const unsigned char*)WD - ws) + (unsigned)u.e * (unsigned)(D * FF * 2);
        return (u.e == NE ? sh : ex) + (unsigned)u.pn * (unsigned)(256 * FF * 2); }
};

struct EpiG1 {
    bf16_t* Z; const float* ROPE;
    __device__ __forceinline__ void row(const Unit& u, int r, int cbase, const f32x4 (&v)[2][2]) const {
        const int grow = u.pm * 256 + r;
#pragma unroll
        for (int bj = 0; bj < 2; ++bj) {
            const int col0 = u.pn * 256 + bj * 128 + cbase;
            f32x4 a = v[bj][0], b = v[bj][1];
            const bool is_rope = (col0 < VA) && (grow < NLAT);
            if (is_rope) {
                const int t = grow & (SEQ - 1); const int pos = ((col0 & 32) == 0) ? (t >> 6) : (t & 63);
                const int f0 = col0 & 15;
                const f32x4 cs = *(const f32x4*)(ROPE + pos * 16 + f0), sn = *(const f32x4*)(ROPE + 1024 + pos * 16 + f0);
                const f32x4 a2 = a * cs - b * sn, b2 = b * cs + a * sn; a = a2; b = b2;
            }
            if (col0 < KA || (col0 >= QN && col0 < KN)) { a = a * 0.125f; b = b * 0.125f; }
            if (col0 >= UB && col0 < QN) {
                a = (f32x4){gelu_tanh(a.x), gelu_tanh(a.y), gelu_tanh(a.z), gelu_tanh(a.w)};
                b = (f32x4){gelu_tanh(b.x), gelu_tanh(b.y), gelu_tanh(b.z), gelu_tanh(b.w)};
            }
            bf16_t* zr = Z + (size_t)grow * INW + col0;
            u32x2 w0, w1; w0.x = pk2(a.x, a.y); w0.y = pk2(a.z, a.w); w1.x = pk2(b.x, b.y); w1.y = pk2(b.z, b.w);
            *(u32x2*)zr = w0; *(u32x2*)(zr + 16) = w1;
        }
    }
};
struct EpiG2 {
    const float* xlat; const float* xctx; float* out; float* XC; const float* MOD; int l;
    __device__ __forceinline__ void row(const Unit& u, int r, int cbase, const f32x4 (&v)[2][2]) const {
        const int grow = u.pm * 256 + r;
        const float* src = grow < NLAT ? xlat + (size_t)grow * D : xctx + (size_t)(grow - NLAT) * D;
        float* dst = grow < NLAT ? out + (size_t)grow * D : XC + (size_t)(grow - NLAT) * D;
        const float* g1 = MOD + ((size_t)(l * 9 + mod_row(grow)) * 6 + 2) * D;
#pragma unroll
        for (int bj = 0; bj < 2; ++bj)
#pragma unroll
            for (int n = 0; n < 2; ++n) { const int c = u.pn * 256 + bj * 128 + cbase + 16 * n;
                *(f32x4*)(dst + c) = *(const f32x4*)(src + c) + *(const f32x4*)(g1 + c) * v[bj][n]; }
    }
};
struct EpiE1 {
    bf16_t* HB;
    __device__ __forceinline__ void row(const Unit& u, int r, int cbase, const f32x4 (&v)[2][2]) const {
        bf16_t* hr = HB + (size_t)(u.pm * 256 + r) * FF + u.pn * 128 + cbase;
#pragma unroll
        for (int n = 0; n < 2; ++n) { const f32x4 g = v[0][n], up = v[1][n];
            u32x2 w; w.x = pk2(silu_f(g.x) * up.x, silu_f(g.y) * up.y); w.y = pk2(silu_f(g.z) * up.z, silu_f(g.w) * up.w);
            *(u32x2*)(hr + 16 * n) = w; }
    }
};
struct EpiE2 {
    MoeTab T; const unsigned* LIST; const float* LISTW; bf16_t* Y2; float* out; float* XC; const float* MOD; int l;
    __device__ __forceinline__ void row(const Unit& u, int r, int cbase, const f32x4 (&v)[2][2]) const {
        const int idx = u.lt * 256 + r;
        if (u.e == NE) {
            float* dst = idx < NLAT ? out + (size_t)idx * D : XC + (size_t)(idx - NLAT) * D;
            const float* g2 = MOD + ((size_t)(l * 9 + mod_row(idx)) * 6 + 5) * D;
#pragma unroll
            for (int bj = 0; bj < 2; ++bj)
#pragma unroll
                for (int n = 0; n < 2; ++n) { const int c = u.pn * 256 + bj * 128 + cbase + 16 * n;
                    *(f32x4*)(dst + c) = *(const f32x4*)(dst + c) + *(const f32x4*)(g2 + c) * v[bj][n]; }
        } else if (idx < T.cnt[u.e]) {
            const unsigned ent = LIST[(size_t)u.e * LIST_CAP + idx]; const float w = LISTW[(size_t)u.e * LIST_CAP + idx];
            bf16_t* yr = Y2 + ((size_t)(ent & 0xffffu) * 8 + (ent >> 16)) * D + u.pn * 256 + cbase;
#pragma unroll
            for (int bj = 0; bj < 2; ++bj)
#pragma unroll
                for (int n = 0; n < 2; ++n) { const f32x4 x = v[bj][n] * w; u32x2 o; o.x = pk2(x.x, x.y); o.y = pk2(x.z, x.w); *(u32x2*)(yr + bj * 128 + 16 * n) = o; }
        }
    }
};

template <class Sched, class Epi>
__device__ __forceinline__ void gemm_simple(Frame& F, const Sched& S, const Epi& E, int K) {
    float* As = (float*)F.lds;
    float* Bs = (float*)(F.lds + 32 * 132 * 4);
    const int tid = F.tid, cg = tid & 15, rg = tid >> 4, wc = cg >> 2, fq = cg & 3, cbase = 32 * wc + 4 * fq;
    Unit u;
    for (int i = 0; S.next(i, u); ++i) {
        const bf16_t* bp = S.b_row(u, tid >> 1) + 16 * (tid & 1);
        for (int ai = 0; ai < 2; ++ai) {
            const bf16_t* ap = S.a_row(u, ai * 128 + (tid >> 2)) + 8 * (tid & 3);
            f32x4 acc[4][2][2];
#pragma unroll
            for (int a = 0; a < 4; ++a)
#pragma unroll
                for (int b = 0; b < 2; ++b)
#pragma unroll
                    for (int n = 0; n < 2; ++n) acc[a][b][n] = (f32x4){0.f, 0.f, 0.f, 0.f};
            for (int k0 = 0; k0 < K; k0 += 32) {
                const u32x4 wa = *(const u32x4*)(ap + k0);
                const u32x4 wb0 = *(const u32x4*)(bp + k0), wb1 = *(const u32x4*)(bp + k0 + 8);
                __syncthreads();
                { const int row = tid >> 2, kc = 8 * (tid & 3);
                  As[(kc + 0) * 132 + row] = bf_lo(wa.x); As[(kc + 1) * 132 + row] = bf_hi(wa.x); As[(kc + 2) * 132 + row] = bf_lo(wa.y); As[(kc + 3) * 132 + row] = bf_hi(wa.y);
                  As[(kc + 4) * 132 + row] = bf_lo(wa.z); As[(kc + 5) * 132 + row] = bf_hi(wa.z); As[(kc + 6) * 132 + row] = bf_lo(wa.w); As[(kc + 7) * 132 + row] = bf_hi(wa.w); }
                { const int col = tid >> 1, kc = 16 * (tid & 1);
                  Bs[(kc + 0) * 260 + col] = bf_lo(wb0.x); Bs[(kc + 1) * 260 + col] = bf_hi(wb0.x); Bs[(kc + 2) * 260 + col] = bf_lo(wb0.y); Bs[(kc + 3) * 260 + col] = bf_hi(wb0.y);
                  Bs[(kc + 4) * 260 + col] = bf_lo(wb0.z); Bs[(kc + 5) * 260 + col] = bf_hi(wb0.z); Bs[(kc + 6) * 260 + col] = bf_lo(wb0.w); Bs[(kc + 7) * 260 + col] = bf_hi(wb0.w);
                  Bs[(kc + 8) * 260 + col] = bf_lo(wb1.x); Bs[(kc + 9) * 260 + col] = bf_hi(wb1.x); Bs[(kc + 10) * 260 + col] = bf_lo(wb1.y); Bs[(kc + 11) * 260 + col] = bf_hi(wb1.y);
                  Bs[(kc + 12) * 260 + col] = bf_lo(wb1.z); Bs[(kc + 13) * 260 + col] = bf_hi(wb1.z); Bs[(kc + 14) * 260 + col] = bf_lo(wb1.w); Bs[(kc + 15) * 260 + col] = bf_hi(wb1.w); }
                __syncthreads();
#pragma unroll 4
                for (int kk = 0; kk < 32; ++kk) {
                    const f32x4 a = *(const f32x4*)(As + kk * 132 + 4 * rg);
                    f32x4 b[2][2];
#pragma unroll
                    for (int bj = 0; bj < 2; ++bj)
#pragma unroll
                        for (int n = 0; n < 2; ++n) b[bj][n] = *(const f32x4*)(Bs + kk * 260 + 128 * bj + cbase + 16 * n);
#pragma unroll
                    for (int bj = 0; bj < 2; ++bj)
#pragma unroll
                        for (int n = 0; n < 2; ++n) { acc[0][bj][n] += a.x * b[bj][n]; acc[1][bj][n] += a.y * b[bj][n]; acc[2][bj][n] += a.z * b[bj][n]; acc[3][bj][n] += a.w * b[bj][n]; }
                }
            }
#pragma unroll
            for (int a = 0; a < 4; ++a) E.row(u, ai * 128 + 4 * rg + a, cbase, acc[a]);
        }
    }
    __syncthreads();
}


namespace pg8 {
typedef short bf16x8 __attribute__((ext_vector_type(8)));
constexpr int BM = 256, BK = 64, HALF = 128, HTB = HALF * BK * 2, STAGE_BYTES = 8 * HTB;
__device__ __forceinline__ int lds_byte(int r, int c) { const int st = (r >> 4) * 2 + (c >> 5), rr = r & 15, cc = c & 31, ob = rr * 64 + cc * 2; return st * 1024 + (ob ^ (((ob >> 9) & 1) << 5)); }
__device__ __forceinline__ void stage_rc(int b, int& R, int& C) { const int st = b / 1024, sb = b % 1024, swz = sb ^ (((sb >> 9) & 1) << 5); R = (st >> 1) * 16 + swz / 64; C = (st & 1) * 32 + (swz % 64) / 2; }

template <class Sched, class REpi, bool GATHER, bool ALIGN_EPI, bool SP2>
__device__ __forceinline__ void gemm_phase(LAS unsigned char* lds, const unsigned char* wsbase, const Sched& S, const REpi& RE, const int K, const int tid, const int wid) {
    const int lane = tid & 63, wr = wid >> 2, wc = wid & 3, fr = lane & 15, fq = lane >> 4;
    const int nt = K / BK;
    const __amdgpu_buffer_rsrc_t rsrc = __builtin_amdgcn_make_buffer_rsrc((void*)wsbase, 0, 0x7fffffff, 0x00020000);
    int R0, C0; stage_rc(tid * 16, R0, C0);
    const unsigned vo0 = (unsigned)(R0 * K + C0) * 2u, vo1 = (unsigned)((R0 + 64) * K + C0) * 2u;
    const unsigned kstep = (unsigned)(BK * 2), hstep = (unsigned)(HALF * K * 2);
    const unsigned ldsw = (unsigned)wid * 1024u;
    const int aoff = lds_byte(wr * 64 + fr, fq * 8), boff = lds_byte(wc * 32 + fr, fq * 8);
#define PG8_SA(b, h) (((b) * 2 + (h)) * HTB)
#define PG8_SB(b, h) ((4 + (b) * 2 + (h)) * HTB)
#define PG8_STAGE2(bufoff, soff, o0, o1) do { \
        const int _so = __builtin_amdgcn_readfirstlane((int)(soff)); \
        __builtin_amdgcn_raw_ptr_buffer_load_lds(rsrc, (LAS void*)(lds + (bufoff) + ldsw), 16, (int)(o0), _so, 0, 0); \
        __builtin_amdgcn_raw_ptr_buffer_load_lds(rsrc, (LAS void*)(lds + (bufoff) + ldsw + 8192), 16, (int)(o1), _so, 0, 0); } while (0)
#define PG8_STAGEB(bufoff, soff) PG8_STAGE2(bufoff, soff, vo0, vo1)
#define PG8_STAGEA(bufoff, soff, h, G) do { if constexpr (GATHER) PG8_STAGE2(bufoff, soff, (G)[h][0], (G)[h][1]); else PG8_STAGE2(bufoff, (soff) + (h) * hstep, vo0, vo1); } while (0)
#define PG8_LDA(dst, b, h) do { _Pragma("unroll") for (int m = 0; m < 4; ++m) _Pragma("unroll") for (int k = 0; k < 2; ++k) dst[m][k] = *(const LAS bf16x8*)(lds + PG8_SA(b, h) + aoff + m * 2048 + k * 1024); } while (0)
#define PG8_LDB(dst, b, h) do { _Pragma("unroll") for (int n = 0; n < 2; ++n) _Pragma("unroll") for (int k = 0; k < 2; ++k) dst[n][k] = *(const LAS bf16x8*)(lds + PG8_SB(b, h) + boff + n * 2048 + k * 1024); } while (0)
#define PG8_MMA(ai, bj, At, Bt) do { __builtin_amdgcn_s_setprio(1); _Pragma("unroll") for (int m = 0; m < 4; ++m) _Pragma("unroll") for (int n = 0; n < 2; ++n) _Pragma("unroll") for (int k = 0; k < 2; ++k) \
        acc[ai][bj][m][n] = __builtin_amdgcn_mfma_f32_16x16x32_bf16(Bt[n][k], At[m][k], acc[ai][bj][m][n], 0, 0, 0); __builtin_amdgcn_s_setprio(0); } while (0)
#define PG8_WAIT_V(n) asm volatile("s_waitcnt vmcnt(" #n ")" ::: "memory")
#define PG8_WAIT_L(n) asm volatile("s_waitcnt lgkmcnt(" #n ")" ::: "memory")
#define PG8_BAR __builtin_amdgcn_s_barrier()
#define PG8_SCHED __builtin_amdgcn_sched_barrier(0)
    Unit cur, nxt; int ui = 0;
    if (!S.next(0, cur)) return;
    f32x4 acc[2][2][4][2];
#pragma unroll
    for (int a = 0; a < 2; ++a)
#pragma unroll
        for (int b = 0; b < 2; ++b)
#pragma unroll
            for (int m = 0; m < 4; ++m)
#pragma unroll
                for (int n = 0; n < 2; ++n) acc[a][b][m][n] = (f32x4){0.f, 0.f, 0.f, 0.f};
    bf16x8 At[4][2], B0[2][2], B1[2][2];
    unsigned gc[2][2], gn[2][2];
    unsigned cA, cB = S.b_off(cur);
    if constexpr (GATHER) { cA = S.a_org();
#pragma unroll
        for (int h = 0; h < 2; ++h)
#pragma unroll
            for (int i = 0; i < 2; ++i) gc[h][i] = S.a_rowoff(cur, h * HALF + R0 + 64 * i) + (unsigned)C0 * 2u;
        asm volatile("s_waitcnt vmcnt(0) lgkmcnt(0)" : "+v"(gc[0][0]), "+v"(gc[0][1]), "+v"(gc[1][0]), "+v"(gc[1][1]) :: "memory");
    } else { cA = S.a_off(cur); gc[0][0] = gc[0][1] = gc[1][0] = gc[1][1] = 0u; }
    if constexpr (SP2) {
        PG8_STAGEB(PG8_SB(0, 0), cB); PG8_STAGEB(PG8_SB(0, 1), cB + hstep); PG8_STAGEA(PG8_SA(0, 0), cA, 0, gc); PG8_STAGEA(PG8_SA(0, 1), cA, 1, gc);
        if (wr == 1) PG8_BAR;
        PG8_WAIT_V(2); PG8_BAR;
        PG8_STAGEB(PG8_SB(1, 0), cB + kstep); PG8_STAGEA(PG8_SA(1, 0), cA + kstep, 0, gc); PG8_STAGEB(PG8_SB(1, 1), cB + hstep + kstep);
        PG8_WAIT_V(6); PG8_BAR;
    } else {
        PG8_STAGEB(PG8_SB(0, 0), cB); PG8_STAGEA(PG8_SA(0, 0), cA, 0, gc); PG8_STAGEB(PG8_SB(0, 1), cB + hstep); PG8_STAGEA(PG8_SA(0, 1), cA, 1, gc);
        if (wr == 1) PG8_BAR;
        PG8_WAIT_V(4); PG8_BAR;
        PG8_STAGEB(PG8_SB(1, 0), cB + kstep); PG8_STAGEA(PG8_SA(1, 0), cA + kstep, 0, gc); PG8_STAGEB(PG8_SB(1, 1), cB + hstep + kstep);
        PG8_WAIT_V(6); PG8_BAR;
    }
    for (;;) {
        const bool has_next = S.next(ui + 1, nxt);
        unsigned nA; const unsigned nB = has_next ? S.b_off(nxt) : cB;
        if constexpr (GATHER) { nA = cA;
#pragma unroll
            for (int h = 0; h < 2; ++h)
#pragma unroll
                for (int i = 0; i < 2; ++i) gn[h][i] = has_next ? S.a_rowoff(nxt, h * HALF + R0 + 64 * i) + (unsigned)C0 * 2u : gc[h][i];
            asm volatile("s_waitcnt vmcnt(0) lgkmcnt(0)" : "+v"(gn[0][0]), "+v"(gn[0][1]), "+v"(gn[1][0]), "+v"(gn[1][1]) :: "memory");
        } else { nA = has_next ? S.a_off(nxt) : cA; }
#pragma unroll 1
        for (int t = 0; t < nt; t += 2) {
            const bool last = (t == nt - 2);
            const unsigned a1 = cA + (unsigned)(t + 1) * kstep;
            unsigned a2; const unsigned b2 = last ? nB : cB + (unsigned)(t + 2) * kstep;
            unsigned g2[2][2];
            if constexpr (GATHER) { a2 = last ? cA : cA + (unsigned)(t + 2) * kstep;
#pragma unroll
                for (int h = 0; h < 2; ++h)
#pragma unroll
                    for (int i = 0; i < 2; ++i) g2[h][i] = last ? gn[h][i] : gc[h][i];
            } else { a2 = last ? nA : cA + (unsigned)(t + 2) * kstep; g2[0][0] = g2[0][1] = g2[1][0] = g2[1][1] = 0u; }
            const unsigned a3 = a2 + kstep, b3 = b2 + kstep;
            if constexpr (SP2) {
            PG8_LDB(B0, 0, 0); PG8_LDB(B1, 0, 1); PG8_SCHED; PG8_LDA(At, 0, 0); PG8_STAGEA(PG8_SA(1, 1), a1, 1, gc);
            PG8_WAIT_V(8); PG8_WAIT_L(0); PG8_BAR; PG8_MMA(0, 0, At, B0); PG8_MMA(0, 1, At, B1); PG8_BAR; PG8_SCHED;
            PG8_LDA(At, 0, 1); PG8_STAGEB(PG8_SB(0, 0), b2); PG8_STAGEB(PG8_SB(0, 1), b2 + hstep); PG8_STAGEA(PG8_SA(0, 0), a2, 0, g2);
            PG8_WAIT_V(8); PG8_WAIT_L(0); PG8_BAR; PG8_MMA(1, 0, At, B0); PG8_MMA(1, 1, At, B1); PG8_BAR; PG8_SCHED;
            PG8_LDB(B0, 1, 0); PG8_LDB(B1, 1, 1); PG8_SCHED; PG8_LDA(At, 1, 0); PG8_STAGEA(PG8_SA(0, 1), a2, 1, g2);
            PG8_WAIT_V(8); PG8_WAIT_L(0); PG8_BAR; PG8_MMA(0, 0, At, B0); PG8_MMA(0, 1, At, B1); PG8_BAR; PG8_SCHED;
            PG8_LDA(At, 1, 1); PG8_STAGEB(PG8_SB(1, 0), b3); PG8_STAGEB(PG8_SB(1, 1), b3 + hstep); PG8_STAGEA(PG8_SA(1, 0), a3, 0, g2);
            PG8_WAIT_V(8); PG8_WAIT_L(0); PG8_BAR; PG8_MMA(1, 0, At, B0); PG8_MMA(1, 1, At, B1); PG8_BAR; PG8_SCHED;
            } else {
            PG8_LDB(B0, 0, 0); PG8_SCHED; PG8_LDA(At, 0, 0); PG8_STAGEA(PG8_SA(1, 1), a1, 1, gc);
            PG8_WAIT_L(8); PG8_BAR; PG8_WAIT_L(0); PG8_MMA(0, 0, At, B0); PG8_BAR; PG8_SCHED;
            PG8_LDB(B1, 0, 1); PG8_STAGEB(PG8_SB(0, 0), b2);
            PG8_BAR; PG8_WAIT_L(0); PG8_MMA(0, 1, At, B1); PG8_BAR;
            PG8_LDA(At, 0, 1); PG8_STAGEA(PG8_SA(0, 0), a2, 0, g2);
            PG8_BAR; PG8_WAIT_L(0); PG8_MMA(1, 0, At, B0); PG8_BAR; PG8_SCHED;
            PG8_STAGEB(PG8_SB(0, 1), b2 + hstep);
            PG8_WAIT_V(6); PG8_BAR; PG8_MMA(1, 1, At, B1); PG8_BAR;
            PG8_LDB(B0, 1, 0); PG8_SCHED; PG8_LDA(At, 1, 0); PG8_STAGEA(PG8_SA(0, 1), a2, 1, g2);
            PG8_WAIT_L(8); PG8_BAR; PG8_WAIT_L(0); PG8_MMA(0, 0, At, B0); PG8_BAR; PG8_SCHED;
            PG8_LDB(B1, 1, 1); PG8_STAGEB(PG8_SB(1, 0), b3);
            PG8_BAR; PG8_WAIT_L(0); PG8_MMA(0, 1, At, B1); PG8_BAR;
            PG8_LDA(At, 1, 1); PG8_STAGEA(PG8_SA(1, 0), a3, 0, g2);
            PG8_BAR; PG8_WAIT_L(0); PG8_MMA(1, 0, At, B0); PG8_BAR; PG8_SCHED;
            PG8_STAGEB(PG8_SB(1, 1), b3 + hstep);
            PG8_WAIT_V(6); PG8_BAR; PG8_MMA(1, 1, At, B1); PG8_BAR;
            }
        }
        if constexpr (ALIGN_EPI) { if (wr == 0) PG8_BAR; }
        {
#pragma unroll
            for (int ai = 0; ai < 2; ++ai)
#pragma unroll
                for (int m = 0; m < 4; ++m) { const f32x4 v[2][2] = {{acc[ai][0][m][0], acc[ai][0][m][1]}, {acc[ai][1][m][0], acc[ai][1][m][1]}};
                    RE.row(cur, ai * HALF + wr * 64 + m * 16 + fr, wc * 32 + 4 * fq, v); asm volatile("" ::: "memory"); }
        }
        if (!has_next) break;
#pragma unroll
        for (int a = 0; a < 2; ++a)
#pragma unroll
            for (int b = 0; b < 2; ++b)
#pragma unroll
                for (int m = 0; m < 4; ++m)
#pragma unroll
                    for (int n = 0; n < 2; ++n) acc[a][b][m][n] = (f32x4){0.f, 0.f, 0.f, 0.f};
        cur = nxt; cA = nA; cB = nB; ++ui;
        if constexpr (GATHER) {
#pragma unroll
            for (int h = 0; h < 2; ++h)
#pragma unroll
                for (int i = 0; i < 2; ++i) gc[h][i] = gn[h][i];
        }
        if constexpr (ALIGN_EPI) { if (wr == 1) PG8_BAR; }
    }
    PG8_WAIT_V(0);
    if constexpr (!ALIGN_EPI) { if (wr == 0) PG8_BAR; }
    PG8_BAR;
#undef PG8_SA
#undef PG8_SB
#undef PG8_STAGE2
#undef PG8_STAGEB
#undef PG8_STAGEA
#undef PG8_LDA
#undef PG8_LDB
#undef PG8_MMA
#undef PG8_WAIT_V
#undef PG8_WAIT_L
#undef PG8_BAR
#undef PG8_SCHED
}
}
#ifndef MK_SP2
#define MK_SP2 true
#endif
#ifndef MK_ALIGN
#define MK_ALIGN true
#endif
#ifndef MK_MFMA
#define MK_MFMA 0xF
#endif
template <bool GATHER, class Sched, class Epi>
__device__ __forceinline__ void run_gemm(Frame& F, bool mfma, const Sched& S, const Epi& E, int K) {
    if (mfma) pg8::gemm_phase<Sched, Epi, GATHER, MK_ALIGN, MK_SP2>((LAS unsigned char*)F.lds, F.wsb(), S, E, K, F.tid, F.wave);
    else gemm_simple(F, S, E, K);
}

__device__ __forceinline__ void load_q64(const bf16_t* p, float (&q)[64]) {
#pragma unroll
    for (int c = 0; c < 8; ++c) { const u32x4 w = *(const u32x4*)(p + 8 * c);
        q[8 * c + 0] = bf_lo(w.x); q[8 * c + 1] = bf_hi(w.x); q[8 * c + 2] = bf_lo(w.y); q[8 * c + 3] = bf_hi(w.y);
        q[8 * c + 4] = bf_lo(w.z); q[8 * c + 5] = bf_hi(w.z); q[8 * c + 6] = bf_lo(w.w); q[8 * c + 7] = bf_hi(w.w); }
}
__device__ __forceinline__ void attn_key(const float (&q)[64], const bf16_t* kp, const bf16_t* vp, float bias, float& m, float& l, float (&o)[64]) {
    float s0 = bias, s1 = 0.f;
#pragma unroll
    for (int c = 0; c < 8; ++c) { const u32x4 w = *(const u32x4*)(kp + 8 * c);
        s0 += q[8 * c + 0] * bf_lo(w.x) + q[8 * c + 2] * bf_lo(w.y) + q[8 * c + 4] * bf_lo(w.z) + q[8 * c + 6] * bf_lo(w.w);
        s1 += q[8 * c + 1] * bf_hi(w.x) + q[8 * c + 3] * bf_hi(w.y) + q[8 * c + 5] * bf_hi(w.z) + q[8 * c + 7] * bf_hi(w.w); }
    const float s = s0 + s1;
    const float mn = fmaxf(m, s), sc = __expf(m - mn), p = __expf(s - mn);
    l = l * sc + p; m = mn;
#pragma unroll
    for (int c = 0; c < 8; ++c) { const u32x4 w = *(const u32x4*)(vp + 8 * c);
        o[8 * c + 0] = o[8 * c + 0] * sc + p * bf_lo(w.x); o[8 * c + 1] = o[8 * c + 1] * sc + p * bf_hi(w.x);
        o[8 * c + 2] = o[8 * c + 2] * sc + p * bf_lo(w.y); o[8 * c + 3] = o[8 * c + 3] * sc + p * bf_hi(w.y);
        o[8 * c + 4] = o[8 * c + 4] * sc + p * bf_lo(w.z); o[8 * c + 5] = o[8 * c + 5] * sc + p * bf_hi(w.z);
        o[8 * c + 6] = o[8 * c + 6] * sc + p * bf_lo(w.w); o[8 * c + 7] = o[8 * c + 7] * sc + p * bf_hi(w.w); }
}
__device__ __forceinline__ void attn_finish(Frame& F, int r, int ycol, int slot, float l, float (&o)[64]) {
    const float inv = 1.0f / l; float ss = 0.f;
    bf16_t* yp = F.Y() + (size_t)r * D + ycol;
#pragma unroll
    for (int c = 0; c < 8; ++c) { float t[8];
#pragma unroll
        for (int j = 0; j < 8; ++j) { t[j] = o[8 * c + j] * inv; ss += t[j] * t[j]; }
        u32x4 w; w.x = pk2(t[0], t[1]); w.y = pk2(t[2], t[3]); w.z = pk2(t[4], t[5]); w.w = pk2(t[6], t[7]);
        *(u32x4*)(yp + 8 * c) = w; }
    F.SSQ()[(size_t)r * 16 + slot] = ss;
}
__device__ __forceinline__ void attn_item(Frame& F, int l, int variant, int qb, int h) {
    const bool latent = variant < 2; const bool isA = (variant == 0 || variant == 2);
    const int r = (latent ? 0 : NLAT) + qb * NTHR + F.tid;
    const int b = latent ? (r >> 11) : ((r - NLAT) >> 8);
    const int qcol = isA ? QA + 64 * h : QN + 64 * h;
    const int kcol = isA ? KA + 64 * (h / 3) : KN + 64 * h, vcol = isA ? VA + 64 * (h / 3) : VN + 64 * h;
    float q[64], o[64];
    load_q64(F.Z() + (size_t)r * INW + qcol, q);
#pragma unroll
    for (int i = 0; i < 64; ++i) o[i] = 0.f;
    float m, ls;
    if (isA) { m = F.inp(IN_SINK)[l * 6 + h]; ls = 1.0f; } else { m = NEGF; ls = 0.f; }
    const bf16_t* zc = F.Z() + (size_t)(NLAT + b * CTXL) * INW;
#pragma unroll 1
    for (int c = 0; c < CTXL; ++c) attn_key(q, zc + (size_t)c * INW + kcol, zc + (size_t)c * INW + vcol, 0.f, m, ls, o);
    if (variant == 0) {
        const int t = r & (SEQ - 1); const int lo = max(0, t - 128), hi = min(SEQ - 1, t + 128);
        const bf16_t* zb = F.Z() + (size_t)(b * SEQ) * INW;
#pragma unroll 1
        for (int kp = lo; kp <= hi; ++kp) attn_key(q, zb + (size_t)kp * INW + kcol, zb + (size_t)kp * INW + vcol, 0.f, m, ls, o);
    } else if (variant == 1) {
        const int t = r & (SEQ - 1), row = t >> 6, col = t & 63;
        const int rs = min(max(row - 4, 0), 24), cs = min(max(col - 8, 0), 48);
        const bf16_t* zb = F.Z() + (size_t)(b * SEQ) * INW;
        const float* rpb = F.inp(IN_RPB) + (size_t)(l * 6 + h) * 15 * 31;
#pragma unroll 1
        for (int j = 0; j < 8; ++j)
#pragma unroll 1
            for (int cc = 0; cc < 16; ++cc) { const int kr = rs + j, kc = cs + cc; const size_t ko = (size_t)(kr * 64 + kc) * INW;
                const float bias = rpb[(kr - row + 7) * 31 + (kc - col + 15)];
                attn_key(q, zb + ko + kcol, zb + ko + vcol, bias, m, ls, o); }
    }
    attn_finish(F, r, (isA ? 0 : 640) + 64 * h, (isA ? 0 : 10) + h, ls, o);
}

typedef short bf16x8 __attribute__((ext_vector_type(8)));
typedef short s16x4 __attribute__((ext_vector_type(4)));
struct QS { bf16x8 q0, q1; float m, l; f32x4 o[4]; };
__device__ __forceinline__ void qs_init(QS& T, const bf16_t* qp, int g, float m0, float l0) {
    T.q0 = *(const bf16x8*)(qp + 8 * g); T.q1 = *(const bf16x8*)(qp + 32 + 8 * g); T.m = m0; T.l = l0;
#pragma unroll
    for (int d = 0; d < 4; ++d) T.o[d] = (f32x4){0.f, 0.f, 0.f, 0.f};
}
__device__ __forceinline__ s16x4 lds_tr(LAS unsigned char* p) { return __builtin_bit_cast(s16x4, __builtin_amdgcn_ds_read_tr16_b64_v4i16((LAS s16x4*)p)); }
__device__ __forceinline__ void stage_kv(const bf16_t* Z, int zrow0, int nkeys, int kcol, int vcol, LAS unsigned char* Kl, LAS unsigned char* Vl, int tid) {
    for (int idx = tid; idx < nkeys * 8; idx += NTHR) {
        const int kk = idx >> 3, c = idx & 7;
        const bf16_t* zr = Z + (size_t)(zrow0 + kk) * INW;
        const u32x4 kv = *(const u32x4*)(zr + kcol + 8 * c), vv = *(const u32x4*)(zr + vcol + 8 * c);
        *(LAS u32x4*)(Kl + kk * 128 + ((c ^ (kk & 7)) << 4)) = kv;
        *(LAS u32x4*)(Vl + kk * 128 + ((((c >> 1) ^ ((kk >> 1) & 3)) << 5) | ((c & 1) << 4))) = vv;
    }
}
template <class MF>
__device__ __forceinline__ void attn_tile64(QS& T, LAS unsigned char* Kt, LAS unsigned char* Vt, int i, int g, const MF& mf, int kt_lo, int kt_hi) {
    f32x4 s[4];
#pragma unroll
    for (int kt = 0; kt < 4; ++kt) {
        if (kt >= kt_lo && kt <= kt_hi) {
            LAS unsigned char* kr = Kt + (kt * 16 + i) * 128;
            const bf16x8 k0 = *(const LAS bf16x8*)(kr + ((g ^ (i & 7)) << 4)), k1 = *(const LAS bf16x8*)(kr + (((4 + g) ^ (i & 7)) << 4));
            f32x4 a = (f32x4){0.f, 0.f, 0.f, 0.f};
            a = __builtin_amdgcn_mfma_f32_16x16x32_bf16(k0, T.q0, a, 0, 0, 0);
            a = __builtin_amdgcn_mfma_f32_16x16x32_bf16(k1, T.q1, a, 0, 0, 0);
            s[kt] = (f32x4){mf(kt, 0, a.x), mf(kt, 1, a.y), mf(kt, 2, a.z), mf(kt, 3, a.w)};
        } else s[kt] = (f32x4){NEGF, NEGF, NEGF, NEGF};
    }
    float mx = fmaxf(fmaxf(fmaxf(s[0].x, s[0].y), fmaxf(s[0].z, s[0].w)), fmaxf(fmaxf(s[1].x, s[1].y), fmaxf(s[1].z, s[1].w)));
    mx = fmaxf(mx, fmaxf(fmaxf(fmaxf(s[2].x, s[2].y), fmaxf(s[2].z, s[2].w)), fmaxf(fmaxf(s[3].x, s[3].y), fmaxf(s[3].z, s[3].w))));
    mx = fmaxf(mx, __shfl_xor(mx, 16)); mx = fmaxf(mx, __shfl_xor(mx, 32));
    const float mn = fmaxf(T.m, mx), sc = __expf(T.m - mn);
    T.m = mn;
    float ps = 0.f;
#pragma unroll
    for (int kt = 0; kt < 4; ++kt) { s[kt].x = __expf(s[kt].x - mn); s[kt].y = __expf(s[kt].y - mn); s[kt].z = __expf(s[kt].z - mn); s[kt].w = __expf(s[kt].w - mn);
        ps += (s[kt].x + s[kt].y) + (s[kt].z + s[kt].w); }
    T.l = T.l * sc + ps;
#pragma unroll
    for (int d = 0; d < 4; ++d) T.o[d] = T.o[d] * sc;
#pragma unroll
    for (int c = 0; c < 2; ++c) {
        if (2 * c + 1 >= kt_lo && 2 * c <= kt_hi) {
            u32x4 pw; pw.x = pk2(s[2 * c].x, s[2 * c].y); pw.y = pk2(s[2 * c].z, s[2 * c].w); pw.z = pk2(s[2 * c + 1].x, s[2 * c + 1].y); pw.w = pk2(s[2 * c + 1].z, s[2 * c + 1].w);
            const bf16x8 pf = __builtin_bit_cast(bf16x8, pw);
            const int key = 32 * c + 4 * g + (i >> 2);
            LAS unsigned char* vr = Vt + key * 128 + (i & 3) * 8;
            const int sw = (key >> 1) & 3;
#pragma unroll
            for (int dt = 0; dt < 4; ++dt) {
                LAS unsigned char* va = vr + ((dt ^ sw) << 5);
                const s16x4 lo = lds_tr(va), hi = lds_tr(va + 2048);
                const bf16x8 vf = {lo[0], lo[1], lo[2], lo[3], hi[0], hi[1], hi[2], hi[3]};
                T.o[dt] = __builtin_amdgcn_mfma_f32_16x16x32_bf16(vf, pf, T.o[dt], 0, 0, 0);
            }
        }
    }
}
__device__ __forceinline__ void qs_finish(const QS& T, float lsum, bf16_t* Y, float* SSQ, int yrow, int ycol, int slot, int g) {
    const float inv = 1.0f / lsum; float ss = 0.f;
    bf16_t* yp = Y + (size_t)yrow * D + ycol + 4 * g;
#pragma unroll
    for (int dt = 0; dt < 4; ++dt) { const f32x4 v = T.o[dt] * inv; ss += (v.x * v.x + v.y * v.y) + (v.z * v.z + v.w * v.w);
        u32x2 w; w.x = pk2(v.x, v.y); w.y = pk2(v.z, v.w); *(u32x2*)(yp + 16 * dt) = w; }
    ss += __shfl_xor(ss, 16); ss += __shfl_xor(ss, 32);
    if (g == 0) SSQ[(size_t)yrow * 16 + slot] = ss;
}
struct MaskNone { __device__ __forceinline__ float operator()(int, int, float s) const { return s; } };
struct MaskBand { int kb4g, qp;
    __device__ __forceinline__ float operator()(int kt, int r, float s) const { const int d = kb4g + 16 * kt + r - qp; return (d >= -128 && d <= 128) ? s : NEGF; } };
struct MaskNA { const LAS float* rp; int g4, cq, cs;
    __device__ __forceinline__ float operator()(int kt, int r, float s) const { const int kc = 16 * kt + g4 + r; return (kc >= cs && kc < cs + 16) ? s + rp[kc - cq + 15] : NEGF; } };

__device__ __forceinline__ void attnA_item(Frame& F, int l, int b, int n, int half, int kvh) {
    LAS unsigned char* L = (LAS unsigned char*)F.lds;
    const int lane = F.tid & 63, i = lane & 15, g = lane >> 4, w = F.wave;
    const bool latent = n >= 0;
    const int qrow0 = latent ? b * SEQ + n * 128 : NLAT + b * CTXL + half * 128;
    const bf16_t* Z = F.Z();
    QS T[3];
#pragma unroll
    for (int j = 0; j < 3; ++j) { const int tq = 3 * w + j, hq = 3 * kvh + (tq >> 3);
        qs_init(T[j], Z + (size_t)(qrow0 + (tq & 7) * 16 + i) * INW + QA + 64 * hq, g, F.inp(IN_SINK)[l * 6 + hq], g == 0 ? 1.0f : 0.f); }
    __syncthreads();
    stage_kv(Z, NLAT + b * CTXL, CTXL, KA + 64 * kvh, VA + 64 * kvh, L, L + 32768, F.tid);
    __syncthreads();
#pragma unroll
    for (int j = 0; j < 3; ++j)
#pragma unroll 1
        for (int t = 0; t < 4; ++t) attn_tile64(T[j], L + t * 8192, L + 32768 + t * 8192, i, g, MaskNone(), 0, 3);
    if (latent) {
        const int j_lo = (n == 0) ? 2 : 0, j_hi = (n == SEQ / 128 - 1) ? 3 : 5;
        __syncthreads();
        stage_kv(Z, b * SEQ + (n - 1) * 128 + 64 * j_lo, 64 * (j_hi - j_lo + 1), KA + 64 * kvh, VA + 64 * kvh, L + j_lo * 8192, L + 49152 + j_lo * 8192, F.tid);
        __syncthreads();
#pragma unroll
        for (int j = 0; j < 3; ++j) { const int tq = 3 * w + j, qp0 = n * 128 + (tq & 7) * 16;
#pragma unroll 1
            for (int t = j_lo; t <= j_hi; ++t) { const int kb = (n - 1) * 128 + 64 * t;
                if (kb + 63 < qp0 - 128 || kb > qp0 + 15 + 128) continue;
                attn_tile64(T[j], L + t * 8192, L + 49152 + t * 8192, i, g, MaskBand{kb + 4 * g, qp0 + i}, 0, 3); } }
    }
#pragma unroll
    for (int j = 0; j < 3; ++j) { const int tq = 3 * w + j, hq = 3 * kvh + (tq >> 3);
        float ls = T[j].l; ls += __shfl_xor(ls, 16); ls += __shfl_xor(ls, 32);
        qs_finish(T[j], ls, F.Y(), F.SSQ(), qrow0 + (tq & 7) * 16 + i, 64 * hq, hq, g); }
}
constexpr int RPB_OFF = RING_BYTES + 4096;
__device__ __forceinline__ void attnC_item(Frame& F, int l, int b, int rr, int quarter, int h) {
    LAS unsigned char* L = (LAS unsigned char*)F.lds;
    const int lane = F.tid & 63, i = lane & 15, g = lane >> 4, w = F.wave, qt = w & 3, part = w >> 2;
    const bool latent = rr >= 0;
    const int qrow = (latent ? b * SEQ + rr * 64 : NLAT + b * CTXL + quarter * 64) + qt * 16 + i;
    const bf16_t* Z = F.Z();
    QS T; qs_init(T, Z + (size_t)qrow * INW + QN + 64 * h, g, NEGF, 0.f);
    __syncthreads();
    stage_kv(Z, NLAT + b * CTXL, CTXL, KN + 64 * h, VN + 64 * h, L, L + 32768, F.tid);
    if (latent) { LAS float* rl = (LAS float*)(L + RPB_OFF); const float* rg = F.inp(IN_RPB) + (size_t)(l * 6 + h) * 15 * 31;
        for (int x = F.tid; x < 15 * 31; x += NTHR) rl[x] = rg[x]; }
    __syncthreads();
#pragma unroll 1
    for (int t = 2 * part; t < 2 * part + 2; ++t) attn_tile64(T, L + t * 8192, L + 32768 + t * 8192, i, g, MaskNone(), 0, 3);
    if (latent) {
        const int rs = min(max(rr - 4, 0), SEQ / 64 - 8);
        __syncthreads();
        stage_kv(Z, b * SEQ + rs * 64, 512, KN + 64 * h, VN + 64 * h, L, L + 65536, F.tid);
        __syncthreads();
        const int cq = qt * 16 + i, cs = min(max(cq - 8, 0), 48);
        const int kt_lo = qt < 2 ? 0 : qt - 1, kt_hi = qt == 0 ? 1 : (qt == 1 ? 2 : 3);
#pragma unroll 1
        for (int j = 4 * part; j < 4 * part + 4; ++j)
            attn_tile64(T, L + j * 8192, L + 65536 + j * 8192, i, g, MaskNA{(const LAS float*)(L + RPB_OFF) + (rs + j - rr + 7) * 31, 4 * g, cq, cs}, kt_lo, kt_hi);
    }
    __syncthreads();
    LAS float* mg = (LAS float*)L + qt * (18 * 64);
    if (part == 1) { mg[0 * 64 + lane] = T.m; mg[1 * 64 + lane] = T.l;
#pragma unroll
        for (int d = 0; d < 4; ++d) { mg[(2 + 4 * d + 0) * 64 + lane] = T.o[d].x; mg[(2 + 4 * d + 1) * 64 + lane] = T.o[d].y; mg[(2 + 4 * d + 2) * 64 + lane] = T.o[d].z; mg[(2 + 4 * d + 3) * 64 + lane] = T.o[d].w; } }
    __syncthreads();
    if (part == 0) {
        const float mb = mg[0 * 64 + lane], lb = mg[1 * 64 + lane];
        const float mn = fmaxf(T.m, mb), sa = __expf(T.m - mn), sb = __expf(mb - mn);
        float ls = T.l * sa + lb * sb;
#pragma unroll
        for (int d = 0; d < 4; ++d) { const f32x4 ob = {mg[(2 + 4 * d + 0) * 64 + lane], mg[(2 + 4 * d + 1) * 64 + lane], mg[(2 + 4 * d + 2) * 64 + lane], mg[(2 + 4 * d + 3) * 64 + lane]};
            T.o[d] = T.o[d] * sa + ob * sb; }
        ls += __shfl_xor(ls, 16); ls += __shfl_xor(ls, 32);
        qs_finish(T, ls, F.Y(), F.SSQ(), qrow, 640 + 64 * h, 10 + h, g);
    }
}
__device__ __forceinline__ void sgu_item(Frame& F, int l, int ch, int g) {
    float* vg = (float*)F.lds;
    const int row0 = ch < 128 ? ch * 128 : NLAT + (ch - 128) * 128;
    const int p = F.tid >> 2, dq = F.tid & 3;
    __syncthreads();
    {
        const bf16_t* zp = F.Z() + (size_t)(row0 + p) * INW + VB + 64 * g + 16 * dq;
        const u32x4 w0 = *(const u32x4*)zp, w1 = *(const u32x4*)(zp + 8);
        float t[16] = {bf_lo(w0.x), bf_hi(w0.x), bf_lo(w0.y), bf_hi(w0.y), bf_lo(w0.z), bf_hi(w0.z), bf_lo(w0.w), bf_hi(w0.w),
                       bf_lo(w1.x), bf_hi(w1.x), bf_lo(w1.y), bf_hi(w1.y), bf_lo(w1.z), bf_hi(w1.z), bf_lo(w1.w), bf_hi(w1.w)};
        float ss = 0.f;
#pragma unroll
        for (int i = 0; i < 16; ++i) ss += t[i] * t[i];
        ss += __shfl_xor(ss, 1); ss += __shfl_xor(ss, 2);
        const float rstd = 1.0f / sqrtf(ss * (1.0f / 64.0f) + EPS);
        const float* ng = F.inp(IN_SGUG) + l * 256 + 64 * g + 16 * dq;
#pragma unroll
        for (int i = 0; i < 16; ++i) vg[p * 65 + 16 * dq + i] = t[i] * rstd * ng[i];
    }
    __syncthreads();
    float acc[16];
#pragma unroll
    for (int i = 0; i < 16; ++i) acc[i] = 0.f;
    const float* ws = F.inp(IN_SGUW) + ((size_t)(l * 4 + g) * 128 + p) * 128;
#pragma unroll 4
    for (int qq = 0; qq < 128; ++qq) { const float w = ws[qq];
#pragma unroll
        for (int i = 0; i < 16; ++i) acc[i] += w * vg[qq * 65 + 16 * dq + i]; }
    const float bs = F.inp(IN_SGUB)[(l * 4 + g) * 128 + p];
    const bf16_t* up = F.Z() + (size_t)(row0 + p) * INW + UB + 64 * g + 16 * dq;
    const u32x4 u0 = *(const u32x4*)up, u1 = *(const u32x4*)(up + 8);
    const float uu[16] = {bf_lo(u0.x), bf_hi(u0.x), bf_lo(u0.y), bf_hi(u0.y), bf_lo(u0.z), bf_hi(u0.z), bf_lo(u0.w), bf_hi(u0.w),
                          bf_lo(u1.x), bf_hi(u1.x), bf_lo(u1.y), bf_hi(u1.y), bf_lo(u1.z), bf_hi(u1.z), bf_lo(u1.w), bf_hi(u1.w)};
    float ss = 0.f;
#pragma unroll
    for (int i = 0; i < 16; ++i) { acc[i] = uu[i] * (acc[i] + bs); ss += acc[i] * acc[i]; }
    ss += __shfl_xor(ss, 1); ss += __shfl_xor(ss, 2);
    bf16_t* yp = F.Y() + (size_t)(row0 + p) * D + 384 + 64 * g + 16 * dq;
    u32x4 o0, o1; o0.x = pk2(acc[0], acc[1]); o0.y = pk2(acc[2], acc[3]); o0.z = pk2(acc[4], acc[5]); o0.w = pk2(acc[6], acc[7]);
    o1.x = pk2(acc[8], acc[9]); o1.y = pk2(acc[10], acc[11]); o1.z = pk2(acc[12], acc[13]); o1.w = pk2(acc[14], acc[15]);
    *(u32x4*)yp = o0; *(u32x4*)(yp + 8) = o1;
    if (dq == 0) F.SSQ()[(size_t)(row0 + p) * 16 + 6 + g] = ss;
}
#ifndef MK_MIXREF
#define MK_MIXREF 0
#endif
__device__ __forceinline__ void phase_mix(Frame& F, int l) {
    const bool refA = (MK_MIXREF & 1) != 0, refC = (MK_MIXREF & 2) != 0;
    const int nC = refC ? 192 : NB * 6 * (SEQ / 64), nA = refA ? 192 : NB * (SEQ / 128) * 2, nS = 512;
    const int nAc = (l == 0) ? (refA ? 24 : NB * 2 * 2) : 0, nCc = (l == 0) ? (refC ? 24 : NB * 6 * 4) : 0, nSc = (l == 0) ? 64 : 0;
    const int total = nA + nC + nS + nAc + nCc + nSc;
    for (int it = F.bid; it < total; it += F.G) {
        int r = it;
        if (r < nC) { if (refC) attn_item(F, l, 1, r / 6, r % 6); else { const int h = r % 6, q = r / 6; attnC_item(F, l, q >> 5, q & 31, 0, h); } continue; } r -= nC;
        if (r < nA) { if (refA) attn_item(F, l, 0, r / 6, r % 6); else { const int kvh = r & 1, q = r >> 1; attnA_item(F, l, q >> 4, q & 15, 0, kvh); } continue; } r -= nA;
        if (r < nS) { sgu_item(F, l, r >> 2, r & 3); continue; } r -= nS;
        if (r < nAc) { if (refA) attn_item(F, l, 2, r / 6, r % 6); else { const int kvh = r & 1, hf = (r >> 1) & 1, b = r >> 2; attnA_item(F, l, b, -1, hf, kvh); } continue; } r -= nAc;
        if (r < nCc) { if (refC) attn_item(F, l, 3, r / 6, r % 6); else { const int h = r % 6, q = r / 6; attnC_item(F, l, q >> 2, -1, q & 3, h); } continue; } r -= nCc;
        sgu_item(F, l, 128 + (r >> 2), r & 3);
    }
    __syncthreads();
}

__global__ void __launch_bounds__(NTHR, 2) mk_fwd(Params P) {
    extern __shared__ __attribute__((aligned(16))) unsigned char lds[];
    Frame F;
    F.lds = lds; F.tid = threadIdx.x; F.lane = F.tid & 63; F.wave = __builtin_amdgcn_readfirstlane(F.tid >> 6); F.bid = blockIdx.x; F.G = gridDim.x;
    F.P = &P;
    volatile LAS unsigned* MISC = (volatile LAS unsigned*)((LAS unsigned char*)lds + MISC_OFF);
    for (int u = F.tid; u < (LDS_BYTES - RING_BYTES) / 4; u += NTHR) ((LAS unsigned*)((LAS unsigned char*)lds + RING_BYTES))[u] = 0u;
    __syncthreads();
    XcdBarrier bar = xcd_barrier_post(F.ctl() + CW_BAR, MISC + 8);
#define LAUNDER() do { asm volatile("" : "+v"(F.tid)); asm volatile("" : "+v"(F.lane)); asm volatile("" : "+s"(F.bid)); asm volatile("" : "+s"(F.wave)); } while (0)

#pragma unroll 1
    for (int ph = 0; ph < 18; ++ph) {
        LAUNDER();
        const int l = ph < 2 ? 0 : (ph - 2) >> 3;
        const int k = ph < 2 ? ph - 2 : (ph - 2) & 7;
        const int nrows = (l == 0) ? NTOK : NLAT;
        if (k == -2) p0_prologue(F);
        else if (k == -1) phase_r1(F, 0);
        else if (k == 0) {
            SchedDense S{F.H1(), F.WIN() + (size_t)l * INW * D, D, NTOK / 256, INW / 256, F.G, F.bid, F.wsb()};
            EpiG1 E{F.Z(), F.ROPE()};
            run_gemm<false>(F, (MK_MFMA & 1) != 0, S, E, D);
            if (l == 1) conv_experts(F, 1);
        } else if (k == 1) phase_mix(F, l);
        else if (k == 2) phase_nrm(F, l, nrows);
        else if (k == 3) {
            SchedDense S{F.Y(), F.WOUT() + (size_t)l * D * D, D, nrows / 256, D / 256, F.G, F.bid, F.wsb()};
            EpiG2 E{l == 0 ? F.inp(IN_X) : F.outp(), l == 0 ? F.inp(IN_CTX) : F.XC(), F.outp(), F.XC(), F.MOD(), l};
            run_gemm<false>(F, (MK_MFMA & 2) != 0, S, E, D);
        } else if (k == 4) phase_r2(F, l, nrows);
        else if (k == 5) {
            moe_build_tab(F, l, nrows);
            const MoeTab T{(const int*)(F.lds + TOFF_OFF), (const int*)(F.lds + TOFF_OFF) + 72};
            SchedE1 S{T, F.LIST(), F.H1(), F.WEXPGU(), F.WSHGU() + (size_t)l * 512 * D, F.G, F.bid, F.wsb()};
            EpiE1 E{F.HB()};
            run_gemm<true>(F, (MK_MFMA & 4) != 0, S, E, D);
        } else if (k == 6) {
            moe_build_tab(F, l, nrows);
            const MoeTab T{(const int*)(F.lds + TOFF_OFF), (const int*)(F.lds + TOFF_OFF) + 72};
            SchedE2 S{T, F.HB(), F.WEXPD(), F.WSHD() + (size_t)l * D * FF, F.G, F.bid, F.wsb()};
            EpiE2 E{T, F.LIST(), F.LISTW(), F.Y2(), F.outp(), F.XC(), F.MOD(), l};
            run_gemm<false>(F, (MK_MFMA & 8) != 0, S, E, FF);
        } else phase_cmb(F, l, nrows);
        if (ph != 17) xcd_barrier(bar);
    }
}

extern "C" void kernel_launch(void* const* d_in, const int* in_sizes, int n_in, void* d_out, int out_size, void* d_ws, size_t ws_size, hipStream_t stream) {
    static int grid = 0;
    if (grid == 0) {
        if (n_in != N_IN || in_sizes[0] != NLAT * D || out_size != NLAT * D || ws_size < WS_END) {
            fprintf(stderr, "kernel_launch: unexpected shapes / workspace (n_in %d, in0 %d, out %d, ws %zu need %zu); nothing launched\n", n_in, n_in > 0 ? in_sizes[0] : -1, out_size, ws_size, (size_t)WS_END);
            grid = -1; return; }
        int dev = 0, cus = 0, per_cu = 0;
        if (hipGetDevice(&dev) != hipSuccess || hipDeviceGetAttribute(&cus, hipDeviceAttributeMultiprocessorCount, dev) != hipSuccess) { grid = -1; return; }
        if (hipFuncSetAttribute((const void*)mk_fwd, hipFuncAttributeMaxDynamicSharedMemorySize, LDS_BYTES) != hipSuccess) { fprintf(stderr, "kernel_launch: hipFuncSetAttribute failed\n"); grid = -1; return; }
        if (hipOccupancyMaxActiveBlocksPerMultiprocessor(&per_cu, (const void*)mk_fwd, NTHR, LDS_BYTES) != hipSuccess || per_cu < 1) { fprintf(stderr, "kernel_launch: occupancy query says %d blocks/CU; nothing launched\n", per_cu); grid = -1; return; }
        (void)hipGetLastError();
        grid = cus;
    }
    if (grid < 0) return;
    if (hipMemsetAsync((char*)d_ws + WS_CTL, 0, CTL_ZERO_BYTES, stream) != hipSuccess) return;
    Params p{};
    for (int i = 0; i < N_IN; ++i) p.in[i] = (const float*)d_in[i];
    p.out = (float*)d_out; p.ws = (unsigned char*)d_ws;
    hipLaunchKernelGGL(mk_fwd, dim3(grid), dim3(NTHR), LDS_BYTES, stream, p);
}
```

```cpp
#include <hip/hip_runtime.h>
#include <cstdio>
#include <cstdint>

#define LAS __attribute__((address_space(3)))
typedef unsigned short bf16_t;
typedef float f32x4 __attribute__((ext_vector_type(4)));
typedef float f32x2 __attribute__((ext_vector_type(2)));
typedef unsigned u32x4 __attribute__((ext_vector_type(4)));
typedef unsigned u32x2 __attribute__((ext_vector_type(2)));
typedef __bf16 bf16x2_t __attribute__((ext_vector_type(2)));

constexpr int D = 1024, NB = 8, SEQ = 2048, CTXL = 256, HD = 64, INW = 2304, NE = 64, FF = 256, DEPTH = 2;
constexpr int NLAT = NB * SEQ, NCTX = NB * CTXL, NTOK = NLAT + NCTX;
constexpr int QA = 0, KA = 384, VA = 512, UB = 640, VB = 896, QN = 1152, KN = 1536, VN = 1920;
constexpr float EPS = 1e-6f, NEGF = -1e30f;
constexpr int NWAVES = 8, NTHR = 512;
enum { IN_X = 0, IN_C, IN_CTX, IN_CCTX, IN_MODW, IN_MODB, IN_N1G, IN_WIN, IN_SINK, IN_SGUG, IN_SGUW, IN_SGUB, IN_RPB, IN_GNG, IN_WOUT, IN_N2G,
       IN_RW, IN_RB, IN_EG, IN_EU, IN_ED, IN_SG, IN_SU, IN_SD, IN_FG, N_IN };

constexpr size_t MiB = 1u << 20;
constexpr size_t WS_CTL = 0, CTL_ZERO_BYTES = 64 * 1024;
constexpr size_t WS_MOD = 1 * MiB;
constexpr size_t WS_ROPE = 1 * MiB + 512 * 1024;
constexpr size_t WS_WIN = 2 * MiB;
constexpr size_t WS_WOUT = 11 * MiB;
constexpr size_t WS_WSHGU = 15 * MiB;
constexpr size_t WS_WSHD = 17 * MiB;
constexpr size_t WS_XC = 18 * MiB;
constexpr size_t WS_LIST = 26 * MiB;
constexpr size_t WS_LISTW = 26 * MiB + 4608 * 1024;
constexpr size_t WS_RWT = 35 * MiB;
constexpr size_t WS_H1 = 36 * MiB;
constexpr size_t WS_WEXPD = 72 * MiB;
constexpr size_t WS_ZH = 104 * MiB;
constexpr size_t WS_HLO = WS_ZH;
constexpr size_t WS_PL = WS_ZH + 40 * MiB;
constexpr size_t WS_Y2 = 194 * MiB;
constexpr size_t WS_Y = WS_Y2;
constexpr size_t WS_SSQ = WS_Y2 + 36 * MiB;
constexpr size_t WS_WEXPGU = WS_Y2 + 38 * MiB;
constexpr size_t WS_END = WS_Y2 + 288 * MiB;
constexpr int LIST_CAP = NTOK;
constexpr int CW_BAR = 4096, CW_CNT = 8192;

constexpr int RING_BYTES = 147456, MISC_OFF = RING_BYTES + 320, TOFF_OFF = RING_BYTES + 1024, LDS_BYTES = 163840;

__device__ __forceinline__ unsigned pk2(float lo, float hi) { f32x2 v = {lo, hi}; bf16x2_t b = __builtin_convertvector(v, bf16x2_t); return __builtin_bit_cast(unsigned, b); }
__device__ __forceinline__ float bf_lo(unsigned w) { return __uint_as_float(w << 16); }
__device__ __forceinline__ float bf_hi(unsigned w) { return __uint_as_float(w & 0xffff0000u); }
__device__ __forceinline__ float wave_sum(float v) {
#pragma unroll
    for (int o = 1; o < 64; o <<= 1) v += __shfl_xor(v, o);
    return v;
}
__device__ __forceinline__ float gelu_tanh(float x) {
    const float u = 0.7978845608028654f * (x + 0.044715f * x * x * x);
    const float e = __expf(2.f * u);
    const float t = 1.f - 2.f / (e + 1.f);
    return 0.5f * x * (1.f + t);
}
__device__ __forceinline__ float silu_f(float x) { return x / (1.f + __expf(-x)); }

#define XB_TMO      128
#define XB_XCNT(j)  (256  + 64 * (j))
#define XB_XSUB(j)  (1280 + 64 * (j))
#define XB_XGEN(j)  (2304 + 64 * (j))
#define XB_TOP      3328
#define XB_TOPGEN   3392
#define XCD_BAR_WORDS 3456
#define XB_SPIN_CAP (1u << 18)
__device__ __forceinline__ unsigned xb_ld(unsigned* p)              { return __hip_atomic_load(p, __ATOMIC_RELAXED, __HIP_MEMORY_SCOPE_AGENT); }
__device__ __forceinline__ unsigned xb_add(unsigned* p, unsigned v) { return __hip_atomic_fetch_add(p, v, __ATOMIC_RELAXED, __HIP_MEMORY_SCOPE_AGENT); }
__device__ __forceinline__ unsigned xb_xcc_id() { return (unsigned)__builtin_amdgcn_s_getreg((3 << 11) | 20) & 0xFu; }
#define XB_SPIN(cond, bar) do { unsigned _sp = 0; while (cond) { __builtin_amdgcn_s_sleep(1); \
    if ((++_sp & 255u) == 0u) { if (xb_ld(&(bar)[XB_TMO])) break; if (_sp > XB_SPIN_CAP) { atomicAdd(&(bar)[XB_TMO], 1u); break; } } } } while (0)
struct XcdBarrier { unsigned* bar; unsigned x; volatile LAS unsigned* st; };
__device__ __forceinline__ XcdBarrier xcd_barrier_post(unsigned* bar, volatile LAS unsigned* st) {
    XcdBarrier b; b.bar = bar; b.x = xb_xcc_id(); b.st = st;
    if (threadIdx.x == 0) (void)xb_add(&bar[XB_XCNT(b.x)], 1u);
    return b;
}
__device__ __forceinline__ void xcd_barrier_complete(unsigned* bar, unsigned x, unsigned& nloc, unsigned& nx) {
    const unsigned G = gridDim.x * gridDim.y * gridDim.z;
    unsigned sum, cnt, mine, sp = 0u;
    for (;;) {
        sum = 0u; cnt = 0u; mine = 0u;
#pragma unroll 1
        for (unsigned j = 0; j < 16; ++j) { const unsigned c = xb_ld(&bar[XB_XCNT(j)]); sum += c; cnt += (c > 0u) ? 1u : 0u; mine = (j == x) ? c : mine; }
        if (sum == G) break;
        __builtin_amdgcn_s_sleep(1);
        if ((++sp & 255u) == 0u) { if (xb_ld(&bar[XB_TMO])) break; if (sp > XB_SPIN_CAP) { atomicAdd(&bar[XB_TMO], 1u); break; } }
    }
    nloc = mine > 0u ? mine : 1u; nx = cnt > 0u ? cnt : 1u;
}
__device__ __forceinline__ void xcd_barrier(const XcdBarrier& b) {
    asm volatile("s_waitcnt vmcnt(0)" ::: "memory");
    __syncthreads();
    if (threadIdx.x == 0) {
        unsigned* bar = b.bar;
        __builtin_amdgcn_s_waitcnt(0);
        unsigned nloc = b.st[0], nx = b.st[1];
        if (nloc == 0u) { xcd_barrier_complete(bar, b.x, nloc, nx); b.st[0] = nloc; b.st[1] = nx; }
        const unsigned old = xb_add(&bar[XB_XSUB(b.x)], 1u);
        const unsigned gen = old / nloc;
        if (old + 1u == (gen + 1u) * nloc) {
            __builtin_amdgcn_fence(__ATOMIC_RELEASE, "agent");
            asm volatile("s_waitcnt vmcnt(0)" ::: "memory");
            const unsigned og = xb_add(&bar[XB_TOP], 1u);
            const unsigned tg = og / nx;
            if (og + 1u == (tg + 1u) * nx) xb_add(&bar[XB_TOPGEN], 1u);
            else XB_SPIN(xb_ld(&bar[XB_TOPGEN]) == tg, bar);
            __builtin_amdgcn_fence(__ATOMIC_ACQUIRE, "agent");
            xb_add(&bar[XB_XGEN(b.x)], 1u);
            asm volatile("s_waitcnt vmcnt(0)" ::: "memory");
        } else {
            XB_SPIN(xb_ld(&bar[XB_XGEN(b.x)]) == gen, bar);
            __builtin_amdgcn_fence(__ATOMIC_ACQUIRE, "agent");
            asm volatile("s_waitcnt vmcnt(0)" ::: "memory");
        }
    }
    __syncthreads();
}

struct Params { const float* in[N_IN]; float* out; unsigned char* ws; };

struct Frame {
    unsigned char* lds;
    int tid, lane, wave, bid, G;
    const Params* P;
    __device__ __forceinline__ const float* inp(int i) const { return P->in[i]; }
    __device__ __forceinline__ float* outp() const { return P->out; }
    __device__ __forceinline__ unsigned char* wsb() const { return P->ws; }
    __device__ __forceinline__ unsigned* ctl() const { return (unsigned*)(P->ws + WS_CTL); }
    __device__ __forceinline__ float* MOD() const { return (float*)(P->ws + WS_MOD); }
    __device__ __forceinline__ float* ROPE() const { return (float*)(P->ws + WS_ROPE); }
    __device__ __forceinline__ bf16_t* WIN() const { return (bf16_t*)(P->ws + WS_WIN); }
    __device__ __forceinline__ bf16_t* WOUT() const { return (bf16_t*)(P->ws + WS_WOUT); }
    __device__ __forceinline__ bf16_t* WSHGU() const { return (bf16_t*)(P->ws + WS_WSHGU); }
    __device__ __forceinline__ bf16_t* WSHD() const { return (bf16_t*)(P->ws + WS_WSHD); }
    __device__ __forceinline__ bf16_t* WEXPGU() const { return (bf16_t*)(P->ws + WS_WEXPGU); }
    __device__ __forceinline__ bf16_t* WEXPD() const { return (bf16_t*)(P->ws + WS_WEXPD); }
    __device__ __forceinline__ bf16_t* H1() const { return (bf16_t*)(P->ws + WS_H1); }
    __device__ __forceinline__ bf16_t* HLO() const { return (bf16_t*)(P->ws + WS_HLO); }
    __device__ __forceinline__ bf16_t* RWT() const { return (bf16_t*)(P->ws + WS_RWT); }
    __device__ __forceinline__ float* PL() const { return (float*)(P->ws + WS_PL); }
    __device__ __forceinline__ bf16_t* Z() const { return (bf16_t*)(P->ws + WS_ZH); }
    __device__ __forceinline__ bf16_t* HB() const { return (bf16_t*)(P->ws + WS_ZH); }
    __device__ __forceinline__ bf16_t* Y() const { return (bf16_t*)(P->ws + WS_Y); }
    __device__ __forceinline__ bf16_t* Y2() const { return (bf16_t*)(P->ws + WS_Y2); }
    __device__ __forceinline__ float* XC() const { return (float*)(P->ws + WS_XC); }
    __device__ __forceinline__ float* SSQ() const { return (float*)(P->ws + WS_SSQ); }
    __device__ __forceinline__ float* LISTW() const { return (float*)(P->ws + WS_LISTW); }
    __device__ __forceinline__ unsigned* LIST() const { return (unsigned*)(P->ws + WS_LIST); }
};
__device__ __forceinline__ float* xa_row(const Frame& F, int r) { return r < NLAT ? F.outp() + (size_t)r * D : F.XC() + (size_t)(r - NLAT) * D; }
__device__ __forceinline__ int mod_row(int r) { return r < NLAT ? (r >> 11) : 8; }
__device__ __forceinline__ const float* mod_ptr(const Frame& F, int l, int r, int chunk) { return F.MOD() + ((size_t)(l * 9 + mod_row(r)) * 6 + chunk) * D; }
__device__ __forceinline__ unsigned* cnt_ptr(const Frame& F, int l, int e) { return F.ctl() + CW_CNT + (l * 64 + e) * 16; }

__device__ __forceinline__ void transpose_item(const float* W, int K, int N, bf16_t* WT, int k0, int n0, int rbase, float* scr, int lane) {
#pragma unroll 8
    for (int i = 0; i < 32; ++i) { const int kk = 2 * i + (lane >> 5); scr[kk * 33 + (lane & 31)] = W[(size_t)(k0 + kk) * N + n0 + (lane & 31)]; }
    asm volatile("s_waitcnt lgkmcnt(0)" ::: "memory");
    const int c = lane & 7;
#pragma unroll
    for (int j = 0; j < 4; ++j) { const int n = (lane >> 3) + 8 * j; const float* s = scr + (8 * c) * 33 + n;
        u32x4 o; o.x = pk2(s[0 * 33], s[1 * 33]); o.y = pk2(s[2 * 33], s[3 * 33]); o.z = pk2(s[4 * 33], s[5 * 33]); o.w = pk2(s[6 * 33], s[7 * 33]);
        *(u32x4*)(WT + (size_t)(rbase + n) * K + k0 + 8 * c) = o; }
    asm volatile("s_waitcnt lgkmcnt(0)" ::: "memory");
}
__device__ __forceinline__ void conv_weight(const float* W, int K, int N, bf16_t* WT, int gu, int item, float* scr, int lane) {
    const int nblk = N / 32, kb = item / nblk, nb = item % nblk, n0 = 32 * nb;
    const int rbase = gu == 0 ? n0 : ((n0 >> 7) * 256 + (n0 & 127) + (gu == 2 ? 128 : 0));
    transpose_item(W, K, N, WT, 64 * kb, n0, rbase, scr, lane);
}
__device__ __forceinline__ void conv_experts(Frame& F, int l) {
    float* scr = (float*)(F.lds + F.wave * 16384);
    const int gw = F.bid * NWAVES + F.wave, NGW = F.G * NWAVES;
    constexpr int IG = (D / 64) * (FF / 32), ID = (FF / 64) * (D / 32);
    constexpr int PER = 2 * IG + ID;
    for (int it = gw; it < NE * PER; it += NGW) {
        const int e = it / PER; int r = it % PER;
        const size_t eo = (size_t)(l * NE + e) * D * FF;
        if (r < IG) { conv_weight(F.inp(IN_EG) + eo, D, FF, F.WEXPGU() + (size_t)e * 512 * D, 1, r, scr, F.lane); continue; } r -= IG;
        if (r < IG) { conv_weight(F.inp(IN_EU) + eo, D, FF, F.WEXPGU() + (size_t)e * 512 * D, 2, r, scr, F.lane); continue; } r -= IG;
        conv_weight(F.inp(IN_ED) + eo, FF, D, F.WEXPD() + (size_t)e * D * FF, 0, r, scr, F.lane);
    }
}
__device__ __forceinline__ void p0_prologue(Frame& F) {
    if (F.bid == 0) {
        for (int i = F.tid; i < 64 * 16; i += NTHR) { const int pos = i >> 4, f = i & 15;
            const float inv = powf(10000.0f, -(float)(2 * f) / 32.0f); const float a = (float)pos * inv;
            F.ROPE()[i] = cosf(a); F.ROPE()[1024 + i] = sinf(a); }
    }
    {
        float* sl = (float*)F.lds;
        float* red = (float*)(F.lds + 40960);
        bool have = false;
        for (int it = F.bid; it < 2 * 96; it += F.G) {
            if (!have) {
                for (int i = F.tid; i < 9 * D; i += NTHR) { const int r = i >> 10, k = i & 1023; const float v = r < 8 ? F.inp(IN_C)[r * D + k] : F.inp(IN_CCTX)[k]; sl[i] = silu_f(v); }
                __syncthreads(); have = true;
            }
            const int l = it / 96, jc = it % 96, c = F.tid & 63, kg = F.tid >> 6;
            const float* W = F.inp(IN_MODW) + (size_t)l * D * 6144 + 64 * jc + c;
            float acc[9];
#pragma unroll
            for (int r = 0; r < 9; ++r) acc[r] = 0.f;
#pragma unroll 8
            for (int k = 128 * kg; k < 128 * kg + 128; ++k) { const float w = W[(size_t)k * 6144];
#pragma unroll
                for (int r = 0; r < 9; ++r) acc[r] += sl[r * D + k] * w; }
#pragma unroll
            for (int r = 0; r < 9; ++r) red[(kg * 9 + r) * 64 + c] = acc[r];
            __syncthreads();
            for (int i = F.tid; i < 9 * 64; i += NTHR) { const int r = i >> 6, cc = i & 63; float s = 0.f;
#pragma unroll
                for (int g = 0; g < 8; ++g) s += red[(g * 9 + r) * 64 + cc];
                F.MOD()[(size_t)(l * 9 + r) * 6144 + 64 * jc + cc] = s + F.inp(IN_MODB)[l * 6144 + 64 * jc + cc]; }
            __syncthreads();
        }
        __syncthreads();
    }
    {
        float* scr = (float*)(F.lds + F.wave * 16384);
        const int gw = F.bid * NWAVES + F.wave, NGW = F.G * NWAVES;
        constexpr int I_IN = (D / 64) * (INW / 32), I_OUT = (D / 64) * (D / 32), I_SG = (D / 64) * (FF / 32), I_SD = (FF / 64) * (D / 32);
        constexpr int PER = I_IN + I_OUT + 2 * I_SG + I_SD;
        for (int it = gw; it < 2 * PER; it += NGW) {
            const int l = it / PER; int r = it % PER;
            if (r < I_IN) { conv_weight(F.inp(IN_WIN) + (size_t)l * D * INW, D, INW, F.WIN() + (size_t)l * INW * D, 0, r, scr, F.lane); continue; } r -= I_IN;
            if (r < I_OUT) { conv_weight(F.inp(IN_WOUT) + (size_t)l * D * D, D, D, F.WOUT() + (size_t)l * D * D, 0, r, scr, F.lane); continue; } r -= I_OUT;
            if (r < I_SG) { conv_weight(F.inp(IN_SG) + (size_t)l * D * FF, D, FF, F.WSHGU() + (size_t)l * 512 * D, 1, r, scr, F.lane); continue; } r -= I_SG;
            if (r < I_SG) { conv_weight(F.inp(IN_SU) + (size_t)l * D * FF, D, FF, F.WSHGU() + (size_t)l * 512 * D, 2, r, scr, F.lane); continue; } r -= I_SG;
            conv_weight(F.inp(IN_SD) + (size_t)l * FF * D, FF, D, F.WSHD() + (size_t)l * D * FF, 0, r, scr, F.lane);
        }
    }
    for (int idx = F.bid * NTHR + F.tid; idx < 2 * NE * D; idx += F.G * NTHR) {
        const int l = idx / (NE * D), e = (idx / D) % NE, k = idx % D;
        const float w = F.inp(IN_RW)[(size_t)l * D * NE + (size_t)k * NE + e];
        const unsigned hi = pk2(w, 0.f) & 0xffffu; const float lo = w - bf_lo(hi);
        F.RWT()[((size_t)l * 128 + e) * D + k] = (bf16_t)hi; F.RWT()[((size_t)l * 128 + 64 + e) * D + k] = (bf16_t)(pk2(lo, 0.f) & 0xffffu);
    }
    conv_experts(F, 0);
}

__device__ __forceinline__ void load_row(const float* src, int lane, f32x4 (&v)[4]) {
#pragma unroll
    for (int j = 0; j < 4; ++j) v[j] = *(const f32x4*)(src + 4 * lane + 256 * j);
}
__device__ __forceinline__ float row_rstd(const f32x4 (&v)[4]) {
    float s = 0.f;
#pragma unroll
    for (int j = 0; j < 4; ++j) s += (v[j].x * v[j].x + v[j].y * v[j].y) + (v[j].z * v[j].z + v[j].w * v[j].w);
    return 1.0f / sqrtf(wave_sum(s) * (1.0f / D) + EPS);
}
__device__ __forceinline__ void norm_mod(const f32x4 (&v)[4], float rstd, const float* g, const float* sh, const float* sc, int lane, f32x4 (&h)[4]) {
#pragma unroll
    for (int j = 0; j < 4; ++j) { const int c = 4 * lane + 256 * j; const f32x4 gg = *(const f32x4*)(g + c), s1 = *(const f32x4*)(sh + c), s2 = *(const f32x4*)(sc + c);
        h[j] = v[j] * rstd * gg * (1.0f + s2) + s1; }
}
__device__ __forceinline__ void store_row_bf16(bf16_t* dst, int lane, const f32x4 (&h)[4]) {
#pragma unroll
    for (int j = 0; j < 4; ++j) { u32x2 w; w.x = pk2(h[j].x, h[j].y); w.y = pk2(h[j].z, h[j].w); *(u32x2*)(dst + 4 * lane + 256 * j) = w; }
}
__device__ __forceinline__ void phase_r1(Frame& F, int l) {
    const int gw = F.bid * NWAVES + F.wave, NGW = F.G * NWAVES;
    for (int r = gw; r < NTOK; r += NGW) {
        const float* src = (l == 0) ? (r < NLAT ? F.inp(IN_X) + (size_t)r * D : F.inp(IN_CTX) + (size_t)(r - NLAT) * D) : xa_row(F, r);
        f32x4 v[4], h[4]; load_row(src, F.lane, v);
        const float rstd = row_rstd(v);
        norm_mod(v, rstd, F.inp(IN_N1G) + l * D, mod_ptr(F, l, r, 0), mod_ptr(F, l, r, 1), F.lane, h);
        store_row_bf16(F.H1() + (size_t)r * D, F.lane, h);
    }
}
__device__ __forceinline__ void phase_nrm(Frame& F, int l, int nrows) {
    const int gw = F.bid * NWAVES + F.wave, NGW = F.G * NWAVES;
    for (int r = gw; r < nrows; r += NGW) {
        const float* sq = F.SSQ() + (size_t)r * 16;
        const float sA = sq[0] + sq[1] + sq[2] + sq[3] + sq[4] + sq[5], sB = sq[6] + sq[7] + sq[8] + sq[9], sC = sq[10] + sq[11] + sq[12] + sq[13] + sq[14] + sq[15];
        const float rA = 1.0f / sqrtf(sA * (1.0f / 384.0f) + EPS), rB = 1.0f / sqrtf(sB * (1.0f / 256.0f) + EPS), rC = 1.0f / sqrtf(sC * (1.0f / 384.0f) + EPS);
        bf16_t* yr = F.Y() + (size_t)r * D;
#pragma unroll
        for (int j = 0; j < 4; ++j) { const int c = 4 * F.lane + 256 * j; const float rs = c < 384 ? rA : (c < 640 ? rB : rC);
            const u32x2 w = *(const u32x2*)(yr + c); const f32x4 gg = *(const f32x4*)(F.inp(IN_GNG) + l * D + c);
            u32x2 o; o.x = pk2(bf_lo(w.x) * rs * gg.x, bf_hi(w.x) * rs * gg.y); o.y = pk2(bf_lo(w.y) * rs * gg.z, bf_hi(w.y) * rs * gg.w);
            *(u32x2*)(yr + c) = o; }
    }
}
__device__ __forceinline__ void phase_r2(Frame& F, int l, int nrows) {
    const int gw = F.bid * NWAVES + F.wave, NGW = F.G * NWAVES;
    for (int r = gw; r < nrows; r += NGW) {
        f32x4 v[4], h[4]; load_row(xa_row(F, r), F.lane, v);
        const float rstd = row_rstd(v);
        norm_mod(v, rstd, F.inp(IN_N2G) + l * D, mod_ptr(F, l, r, 3), mod_ptr(F, l, r, 4), F.lane, h);
        bf16_t* hp = F.H1() + (size_t)r * D; bf16_t* lp = F.HLO() + (size_t)r * D;
#pragma unroll
        for (int j = 0; j < 4; ++j) { u32x2 w; w.x = pk2(h[j].x, h[j].y); w.y = pk2(h[j].z, h[j].w); *(u32x2*)(hp + 4 * F.lane + 256 * j) = w;
            u32x2 q; q.x = pk2(h[j].x - bf_lo(w.x), h[j].y - bf_hi(w.x)); q.y = pk2(h[j].z - bf_lo(w.y), h[j].w - bf_hi(w.y)); *(u32x2*)(lp + 4 * F.lane + 256 * j) = q; }
    }
}
__device__ __forceinline__ void phase_topk(Frame& F, int l, int nrows) {
    const int gw = F.bid * NWAVES + F.wave, NGW = F.G * NWAVES;
    const float rbias = F.inp(IN_RB)[l * NE + F.lane];
    const float* PL = F.PL();
    for (int r = gw; r < nrows; r += NGW) {
        const float logit = (PL[(size_t)r * NE + F.lane] + PL[(size_t)(NTOK + r) * NE + F.lane]) + PL[(size_t)(2 * NTOK + r) * NE + F.lane];
        const float score = 1.0f / (1.0f + expf(-logit));
        const float sel = score + rbias;
        float m1 = sel;
#pragma unroll
        for (int o = 1; o < 8; o <<= 1) m1 = fmaxf(m1, __shfl_xor(m1, o));
        const unsigned long long bal = __ballot(sel == m1);
        const unsigned gm = (unsigned)(bal >> (F.lane & ~7)) & 0xffu; const int first = __ffs(gm) - 1;
        float m2 = ((F.lane & 7) == first) ? -3.0e38f : sel;
#pragma unroll
        for (int o = 1; o < 8; o <<= 1) m2 = fmaxf(m2, __shfl_xor(m2, o));
        const float gs = m1 + m2; const int g = F.lane >> 3; int rank = 0;
#pragma unroll
        for (int j = 0; j < 8; ++j) { const float o = __shfl(gs, j * 8); rank += ((o > gs) || (o == gs && j < g)) ? 1 : 0; }
        const float msel = rank < 4 ? sel : NEGF;
        int r2 = 0;
#pragma unroll
        for (int j = 0; j < 64; ++j) { const float o = __shfl(msel, j); r2 += ((o > msel) || (o == msel && j < F.lane)) ? 1 : 0; }
        const bool chosen = r2 < 8;
        const float wsum = wave_sum(chosen ? score : 0.f);
        if (chosen) {
            const unsigned pos = atomicAdd(cnt_ptr(F, l, F.lane), 1u);
            F.LIST()[(size_t)F.lane * LIST_CAP + pos] = (unsigned)r | ((unsigned)r2 << 16);
            F.LISTW()[(size_t)F.lane * LIST_CAP + pos] = score / wsum * 2.5f;
        }
    }
}
__device__ __forceinline__ void phase_cmb(Frame& F, int l, int nrows) {
    const int gw = F.bid * NWAVES + F.wave, NGW = F.G * NWAVES;
    for (int r = gw; r < nrows; r += NGW) {
        float* xr = xa_row(F, r);
        f32x4 v[4]; load_row(xr, F.lane, v);
        f32x4 s[4];
#pragma unroll
        for (int j = 0; j < 4; ++j) s[j] = (f32x4){0.f, 0.f, 0.f, 0.f};
        const bf16_t* yb = F.Y2() + (size_t)r * 8 * D;
#pragma unroll
        for (int k = 0; k < 8; ++k)
#pragma unroll
            for (int j = 0; j < 4; ++j) { const u32x2 w = *(const u32x2*)(yb + (size_t)k * D + 4 * F.lane + 256 * j);
                s[j].x += bf_lo(w.x); s[j].y += bf_hi(w.x); s[j].z += bf_lo(w.y); s[j].w += bf_hi(w.y); }
        const float* g2 = mod_ptr(F, l, r, 5);
#pragma unroll
        for (int j = 0; j < 4; ++j) v[j] = v[j] + *(const f32x4*)(g2 + 4 * F.lane + 256 * j) * s[j];
        const float rstd = row_rstd(v);
        if (l == 0) {
#pragma unroll
            for (int j = 0; j < 4; ++j) *(f32x4*)(xr + 4 * F.lane + 256 * j) = v[j];
            f32x4 h[4];
            norm_mod(v, rstd, F.inp(IN_N1G) + D, mod_ptr(F, 1, r, 0), mod_ptr(F, 1, r, 1), F.lane, h);
            store_row_bf16(F.H1() + (size_t)r * D, F.lane, h);
        } else {
#pragma unroll
            for (int j = 0; j < 4; ++j) { const f32x4 gg = *(const f32x4*)(F.inp(IN_FG) + 4 * F.lane + 256 * j); *(f32x4*)(xr + 4 * F.lane + 256 * j) = v[j] * rstd * gg; }
        }
    }
}

struct Unit { int pm, pn, e, lt; };

struct SchedDense {
    const bf16_t* A; const bf16_t* Bt; int K, nM, nN, G, c;
    __device__ __forceinline__ bool next(int i, Unit& u) const {
        const int L = i * G + c; if (L >= nM * nN) return false;
        u.pn = __builtin_amdgcn_readfirstlane(L % nN); u.pm = __builtin_amdgcn_readfirstlane(L / nN); u.e = 0; u.lt = 0; return true;
    }
    __device__ __forceinline__ const bf16_t* a_row(const Unit& u, int r) const { return A + (size_t)(u.pm * 256 + r) * K; }
    __device__ __forceinline__ const bf16_t* b_row(const Unit& u, int c_) const { return Bt + (size_t)(u.pn * 256 + c_) * K; }
    const unsigned char* ws;
    __device__ __forceinline__ unsigned a_off(const Unit& u) const { return (unsigned)((const unsigned char*)A - ws) + (unsigned)u.pm * (unsigned)(512 * K); }
    __device__ __forceinline__ unsigned b_off(const Unit& u) const { return (unsigned)((const unsigned char*)Bt - ws) + (unsigned)u.pn * (unsigned)(512 * K); }
};
struct SchedRG {
    const bf16_t* H1; const bf16_t* HLO; const bf16_t* RW; int nM, G, c; const unsigned char* ws;
    __device__ __forceinline__ bool next(int i, Unit& u) const {
        const int L = i * G + c; if (L >= nM * 2) return false;
        u.pm = __builtin_amdgcn_readfirstlane(L >> 1); u.pn = 0; u.e = __builtin_amdgcn_readfirstlane(L & 1); u.lt = 0; return true;
    }
    __device__ __forceinline__ const bf16_t* a_row(const Unit& u, int r) const { return (u.e ? HLO : H1) + (size_t)(u.pm * 256 + r) * D; }
    __device__ __forceinline__ const bf16_t* b_row(const Unit& u, int c_) const { return RW + (size_t)c_ * D; }
    __device__ __forceinline__ unsigned a_off(const Unit& u) const { return (u.e ? (unsigned)((const unsigned char*)HLO - ws) : (unsigned)((const unsigned char*)H1 - ws)) + (unsigned)u.pm * (unsigned)(512 * D); }
    __device__ __forceinline__ unsigned b_off(const Unit&) const { return (unsigned)((const unsigned char*)RW - ws); }
};
struct EpiRG {
    float* PL;
    __device__ __forceinline__ void row(const Unit& u, int r, int cbase, const f32x4 (&v)[2][2]) const {
        const int grow = u.pm * 256 + r;
#pragma unroll
        for (int n = 0; n < 2; ++n) { const int c = cbase + 16 * n;
            if (u.e == 0) *(f32x4*)(PL + ((size_t)(c < 64 ? 0 : NTOK) + grow) * NE + (c & 63)) = v[0][n];
            else if (c < 64) *(f32x4*)(PL + ((size_t)(2 * NTOK) + grow) * NE + c) = v[0][n]; }
    }
};
struct MoeTab { const int* toff; const int* cnt; };
__device__ __forceinline__ void moe_build_tab(Frame& F, int l, int nrows_shared) {
    int* toff = (int*)(F.lds + TOFF_OFF); int* cnt = toff + 72;
    __syncthreads();
    if (F.tid == 0) { int acc = 0;
        for (int e = 0; e < NE; ++e) { const int c = (int)__hip_atomic_load(cnt_ptr(F, l, e), __ATOMIC_RELAXED, __HIP_MEMORY_SCOPE_AGENT); cnt[e] = c; toff[e] = acc; acc += (c + 255) >> 8; }
        cnt[NE] = nrows_shared; toff[NE] = acc; acc += nrows_shared >> 8; toff[NE + 1] = acc; }
    __syncthreads();
}
__device__ __forceinline__ void moe_find(const MoeTab& T, int tg, Unit& u) {
    int e = 0;
#pragma unroll 1
    for (int j = 1; j <= NE; ++j) e = (T.toff[j] <= tg) ? j : e;
    u.pm = __builtin_amdgcn_readfirstlane(tg); u.e = __builtin_amdgcn_readfirstlane(e); u.lt = __builtin_amdgcn_readfirstlane(tg - T.toff[e]);
}
struct SchedE1 {
    MoeTab T; const unsigned* LIST; const bf16_t* H1; const bf16_t* WGU; const bf16_t* WSH; int G, c;
    __device__ __forceinline__ bool next(int i, Unit& u) const {
        const int L = i * G + c; if (L >= __builtin_amdgcn_readfirstlane(T.toff[NE + 1]) * 2) return false;
        u.pn = __builtin_amdgcn_readfirstlane(L & 1); moe_find(T, L >> 1, u); return true;
    }
    __device__ __forceinline__ int token(const Unit& u, int r) const {
        const int idx = u.lt * 256 + r;
        if (u.e == NE) return idx;
        return idx < T.cnt[u.e] ? (int)(LIST[(size_t)u.e * LIST_CAP + idx] & 0xffffu) : 0;
    }
    __device__ __forceinline__ const bf16_t* a_row(const Unit& u, int r) const { return H1 + (size_t)token(u, r) * D; }
    __device__ __forceinline__ const bf16_t* b_row(const Unit& u, int c_) const { return (u.e == NE ? WSH : WGU + (size_t)u.e * 512 * D) + (size_t)(u.pn * 256 + c_) * D; }
    const unsigned char* ws;
    __device__ __forceinline__ unsigned a_org() const { return (unsigned)((const unsigned char*)H1 - ws); }
    __device__ __forceinline__ unsigned a_rowoff(const Unit& u, int r) const { return (unsigned)token(u, r) * (unsigned)(D * 2); }
    __device__ __forceinline__ unsigned b_off(const Unit& u) const {
        const unsigned sh = (unsigned)((const unsigned char*)WSH - ws), ex = (unsigned)((const unsigned char*)WGU - ws) + (unsigned)u.e * (unsigned)(512 * D * 2);
        return (u.e == NE ? sh : ex) + (unsigned)u.pn * (unsigned)(256 * D * 2); }
};
struct SchedE2 {
    MoeTab T; const bf16_t* HB; const bf16_t* WD; const bf16_t* WSH; int G, c;
    __device__ __forceinline__ bool next(int i, Unit& u) const {
        const int L = i * G + c; if (L >= __builtin_amdgcn_readfirstlane(T.toff[NE + 1]) * 4) return false;
        u.pn = __builtin_amdgcn_readfirstlane(L & 3); moe_find(T, L >> 2, u); return true;
    }
    __device__ __forceinline__ const bf16_t* a_row(const Unit& u, int r) const { return HB + (size_t)(u.pm * 256 + r) * FF; }
    __device__ __forceinline__ const bf16_t* b_row(const Unit& u, int c_) const { return (u.e == NE ? WSH : WD + (size_t)u.e * D * FF) + (size_t)(u.pn * 256 + c_) * FF; }
    const unsigned char* ws;
    __device__ __forceinline__ unsigned a_off(const Unit& u) const { return (unsigned)((const unsigned char*)HB - ws) + (unsigned)u.pm * (unsigned)(256 * FF * 2); }
    __device__ __forceinline__ unsigned b_off(const Unit& u) const {
        const unsigned sh = (unsigned)((const unsigned char*)WSH - ws), ex = (unsigned)((const unsigned char*)WD - ws) + (unsigned)u.e * (unsigned)(D * FF * 2);
        return (u.e == NE ? sh : ex) + (unsigned)u.pn * (unsigned)(256 * FF * 2); }
};

struct EpiG1 {
    bf16_t* Z; const float* ROPE;
    __device__ __forceinline__ void row(const Unit& u, int r, int cbase, const f32x4 (&v)[2][2]) const {
        const int grow = u.pm * 256 + r;
#pragma unroll
        for (int bj = 0; bj < 2; ++bj) {
            const int col0 = u.pn * 256 + bj * 128 + cbase;
            f32x4 a = v[bj][0], b = v[bj][1];
            const bool is_rope = (col0 < VA) && (grow < NLAT);
            if (is_rope) {
                const int t = grow & (SEQ - 1); const int pos = ((col0 & 32) == 0) ? (t >> 6) : (t & 63);
                const int f0 = col0 & 15;
                const f32x4 cs = *(const f32x4*)(ROPE + pos * 16 + f0), sn = *(const f32x4*)(ROPE + 1024 + pos * 16 + f0);
                const f32x4 a2 = a * cs - b * sn, b2 = b * cs + a * sn; a = a2; b = b2;
            }
            if (col0 < KA || (col0 >= QN && col0 < KN)) { a = a * 0.125f; b = b * 0.125f; }
            if (col0 >= UB && col0 < QN) {
                a = (f32x4){gelu_tanh(a.x), gelu_tanh(a.y), gelu_tanh(a.z), gelu_tanh(a.w)};
                b = (f32x4){gelu_tanh(b.x), gelu_tanh(b.y), gelu_tanh(b.z), gelu_tanh(b.w)};
            }
            bf16_t* zr = Z + (size_t)grow * INW + col0;
            u32x2 w0, w1; w0.x = pk2(a.x, a.y); w0.y = pk2(a.z, a.w); w1.x = pk2(b.x, b.y); w1.y = pk2(b.z, b.w);
            *(u32x2*)zr = w0; *(u32x2*)(zr + 16) = w1;
        }
    }
};
struct EpiG2 {
    const float* xlat; const float* xctx; float* out; float* XC; const float* MOD; int l;
    __device__ __forceinline__ void row(const Unit& u, int r, int cbase, const f32x4 (&v)[2][2]) const {
        const int grow = u.pm * 256 + r;
        const float* src = grow < NLAT ? xlat + (size_t)grow * D : xctx + (size_t)(grow - NLAT) * D;
        float* dst = grow < NLAT ? out + (size_t)grow * D : XC + (size_t)(grow - NLAT) * D;
        const float* g1 = MOD + ((size_t)(l * 9 + mod_row(grow)) * 6 + 2) * D;
#pragma unroll
        for (int bj = 0; bj < 2; ++bj)
#pragma unroll
            for (int n = 0; n < 2; ++n) { const int c = u.pn * 256 + bj * 128 + cbase + 16 * n;
                *(f32x4*)(dst + c) = *(const f32x4*)(src + c) + *(const f32x4*)(g1 + c) * v[bj][n]; }
    }
};
struct EpiE1 {
    bf16_t* HB;
    __device__ __forceinline__ void row(const Unit& u, int r, int cbase, const f32x4 (&v)[2][2]) const {
        bf16_t* hr = HB + (size_t)(u.pm * 256 + r) * FF + u.pn * 128 + cbase;
#pragma unroll
        for (int n = 0; n < 2; ++n) { const f32x4 g = v[0][n], up = v[1][n];
            u32x2 w; w.x = pk2(silu_f(g.x) * up.x, silu_f(g.y) * up.y); w.y = pk2(silu_f(g.z) * up.z, silu_f(g.w) * up.w);
            *(u32x2*)(hr + 16 * n) = w; }
    }
};
struct EpiE2 {
    MoeTab T; const unsigned* LIST; const float* LISTW; bf16_t* Y2; float* out; float* XC; const float* MOD; int l;
    __device__ __forceinline__ void row(const Unit& u, int r, int cbase, const f32x4 (&v)[2][2]) const {
        const int idx = u.lt * 256 + r;
        if (u.e == NE) {
            float* dst = idx < NLAT ? out + (size_t)idx * D : XC + (size_t)(idx - NLAT) * D;
            const float* g2 = MOD + ((size_t)(l * 9 + mod_row(idx)) * 6 + 5) * D;
#pragma unroll
            for (int bj = 0; bj < 2; ++bj)
#pragma unroll
                for (int n = 0; n < 2; ++n) { const int c = u.pn * 256 + bj * 128 + cbase + 16 * n;
                    *(f32x4*)(dst + c) = *(const f32x4*)(dst + c) + *(const f32x4*)(g2 + c) * v[bj][n]; }
        } else if (idx < T.cnt[u.e]) {
            const unsigned ent = LIST[(size_t)u.e * LIST_CAP + idx]; const float w = LISTW[(size_t)u.e * LIST_CAP + idx];
            bf16_t* yr = Y2 + ((size_t)(ent & 0xffffu) * 8 + (ent >> 16)) * D + u.pn * 256 + cbase;
#pragma unroll
            for (int bj = 0; bj < 2; ++bj)
#pragma unroll
                for (int n = 0; n < 2; ++n) { const f32x4 x = v[bj][n] * w; u32x2 o; o.x = pk2(x.x, x.y); o.y = pk2(x.z, x.w); *(u32x2*)(yr + bj * 128 + 16 * n) = o; }
        }
    }
};

template <class Sched, class Epi>
__device__ __forceinline__ void gemm_simple(Frame& F, const Sched& S, const Epi& E, int K) {
    float* As = (float*)F.lds;
    float* Bs = (float*)(F.lds + 32 * 132 * 4);
    const int tid = F.tid, cg = tid & 15, rg = tid >> 4, wc = cg >> 2, fq = cg & 3, cbase = 32 * wc + 4 * fq;
    Unit u;
    for (int i = 0; S.next(i, u); ++i) {
        const bf16_t* bp = S.b_row(u, tid >> 1) + 16 * (tid & 1);
        for (int ai = 0; ai < 2; ++ai) {
            const bf16_t* ap = S.a_row(u, ai * 128 + (tid >> 2)) + 8 * (tid & 3);
            f32x4 acc[4][2][2];
#pragma unroll
            for (int a = 0; a < 4; ++a)
#pragma unroll
                for (int b = 0; b < 2; ++b)
#pragma unroll
                    for (int n = 0; n < 2; ++n) acc[a][b][n] = (f32x4){0.f, 0.f, 0.f, 0.f};
            for (int k0 = 0; k0 < K; k0 += 32) {
                const u32x4 wa = *(const u32x4*)(ap + k0);
                const u32x4 wb0 = *(const u32x4*)(bp + k0), wb1 = *(const u32x4*)(bp + k0 + 8);
                __syncthreads();
                { const int row = tid >> 2, kc = 8 * (tid & 3);
                  As[(kc + 0) * 132 + row] = bf_lo(wa.x); As[(kc + 1) * 132 + row] = bf_hi(wa.x); As[(kc + 2) * 132 + row] = bf_lo(wa.y); As[(kc + 3) * 132 + row] = bf_hi(wa.y);
                  As[(kc + 4) * 132 + row] = bf_lo(wa.z); As[(kc + 5) * 132 + row] = bf_hi(wa.z); As[(kc + 6) * 132 + row] = bf_lo(wa.w); As[(kc + 7) * 132 + row] = bf_hi(wa.w); }
                { const int col = tid >> 1, kc = 16 * (tid & 1);
                  Bs[(kc + 0) * 260 + col] = bf_lo(wb0.x); Bs[(kc + 1) * 260 + col] = bf_hi(wb0.x); Bs[(kc + 2) * 260 + col] = bf_lo(wb0.y); Bs[(kc + 3) * 260 + col] = bf_hi(wb0.y);
                  Bs[(kc + 4) * 260 + col] = bf_lo(wb0.z); Bs[(kc + 5) * 260 + col] = bf_hi(wb0.z); Bs[(kc + 6) * 260 + col] = bf_lo(wb0.w); Bs[(kc + 7) * 260 + col] = bf_hi(wb0.w);
                  Bs[(kc + 8) * 260 + col] = bf_lo(wb1.x); Bs[(kc + 9) * 260 + col] = bf_hi(wb1.x); Bs[(kc + 10) * 260 + col] = bf_lo(wb1.y); Bs[(kc + 11) * 260 + col] = bf_hi(wb1.y);
                  Bs[(kc + 12) * 260 + col] = bf_lo(wb1.z); Bs[(kc + 13) * 260 + col] = bf_hi(wb1.z); Bs[(kc + 14) * 260 + col] = bf_lo(wb1.w); Bs[(kc + 15) * 260 + col] = bf_hi(wb1.w); }
                __syncthreads();
#pragma unroll 4
                for (int kk = 0; kk < 32; ++kk) {
                    const f32x4 a = *(const f32x4*)(As + kk * 132 + 4 * rg);
                    f32x4 b[2][2];
#pragma unroll
                    for (int bj = 0; bj < 2; ++bj)
#pragma unroll
                        for (int n = 0; n < 2; ++n) b[bj][n] = *(const f32x4*)(Bs + kk * 260 + 128 * bj + cbase + 16 * n);
#pragma unroll
                    for (int bj = 0; bj < 2; ++bj)
#pragma unroll
                        for (int n = 0; n < 2; ++n) { acc[0][bj][n] += a.x * b[bj][n]; acc[1][bj][n] += a.y * b[bj][n]; acc[2][bj][n] += a.z * b[bj][n]; acc[3][bj][n] += a.w * b[bj][n]; }
                }
            }
#pragma unroll
            for (int a = 0; a < 4; ++a) E.row(u, ai * 128 + 4 * rg + a, cbase, acc[a]);
        }
    }
    __syncthreads();
}


namespace pg8 {
typedef short bf16x8 __attribute__((ext_vector_type(8)));
constexpr int BM = 256, BK = 64, HALF = 128, HTB = HALF * BK * 2, STAGE_BYTES = 8 * HTB;
__device__ __forceinline__ int lds_byte(int r, int c) { const int st = (r >> 4) * 2 + (c >> 5), rr = r & 15, cc = c & 31, ob = rr * 64 + cc * 2; return st * 1024 + (ob ^ (((ob >> 9) & 1) << 5)); }
__device__ __forceinline__ void stage_rc(int b, int& R, int& C) { const int st = b / 1024, sb = b % 1024, swz = sb ^ (((sb >> 9) & 1) << 5); R = (st >> 1) * 16 + swz / 64; C = (st & 1) * 32 + (swz % 64) / 2; }

template <class Sched, class REpi, bool GATHER, bool ALIGN_EPI, bool SP2>
__device__ __forceinline__ void gemm_phase(LAS unsigned char* lds, const unsigned char* wsbase, const Sched& S, const REpi& RE, const int K, const int tid, const int wid) {
    const int lane = tid & 63, wr = wid >> 2, wc = wid & 3, fr = lane & 15, fq = lane >> 4;
    const int nt = K / BK;
    const __amdgpu_buffer_rsrc_t rsrc = __builtin_amdgcn_make_buffer_rsrc((void*)wsbase, 0, 0x7fffffff, 0x00020000);
    int R0, C0; stage_rc(tid * 16, R0, C0);
    const unsigned vo0 = (unsigned)(R0 * K + C0) * 2u, vo1 = (unsigned)((R0 + 64) * K + C0) * 2u;
    const unsigned kstep = (unsigned)(BK * 2), hstep = (unsigned)(HALF * K * 2);
    const unsigned ldsw = (unsigned)wid * 1024u;
    const int aoff = lds_byte(wr * 64 + fr, fq * 8), boff = lds_byte(wc * 32 + fr, fq * 8);
#define PG8_SA(b, h) (((b) * 2 + (h)) * HTB)
#define PG8_SB(b, h) ((4 + (b) * 2 + (h)) * HTB)
#define PG8_STAGE2(bufoff, soff, o0, o1) do { \
        const int _so = __builtin_amdgcn_readfirstlane((int)(soff)); \
        __builtin_amdgcn_raw_ptr_buffer_load_lds(rsrc, (LAS void*)(lds + (bufoff) + ldsw), 16, (int)(o0), _so, 0, 0); \
        __builtin_amdgcn_raw_ptr_buffer_load_lds(rsrc, (LAS void*)(lds + (bufoff) + ldsw + 8192), 16, (int)(o1), _so, 0, 0); } while (0)
#define PG8_STAGEB(bufoff, soff) PG8_STAGE2(bufoff, soff, vo0, vo1)
#define PG8_STAGEA(bufoff, soff, h, G) do { if constexpr (GATHER) PG8_STAGE2(bufoff, soff, (G)[h][0], (G)[h][1]); else PG8_STAGE2(bufoff, (soff) + (h) * hstep, vo0, vo1); } while (0)
#define PG8_LDA(dst, b, h) do { _Pragma("unroll") for (int m = 0; m < 4; ++m) _Pragma("unroll") for (int k = 0; k < 2; ++k) dst[m][k] = *(const LAS bf16x8*)(lds + PG8_SA(b, h) + aoff + m * 2048 + k * 1024); } while (0)
#define PG8_LDB(dst, b, h) do { _Pragma("unroll") for (int n = 0; n < 2; ++n) _Pragma("unroll") for (int k = 0; k < 2; ++k) dst[n][k] = *(const LAS bf16x8*)(lds + PG8_SB(b, h) + boff + n * 2048 + k * 1024); } while (0)
#define PG8_MMA(ai, bj, At, Bt) do { __builtin_amdgcn_s_setprio(1); _Pragma("unroll") for (int m = 0; m < 4; ++m) _Pragma("unroll") for (int n = 0; n < 2; ++n) _Pragma("unroll") for (int k = 0; k < 2; ++k) \
        acc[ai][bj][m][n] = __builtin_amdgcn_mfma_f32_16x16x32_bf16(Bt[n][k], At[m][k], acc[ai][bj][m][n], 0, 0, 0); __builtin_amdgcn_s_setprio(0); } while (0)
#define PG8_WAIT_V(n) asm volatile("s_waitcnt vmcnt(" #n ")" ::: "memory")
#define PG8_WAIT_L(n) asm volatile("s_waitcnt lgkmcnt(" #n ")" ::: "memory")
#define PG8_BAR __builtin_amdgcn_s_barrier()
#define PG8_SCHED __builtin_amdgcn_sched_barrier(0)
    Unit cur, nxt; int ui = 0;
    if (!S.next(0, cur)) return;
    f32x4 acc[2][2][4][2];
#pragma unroll
    for (int a = 0; a < 2; ++a)
#pragma unroll
        for (int b = 0; b < 2; ++b)
#pragma unroll
            for (int m = 0; m < 4; ++m)
#pragma unroll
                for (int n = 0; n < 2; ++n) acc[a][b][m][n] = (f32x4){0.f, 0.f, 0.f, 0.f};
    bf16x8 At[4][2], B0[2][2], B1[2][2];
    unsigned gc[2][2], gn[2][2];
    unsigned cA, cB = S.b_off(cur);
    if constexpr (GATHER) { cA = S.a_org();
#pragma unroll
        for (int h = 0; h < 2; ++h)
#pragma unroll
            for (int i = 0; i < 2; ++i) gc[h][i] = S.a_rowoff(cur, h * HALF + R0 + 64 * i) + (unsigned)C0 * 2u;
        asm volatile("s_waitcnt vmcnt(0) lgkmcnt(0)" : "+v"(gc[0][0]), "+v"(gc[0][1]), "+v"(gc[1][0]), "+v"(gc[1][1]) :: "memory");
    } else { cA = S.a_off(cur); gc[0][0] = gc[0][1] = gc[1][0] = gc[1][1] = 0u; }
    if constexpr (SP2) {
        PG8_STAGEB(PG8_SB(0, 0), cB); PG8_STAGEB(PG8_SB(0, 1), cB + hstep); PG8_STAGEA(PG8_SA(0, 0), cA, 0, gc); PG8_STAGEA(PG8_SA(0, 1), cA, 1, gc);
        if (wr == 1) PG8_BAR;
        PG8_WAIT_V(2); PG8_BAR;
        PG8_STAGEB(PG8_SB(1, 0), cB + kstep); PG8_STAGEA(PG8_SA(1, 0), cA + kstep, 0, gc); PG8_STAGEB(PG8_SB(1, 1), cB + hstep + kstep);
        PG8_WAIT_V(6); PG8_BAR;
    } else {
        PG8_STAGEB(PG8_SB(0, 0), cB); PG8_STAGEA(PG8_SA(0, 0), cA, 0, gc); PG8_STAGEB(PG8_SB(0, 1), cB + hstep); PG8_STAGEA(PG8_SA(0, 1), cA, 1, gc);
        if (wr == 1) PG8_BAR;
        PG8_WAIT_V(4); PG8_BAR;
        PG8_STAGEB(PG8_SB(1, 0), cB + kstep); PG8_STAGEA(PG8_SA(1, 0), cA + kstep, 0, gc); PG8_STAGEB(PG8_SB(1, 1), cB + hstep + kstep);
        PG8_WAIT_V(6); PG8_BAR;
    }
    for (;;) {
        const bool has_next = S.next(ui + 1, nxt);
        unsigned nA; const unsigned nB = has_next ? S.b_off(nxt) : cB;
        if constexpr (GATHER) { nA = cA;
#pragma unroll
            for (int h = 0; h < 2; ++h)
#pragma unroll
                for (int i = 0; i < 2; ++i) gn[h][i] = has_next ? S.a_rowoff(nxt, h * HALF + R0 + 64 * i) + (unsigned)C0 * 2u : gc[h][i];
            asm volatile("s_waitcnt vmcnt(0) lgkmcnt(0)" : "+v"(gn[0][0]), "+v"(gn[0][1]), "+v"(gn[1][0]), "+v"(gn[1][1]) :: "memory");
        } else { nA = has_next ? S.a_off(nxt) : cA; }
#pragma unroll 1
        for (int t = 0; t < nt; t += 2) {
            const bool last = (t == nt - 2);
            const unsigned a1 = cA + (unsigned)(t + 1) * kstep;
            unsigned a2; const unsigned b2 = last ? nB : cB + (unsigned)(t + 2) * kstep;
            unsigned g2[2][2];
            if constexpr (GATHER) { a2 = last ? cA : cA + (unsigned)(t + 2) * kstep;
#pragma unroll
                for (int h = 0; h < 2; ++h)
#pragma unroll
                    for (int i = 0; i < 2; ++i) g2[h][i] = last ? gn[h][i] : gc[h][i];
            } else { a2 = last ? nA : cA + (unsigned)(t + 2) * kstep; g2[0][0] = g2[0][1] = g2[1][0] = g2[1][1] = 0u; }
            const unsigned a3 = a2 + kstep, b3 = b2 + kstep;
            if constexpr (SP2) {
            PG8_LDB(B0, 0, 0); PG8_LDB(B1, 0, 1); PG8_SCHED; PG8_LDA(At, 0, 0); PG8_STAGEA(PG8_SA(1, 1), a1, 1, gc);
            PG8_WAIT_V(8); PG8_WAIT_L(0); PG8_BAR; PG8_MMA(0, 0, At, B0); PG8_MMA(0, 1, At, B1); PG8_BAR; PG8_SCHED;
            PG8_LDA(At, 0, 1); PG8_STAGEB(PG8_SB(0, 0), b2); PG8_STAGEB(PG8_SB(0, 1), b2 + hstep); PG8_STAGEA(PG8_SA(0, 0), a2, 0, g2);
            PG8_WAIT_V(8); PG8_WAIT_L(0); PG8_BAR; PG8_MMA(1, 0, At, B0); PG8_MMA(1, 1, At, B1); PG8_BAR; PG8_SCHED;
            PG8_LDB(B0, 1, 0); PG8_LDB(B1, 1, 1); PG8_SCHED; PG8_LDA(At, 1, 0); PG8_STAGEA(PG8_SA(0, 1), a2, 1, g2);
            PG8_WAIT_V(8); PG8_WAIT_L(0); PG8_BAR; PG8_MMA(0, 0, At, B0); PG8_MMA(0, 1, At, B1); PG8_BAR; PG8_SCHED;
            PG8_LDA(At, 1, 1); PG8_STAGEB(PG8_SB(1, 0), b3); PG8_STAGEB(PG8_SB(1, 1), b3 + hstep); PG8_STAGEA(PG8_SA(1, 0), a3, 0, g2);
            PG8_WAIT_V(8); PG8_WAIT_L(0); PG8_BAR; PG8_MMA(1, 0, At, B0); PG8_MMA(1, 1, At, B1); PG8_BAR; PG8_SCHED;
            } else {
            PG8_LDB(B0, 0, 0); PG8_SCHED; PG8_LDA(At, 0, 0); PG8_STAGEA(PG8_SA(1, 1), a1, 1, gc);
            PG8_WAIT_L(8); PG8_BAR; PG8_WAIT_L(0); PG8_MMA(0, 0, At, B0); PG8_BAR; PG8_SCHED;
            PG8_LDB(B1, 0, 1); PG8_STAGEB(PG8_SB(0, 0), b2);
            PG8_BAR; PG8_WAIT_L(0); PG8_MMA(0, 1, At, B1); PG8_BAR;
            PG8_LDA(At, 0, 1); PG8_STAGEA(PG8_SA(0, 0), a2, 0, g2);
            PG8_BAR; PG8_WAIT_L(0); PG8_MMA(1, 0, At, B0); PG8_BAR; PG8_SCHED;
            PG8_STAGEB(PG8_SB(0, 1), b2 + hstep);
            PG8_WAIT_V(6); PG8_BAR; PG8_MMA(1, 1, At, B1); PG8_BAR;
            PG8_LDB(B0, 1, 0); PG8_SCHED; PG8_LDA(At, 1, 0); PG8_STAGEA(PG8_SA(0, 1), a2, 1, g2);
            PG8_WAIT_L(8); PG8_BAR; PG8_WAIT_L(0); PG8_MMA(0, 0, At, B0); PG8_BAR; PG8_SCHED;
            PG8_LDB(B1, 1, 1); PG8_STAGEB(PG8_SB(1, 0), b3);
            PG8_BAR; PG8_WAIT_L(0); PG8_MMA(0, 1, At, B1); PG8_BAR;
            PG8_LDA(At, 1, 1); PG8_STAGEA(PG8_SA(1, 0), a3, 0, g2);
            PG8_BAR; PG8_WAIT_L(0); PG8_MMA(1, 0, At, B0); PG8_BAR; PG8_SCHED;
            PG8_STAGEB(PG8_SB(1, 1), b3 + hstep);
            PG8_WAIT_V(6); PG8_BAR; PG8_MMA(1, 1, At, B1); PG8_BAR;
            }
        }
        if constexpr (ALIGN_EPI) { if (wr == 0) PG8_BAR; }
        {
#pragma unroll
            for (int ai = 0; ai < 2; ++ai)
#pragma unroll
                for (int m = 0; m < 4; ++m) { const f32x4 v[2][2] = {{acc[ai][0][m][0], acc[ai][0][m][1]}, {acc[ai][1][m][0], acc[ai][1][m][1]}};
                    RE.row(cur, ai * HALF + wr * 64 + m * 16 + fr, wc * 32 + 4 * fq, v); asm volatile("" ::: "memory"); }
        }
        if (!has_next) break;
#pragma unroll
        for (int a = 0; a < 2; ++a)
#pragma unroll
            for (int b = 0; b < 2; ++b)
#pragma unroll
                for (int m = 0; m < 4; ++m)
#pragma unroll
                    for (int n = 0; n < 2; ++n) acc[a][b][m][n] = (f32x4){0.f, 0.f, 0.f, 0.f};
        cur = nxt; cA = nA; cB = nB; ++ui;
        if constexpr (GATHER) {
#pragma unroll
            for (int h = 0; h < 2; ++h)
#pragma unroll
                for (int i = 0; i < 2; ++i) gc[h][i] = gn[h][i];
        }
        if constexpr (ALIGN_EPI) { if (wr == 1) PG8_BAR; }
    }
    PG8_WAIT_V(0);
    if constexpr (!ALIGN_EPI) { if (wr == 0) PG8_BAR; }
    PG8_BAR;
#undef PG8_SA
#undef PG8_SB
#undef PG8_STAGE2
#undef PG8_STAGEB
#undef PG8_STAGEA
#undef PG8_LDA
#undef PG8_LDB
#undef PG8_MMA
#undef PG8_WAIT_V
#undef PG8_WAIT_L
#undef PG8_BAR
#undef PG8_SCHED
}
}
#ifndef MK_SP2
#define MK_SP2 true
#endif
#ifndef MK_ALIGN
#define MK_ALIGN true
#endif
#ifndef MK_MFMA
#define MK_MFMA 0xF
#endif
template <bool GATHER, class Sched, class Epi>
__device__ __forceinline__ void run_gemm(Frame& F, bool mfma, const Sched& S, const Epi& E, int K) {
    if (mfma) pg8::gemm_phase<Sched, Epi, GATHER, MK_ALIGN, MK_SP2>((LAS unsigned char*)F.lds, F.wsb(), S, E, K, F.tid, F.wave);
    else gemm_simple(F, S, E, K);
}

__device__ __forceinline__ void load_q64(const bf16_t* p, float (&q)[64]) {
#pragma unroll
    for (int c = 0; c < 8; ++c) { const u32x4 w = *(const u32x4*)(p + 8 * c);
        q[8 * c + 0] = bf_lo(w.x); q[8 * c + 1] = bf_hi(w.x); q[8 * c + 2] = bf_lo(w.y); q[8 * c + 3] = bf_hi(w.y);
        q[8 * c + 4] = bf_lo(w.z); q[8 * c + 5] = bf_hi(w.z); q[8 * c + 6] = bf_lo(w.w); q[8 * c + 7] = bf_hi(w.w); }
}
__device__ __forceinline__ void attn_key(const float (&q)[64], const bf16_t* kp, const bf16_t* vp, float bias, float& m, float& l, float (&o)[64]) {
    float s0 = bias, s1 = 0.f;
#pragma unroll
    for (int c = 0; c < 8; ++c) { const u32x4 w = *(const u32x4*)(kp + 8 * c);
        s0 += q[8 * c + 0] * bf_lo(w.x) + q[8 * c + 2] * bf_lo(w.y) + q[8 * c + 4] * bf_lo(w.z) + q[8 * c + 6] * bf_lo(w.w);
        s1 += q[8 * c + 1] * bf_hi(w.x) + q[8 * c + 3] * bf_hi(w.y) + q[8 * c + 5] * bf_hi(w.z) + q[8 * c + 7] * bf_hi(w.w); }
    const float s = s0 + s1;
    const float mn = fmaxf(m, s), sc = __expf(m - mn), p = __expf(s - mn);
    l = l * sc + p; m = mn;
#pragma unroll
    for (int c = 0; c < 8; ++c) { const u32x4 w = *(const u32x4*)(vp + 8 * c);
        o[8 * c + 0] = o[8 * c + 0] * sc + p * bf_lo(w.x); o[8 * c + 1] = o[8 * c + 1] * sc + p * bf_hi(w.x);
        o[8 * c + 2] = o[8 * c + 2] * sc + p * bf_lo(w.y); o[8 * c + 3] = o[8 * c + 3] * sc + p * bf_hi(w.y);
        o[8 * c + 4] = o[8 * c + 4] * sc + p * bf_lo(w.z); o[8 * c + 5] = o[8 * c + 5] * sc + p * bf_hi(w.z);
        o[8 * c + 6] = o[8 * c + 6] * sc + p * bf_lo(w.w); o[8 * c + 7] = o[8 * c + 7] * sc + p * bf_hi(w.w); }
}
__device__ __forceinline__ void attn_finish(Frame& F, int r, int ycol, int slot, float l, float (&o)[64]) {
    const float inv = 1.0f / l; float ss = 0.f;
    bf16_t* yp = F.Y() + (size_t)r * D + ycol;
#pragma unroll
    for (int c = 0; c < 8; ++c) { float t[8];
#pragma unroll
        for (int j = 0; j < 8; ++j) { t[j] = o[8 * c + j] * inv; ss += t[j] * t[j]; }
        u32x4 w; w.x = pk2(t[0], t[1]); w.y = pk2(t[2], t[3]); w.z = pk2(t[4], t[5]); w.w = pk2(t[6], t[7]);
        *(u32x4*)(yp + 8 * c) = w; }
    F.SSQ()[(size_t)r * 16 + slot] = ss;
}
__device__ __forceinline__ void attn_item(Frame& F, int l, int variant, int qb, int h) {
    const bool latent = variant < 2; const bool isA = (variant == 0 || variant == 2);
    const int r = (latent ? 0 : NLAT) + qb * NTHR + F.tid;
    const int b = latent ? (r >> 11) : ((r - NLAT) >> 8);
    const int qcol = isA ? QA + 64 * h : QN + 64 * h;
    const int kcol = isA ? KA + 64 * (h / 3) : KN + 64 * h, vcol = isA ? VA + 64 * (h / 3) : VN + 64 * h;
    float q[64], o[64];
    load_q64(F.Z() + (size_t)r * INW + qcol, q);
#pragma unroll
    for (int i = 0; i < 64; ++i) o[i] = 0.f;
    float m, ls;
    if (isA) { m = F.inp(IN_SINK)[l * 6 + h]; ls = 1.0f; } else { m = NEGF; ls = 0.f; }
    const bf16_t* zc = F.Z() + (size_t)(NLAT + b * CTXL) * INW;
#pragma unroll 1
    for (int c = 0; c < CTXL; ++c) attn_key(q, zc + (size_t)c * INW + kcol, zc + (size_t)c * INW + vcol, 0.f, m, ls, o);
    if (variant == 0) {
        const int t = r & (SEQ - 1); const int lo = max(0, t - 128), hi = min(SEQ - 1, t + 128);
        const bf16_t* zb = F.Z() + (size_t)(b * SEQ) * INW;
#pragma unroll 1
        for (int kp = lo; kp <= hi; ++kp) attn_key(q, zb + (size_t)kp * INW + kcol, zb + (size_t)kp * INW + vcol, 0.f, m, ls, o);
    } else if (variant == 1) {
        const int t = r & (SEQ - 1), row = t >> 6, col = t & 63;
        const int rs = min(max(row - 4, 0), 24), cs = min(max(col - 8, 0), 48);
        const bf16_t* zb = F.Z() + (size_t)(b * SEQ) * INW;
        const float* rpb = F.inp(IN_RPB) + (size_t)(l * 6 + h) * 15 * 31;
#pragma unroll 1
        for (int j = 0; j < 8; ++j)
#pragma unroll 1
            for (int cc = 0; cc < 16; ++cc) { const int kr = rs + j, kc = cs + cc; const size_t ko = (size_t)(kr * 64 + kc) * INW;
                const float bias = rpb[(kr - row + 7) * 31 + (kc - col + 15)];
                attn_key(q, zb + ko + kcol, zb + ko + vcol, bias, m, ls, o); }
    }
    attn_finish(F, r, (isA ? 0 : 640) + 64 * h, (isA ? 0 : 10) + h, ls, o);
}

typedef short bf16x8 __attribute__((ext_vector_type(8)));
typedef short s16x4 __attribute__((ext_vector_type(4)));
struct QS { bf16x8 q0, q1; float m, l; f32x4 o[4]; };
__device__ __forceinline__ void qs_init(QS& T, const bf16_t* qp, int g, float m0, float l0) {
    T.q0 = *(const bf16x8*)(qp + 8 * g); T.q1 = *(const bf16x8*)(qp + 32 + 8 * g); T.m = m0; T.l = l0;
#pragma unroll
    for (int d = 0; d < 4; ++d) T.o[d] = (f32x4){0.f, 0.f, 0.f, 0.f};
}
__device__ __forceinline__ s16x4 lds_tr(LAS unsigned char* p) { return __builtin_bit_cast(s16x4, __builtin_amdgcn_ds_read_tr16_b64_v4i16((LAS s16x4*)p)); }
__device__ __forceinline__ void stage_kv(const bf16_t* Z, int zrow0, int nkeys, int kcol, int vcol, LAS unsigned char* Kl, LAS unsigned char* Vl, int tid) {
    for (int idx = tid; idx < nkeys * 8; idx += NTHR) {
        const int kk = idx >> 3, c = idx & 7;
        const bf16_t* zr = Z + (size_t)(zrow0 + kk) * INW;
        const u32x4 kv = *(const u32x4*)(zr + kcol + 8 * c), vv = *(const u32x4*)(zr + vcol + 8 * c);
        *(LAS u32x4*)(Kl + kk * 128 + ((c ^ (kk & 7)) << 4)) = kv;
        *(LAS u32x4*)(Vl + kk * 128 + ((((c >> 1) ^ ((kk >> 1) & 3)) << 5) | ((c & 1) << 4))) = vv;
    }
}
template <class MF>
__device__ __forceinline__ void attn_tile64(QS& T, LAS unsigned char* Kt, LAS unsigned char* Vt, int i, int g, const MF& mf, int kt_lo, int kt_hi) {
    f32x4 s[4];
#pragma unroll
    for (int kt = 0; kt < 4; ++kt) {
        if (kt >= kt_lo && kt <= kt_hi) {
            LAS unsigned char* kr = Kt + (kt * 16 + i) * 128;
            const bf16x8 k0 = *(const LAS bf16x8*)(kr + ((g ^ (i & 7)) << 4)), k1 = *(const LAS bf16x8*)(kr + (((4 + g) ^ (i & 7)) << 4));
            f32x4 a = (f32x4){0.f, 0.f, 0.f, 0.f};
            a = __builtin_amdgcn_mfma_f32_16x16x32_bf16(k0, T.q0, a, 0, 0, 0);
            a = __builtin_amdgcn_mfma_f32_16x16x32_bf16(k1, T.q1, a, 0, 0, 0);
            s[kt] = (f32x4){mf(kt, 0, a.x), mf(kt, 1, a.y), mf(kt, 2, a.z), mf(kt, 3, a.w)};
        } else s[kt] = (f32x4){NEGF, NEGF, NEGF, NEGF};
    }
    float mx = fmaxf(fmaxf(fmaxf(s[0].x, s[0].y), fmaxf(s[0].z, s[0].w)), fmaxf(fmaxf(s[1].x, s[1].y), fmaxf(s[1].z, s[1].w)));
    mx = fmaxf(mx, fmaxf(fmaxf(fmaxf(s[2].x, s[2].y), fmaxf(s[2].z, s[2].w)), fmaxf(fmaxf(s[3].x, s[3].y), fmaxf(s[3].z, s[3].w))));
    mx = fmaxf(mx, __shfl_xor(mx, 16)); mx = fmaxf(mx, __shfl_xor(mx, 32));
    const float mn = fmaxf(T.m, mx), sc = __expf(T.m - mn);
    T.m = mn;
    float ps = 0.f;
#pragma unroll
    for (int kt = 0; kt < 4; ++kt) { s[kt].x = __expf(s[kt].x - mn); s[kt].y = __expf(s[kt].y - mn); s[kt].z = __expf(s[kt].z - mn); s[kt].w = __expf(s[kt].w - mn);
        ps += (s[kt].x + s[kt].y) + (s[kt].z + s[kt].w); }
    T.l = T.l * sc + ps;
#pragma unroll
    for (int d = 0; d < 4; ++d) T.o[d] = T.o[d] * sc;
#pragma unroll
    for (int c = 0; c < 2; ++c) {
        if (2 * c + 1 >= kt_lo && 2 * c <= kt_hi) {
            u32x4 pw; pw.x = pk2(s[2 * c].x, s[2 * c].y); pw.y = pk2(s[2 * c].z, s[2 * c].w); pw.z = pk2(s[2 * c + 1].x, s[2 * c + 1].y); pw.w = pk2(s[2 * c + 1].z, s[2 * c + 1].w);
            const bf16x8 pf = __builtin_bit_cast(bf16x8, pw);
            const int key = 32 * c + 4 * g + (i >> 2);
            LAS unsigned char* vr = Vt + key * 128 + (i & 3) * 8;
            const int sw = (key >> 1) & 3;
#pragma unroll
            for (int dt = 0; dt < 4; ++dt) {
                LAS unsigned char* va = vr + ((dt ^ sw) << 5);
                const s16x4 lo = lds_tr(va), hi = lds_tr(va + 2048);
                const bf16x8 vf = {lo[0], lo[1], lo[2], lo[3], hi[0], hi[1], hi[2], hi[3]};
                T.o[dt] = __builtin_amdgcn_mfma_f32_16x16x32_bf16(vf, pf, T.o[dt], 0, 0, 0);
            }
        }
    }
}
__device__ __forceinline__ void qs_finish(const QS& T, float lsum, bf16_t* Y, float* SSQ, int yrow, int ycol, int slot, int g) {
    const float inv = 1.0f / lsum; float ss = 0.f;
    bf16_t* yp = Y + (size_t)yrow * D + ycol + 4 * g;
#pragma unroll
    for (int dt = 0; dt < 4; ++dt) { const f32x4 v = T.o[dt] * inv; ss += (v.x * v.x + v.y * v.y) + (v.z * v.z + v.w * v.w);
        u32x2 w; w.x = pk2(v.x, v.y); w.y = pk2(v.z, v.w); *(u32x2*)(yp + 16 * dt) = w; }
    ss += __shfl_xor(ss, 16); ss += __shfl_xor(ss, 32);
    if (g == 0) SSQ[(size_t)yrow * 16 + slot] = ss;
}
struct MaskNone { __device__ __forceinline__ float operator()(int, int, float s) const { return s; } };
struct MaskBand { int kb4g, qp;
    __device__ __forceinline__ float operator()(int kt, int r, float s) const { const int d = kb4g + 16 * kt + r - qp; return (d >= -128 && d <= 128) ? s : NEGF; } };
struct MaskNA { const LAS float* rp; int g4, cq, cs;
    __device__ __forceinline__ float operator()(int kt, int r, float s) const { const int kc = 16 * kt + g4 + r; return (kc >= cs && kc < cs + 16) ? s + rp[kc - cq + 15] : NEGF; } };

__device__ __forceinline__ void attnA_item(Frame& F, int l, int b, int n, int half, int kvh) {
    LAS unsigned char* L = (LAS unsigned char*)F.lds;
    const int lane = F.tid & 63, i = lane & 15, g = lane >> 4, w = F.wave;
    const bool latent = n >= 0;
    const int qrow0 = latent ? b * SEQ + n * 128 : NLAT + b * CTXL + half * 128;
    const bf16_t* Z = F.Z();
    QS T[3];
#pragma unroll
    for (int j = 0; j < 3; ++j) { const int tq = 3 * w + j, hq = 3 * kvh + (tq >> 3);
        qs_init(T[j], Z + (size_t)(qrow0 + (tq & 7) * 16 + i) * INW + QA + 64 * hq, g, F.inp(IN_SINK)[l * 6 + hq], g == 0 ? 1.0f : 0.f); }
    __syncthreads();
    stage_kv(Z, NLAT + b * CTXL, CTXL, KA + 64 * kvh, VA + 64 * kvh, L, L + 32768, F.tid);
    __syncthreads();
#pragma unroll
    for (int j = 0; j < 3; ++j)
#pragma unroll 1
        for (int t = 0; t < 4; ++t) attn_tile64(T[j], L + t * 8192, L + 32768 + t * 8192, i, g, MaskNone(), 0, 3);
    if (latent) {
        const int j_lo = (n == 0) ? 2 : 0, j_hi = (n == SEQ / 128 - 1) ? 3 : 5;
        __syncthreads();
        stage_kv(Z, b * SEQ + (n - 1) * 128 + 64 * j_lo, 64 * (j_hi - j_lo + 1), KA + 64 * kvh, VA + 64 * kvh, L + j_lo * 8192, L + 49152 + j_lo * 8192, F.tid);
        __syncthreads();
#pragma unroll
        for (int j = 0; j < 3; ++j) { const int tq = 3 * w + j, qp0 = n * 128 + (tq & 7) * 16;
#pragma unroll 1
            for (int t = j_lo; t <= j_hi; ++t) { const int kb = (n - 1) * 128 + 64 * t;
                if (kb + 63 < qp0 - 128 || kb > qp0 + 15 + 128) continue;
                attn_tile64(T[j], L + t * 8192, L + 49152 + t * 8192, i, g, MaskBand{kb + 4 * g, qp0 + i}, 0, 3); } }
    }
#pragma unroll
    for (int j = 0; j < 3; ++j) { const int tq = 3 * w + j, hq = 3 * kvh + (tq >> 3);
        float ls = T[j].l; ls += __shfl_xor(ls, 16); ls += __shfl_xor(ls, 32);
        qs_finish(T[j], ls, F.Y(), F.SSQ(), qrow0 + (tq & 7) * 16 + i, 64 * hq, hq, g); }
}
constexpr int RPB_OFF = RING_BYTES + 4096;
__device__ __forceinline__ void attnC_item(Frame& F, int l, int b, int rr, int quarter, int h) {
    LAS unsigned char* L = (LAS unsigned char*)F.lds;
    const int lane = F.tid & 63, i = lane & 15, g = lane >> 4, w = F.wave, qt = w & 3, part = w >> 2;
    const bool latent = rr >= 0;
    const int qrow = (latent ? b * SEQ + rr * 64 : NLAT + b * CTXL + quarter * 64) + qt * 16 + i;
    const bf16_t* Z = F.Z();
    QS T; qs_init(T, Z + (size_t)qrow * INW + QN + 64 * h, g, NEGF, 0.f);
    __syncthreads();
    stage_kv(Z, NLAT + b * CTXL, CTXL, KN + 64 * h, VN + 64 * h, L, L + 32768, F.tid);
    if (latent) { LAS float* rl = (LAS float*)(L + RPB_OFF); const float* rg = F.inp(IN_RPB) + (size_t)(l * 6 + h) * 15 * 31;
        for (int x = F.tid; x < 15 * 31; x += NTHR) rl[x] = rg[x]; }
    __syncthreads();
#pragma unroll 1
    for (int t = 2 * part; t < 2 * part + 2; ++t) attn_tile64(T, L + t * 8192, L + 32768 + t * 8192, i, g, MaskNone(), 0, 3);
    if (latent) {
        const int rs = min(max(rr - 4, 0), SEQ / 64 - 8);
        __syncthreads();
        stage_kv(Z, b * SEQ + rs * 64, 512, KN + 64 * h, VN + 64 * h, L, L + 65536, F.tid);
        __syncthreads();
        const int cq = qt * 16 + i, cs = min(max(cq - 8, 0), 48);
        const int kt_lo = qt < 2 ? 0 : qt - 1, kt_hi = qt == 0 ? 1 : (qt == 1 ? 2 : 3);
#pragma unroll 1
        for (int j = 4 * part; j < 4 * part + 4; ++j)
            attn_tile64(T, L + j * 8192, L + 65536 + j * 8192, i, g, MaskNA{(const LAS float*)(L + RPB_OFF) + (rs + j - rr + 7) * 31, 4 * g, cq, cs}, kt_lo, kt_hi);
    }
    __syncthreads();
    LAS float* mg = (LAS float*)L + qt * (18 * 64);
    if (part == 1) { mg[0 * 64 + lane] = T.m; mg[1 * 64 + lane] = T.l;
#pragma unroll
        for (int d = 0; d < 4; ++d) { mg[(2 + 4 * d + 0) * 64 + lane] = T.o[d].x; mg[(2 + 4 * d + 1) * 64 + lane] = T.o[d].y; mg[(2 + 4 * d + 2) * 64 + lane] = T.o[d].z; mg[(2 + 4 * d + 3) * 64 + lane] = T.o[d].w; } }
    __syncthreads();
    if (part == 0) {
        const float mb = mg[0 * 64 + lane], lb = mg[1 * 64 + lane];
        const float mn = fmaxf(T.m, mb), sa = __expf(T.m - mn), sb = __expf(mb - mn);
        float ls = T.l * sa + lb * sb;
#pragma unroll
        for (int d = 0; d < 4; ++d) { const f32x4 ob = {mg[(2 + 4 * d + 0) * 64 + lane], mg[(2 + 4 * d + 1) * 64 + lane], mg[(2 + 4 * d + 2) * 64 + lane], mg[(2 + 4 * d + 3) * 64 + lane]};
            T.o[d] = T.o[d] * sa + ob * sb; }
        ls += __shfl_xor(ls, 16); ls += __shfl_xor(ls, 32);
        qs_finish(T, ls, F.Y(), F.SSQ(), qrow, 640 + 64 * h, 10 + h, g);
    }
}
__device__ __forceinline__ void sgu_item(Frame& F, int l, int ch, int g) {
    float* vg = (float*)F.lds;
    const int row0 = ch < 128 ? ch * 128 : NLAT + (ch - 128) * 128;
    const int p = F.tid >> 2, dq = F.tid & 3;
    __syncthreads();
    {
        const bf16_t* zp = F.Z() + (size_t)(row0 + p) * INW + VB + 64 * g + 16 * dq;
        const u32x4 w0 = *(const u32x4*)zp, w1 = *(const u32x4*)(zp + 8);
        float t[16] = {bf_lo(w0.x), bf_hi(w0.x), bf_lo(w0.y), bf_hi(w0.y), bf_lo(w0.z), bf_hi(w0.z), bf_lo(w0.w), bf_hi(w0.w),
                       bf_lo(w1.x), bf_hi(w1.x), bf_lo(w1.y), bf_hi(w1.y), bf_lo(w1.z), bf_hi(w1.z), bf_lo(w1.w), bf_hi(w1.w)};
        float ss = 0.f;
#pragma unroll
        for (int i = 0; i < 16; ++i) ss += t[i] * t[i];
        ss += __shfl_xor(ss, 1); ss += __shfl_xor(ss, 2);
        const float rstd = 1.0f / sqrtf(ss * (1.0f / 64.0f) + EPS);
        const float* ng = F.inp(IN_SGUG) + l * 256 + 64 * g + 16 * dq;
#pragma unroll
        for (int i = 0; i < 16; ++i) vg[p * 65 + 16 * dq + i] = t[i] * rstd * ng[i];
    }
    __syncthreads();
    float acc[16];
#pragma unroll
    for (int i = 0; i < 16; ++i) acc[i] = 0.f;
    const float* ws = F.inp(IN_SGUW) + ((size_t)(l * 4 + g) * 128 + p) * 128;
#pragma unroll 4
    for (int qq = 0; qq < 128; ++qq) { const float w = ws[qq];
#pragma unroll
        for (int i = 0; i < 16; ++i) acc[i] += w * vg[qq * 65 + 16 * dq + i]; }
    const float bs = F.inp(IN_SGUB)[(l * 4 + g) * 128 + p];
    const bf16_t* up = F.Z() + (size_t)(row0 + p) * INW + UB + 64 * g + 16 * dq;
    const u32x4 u0 = *(const u32x4*)up, u1 = *(const u32x4*)(up + 8);
    const float uu[16] = {bf_lo(u0.x), bf_hi(u0.x), bf_lo(u0.y), bf_hi(u0.y), bf_lo(u0.z), bf_hi(u0.z), bf_lo(u0.w), bf_hi(u0.w),
                          bf_lo(u1.x), bf_hi(u1.x), bf_lo(u1.y), bf_hi(u1.y), bf_lo(u1.z), bf_hi(u1.z), bf_lo(u1.w), bf_hi(u1.w)};
    float ss = 0.f;
#pragma unroll
    for (int i = 0; i < 16; ++i) { acc[i] = uu[i] * (acc[i] + bs); ss += acc[i] * acc[i]; }
    ss += __shfl_xor(ss, 1); ss += __shfl_xor(ss, 2);
    bf16_t* yp = F.Y() + (size_t)(row0 + p) * D + 384 + 64 * g + 16 * dq;
    u32x4 o0, o1; o0.x = pk2(acc[0], acc[1]); o0.y = pk2(acc[2], acc[3]); o0.z = pk2(acc[4], acc[5]); o0.w = pk2(acc[6], acc[7]);
    o1.x = pk2(acc[8], acc[9]); o1.y = pk2(acc[10], acc[11]); o1.z = pk2(acc[12], acc[13]); o1.w = pk2(acc[14], acc[15]);
    *(u32x4*)yp = o0; *(u32x4*)(yp + 8) = o1;
    if (dq == 0) F.SSQ()[(size_t)(row0 + p) * 16 + 6 + g] = ss;
}
#ifndef MK_MIXREF
#define MK_MIXREF 0
#endif
__device__ __forceinline__ void phase_mix(Frame& F, int l) {
    const bool refA = (MK_MIXREF & 1) != 0, refC = (MK_MIXREF & 2) != 0;
    const int nC = refC ? 192 : NB * 6 * (SEQ / 64), nA = refA ? 192 : NB * (SEQ / 128) * 2, nS = 512;
    const int nAc = (l == 0) ? (refA ? 24 : NB * 2 * 2) : 0, nCc = (l == 0) ? (refC ? 24 : NB * 6 * 4) : 0, nSc = (l == 0) ? 64 : 0;
    const int total = nA + nC + nS + nAc + nCc + nSc;
    for (int it = F.bid; it < total; it += F.G) {
        int r = it;
        if (r < nC) { if (refC) attn_item(F, l, 1, r / 6, r % 6); else { const int h = r % 6, q = r / 6; attnC_item(F, l, q >> 5, q & 31, 0, h); } continue; } r -= nC;
        if (r < nA) { if (refA) attn_item(F, l, 0, r / 6, r % 6); else { const int kvh = r & 1, q = r >> 1; attnA_item(F, l, q >> 4, q & 15, 0, kvh); } continue; } r -= nA;
        if (r < nS) { sgu_item(F, l, r >> 2, r & 3); continue; } r -= nS;
        if (r < nAc) { if (refA) attn_item(F, l, 2, r / 6, r % 6); else { const int kvh = r & 1, hf = (r >> 1) & 1, b = r >> 2; attnA_item(F, l, b, -1, hf, kvh); } continue; } r -= nAc;
        if (r < nCc) { if (refC) attn_item(F, l, 3, r / 6, r % 6); else { const int h = r % 6, q = r / 6; attnC_item(F, l, q >> 2, -1, q & 3, h); } continue; } r -= nCc;
        sgu_item(F, l, 128 + (r >> 2), r & 3);
    }
    __syncthreads();
}

__global__ void __launch_bounds__(NTHR, 2) mk_fwd(Params P) {
    extern __shared__ __attribute__((aligned(16))) unsigned char lds[];
    Frame F;
    F.lds = lds; F.tid = threadIdx.x; F.lane = F.tid & 63; F.wave = __builtin_amdgcn_readfirstlane(F.tid >> 6); F.bid = blockIdx.x; F.G = gridDim.x;
    F.P = &P;
    volatile LAS unsigned* MISC = (volatile LAS unsigned*)((LAS unsigned char*)lds + MISC_OFF);
    for (int u = F.tid; u < (LDS_BYTES - RING_BYTES) / 4; u += NTHR) ((LAS unsigned*)((LAS unsigned char*)lds + RING_BYTES))[u] = 0u;
    __syncthreads();
    XcdBarrier bar = xcd_barrier_post(F.ctl() + CW_BAR, MISC + 8);
#define LAUNDER() do { asm volatile("" : "+v"(F.tid)); asm volatile("" : "+v"(F.lane)); asm volatile("" : "+s"(F.bid)); asm volatile("" : "+s"(F.wave)); } while (0)

    constexpr int NPH = 2 + 10 * DEPTH;
#pragma unroll 1
    for (int ph = 0; ph < NPH; ++ph) {
        LAUNDER();
        const int l = ph < 2 ? 0 : (ph - 2) / 10;
        const int k = ph < 2 ? ph - 2 : (ph - 2) % 10;
        const int nrows = (l == 0) ? NTOK : NLAT;
#ifdef MK_REP_PH
        const int nrep = (ph == MK_REP_PH) ? MK_REP_N : 1;
#pragma unroll 1
        for (int rep = 0; rep < nrep; ++rep) {
        if (rep) { xcd_barrier(bar); LAUNDER(); }
#endif
        if (k == -2) p0_prologue(F);
        else if (k == -1) phase_r1(F, 0);
        else if (k == 0) {
            SchedDense S{F.H1(), F.WIN() + (size_t)l * INW * D, D, NTOK / 256, INW / 256, F.G, F.bid, F.wsb()};
            EpiG1 E{F.Z(), F.ROPE()};
            run_gemm<false>(F, (MK_MFMA & 1) != 0, S, E, D);
            if (l == 1) conv_experts(F, 1);
        } else if (k == 1) phase_mix(F, l);
        else if (k == 2) phase_nrm(F, l, nrows);
        else if (k == 3) {
            SchedDense S{F.Y(), F.WOUT() + (size_t)l * D * D, D, nrows / 256, D / 256, F.G, F.bid, F.wsb()};
            EpiG2 E{l == 0 ? F.inp(IN_X) : F.outp(), l == 0 ? F.inp(IN_CTX) : F.XC(), F.outp(), F.XC(), F.MOD(), l};
            run_gemm<false>(F, (MK_MFMA & 2) != 0, S, E, D);
        } else if (k == 4) phase_r2(F, l, nrows);
        else if (k == 5) {
            SchedRG S{F.H1(), F.HLO(), F.RWT() + (size_t)l * 128 * D, nrows / 256, F.G, F.bid, F.wsb()};
            EpiRG E{F.PL()};
            run_gemm<false>(F, true, S, E, D);
        } else if (k == 6) phase_topk(F, l, nrows);
        else if (k == 7) {
            moe_build_tab(F, l, nrows);
            const MoeTab T{(const int*)(F.lds + TOFF_OFF), (const int*)(F.lds + TOFF_OFF) + 72};
            SchedE1 S{T, F.LIST(), F.H1(), F.WEXPGU(), F.WSHGU() + (size_t)l * 512 * D, F.G, F.bid, F.wsb()};
            EpiE1 E{F.HB()};
            run_gemm<true>(F, (MK_MFMA & 4) != 0, S, E, D);
        } else if (k == 8) {
            moe_build_tab(F, l, nrows);
            const MoeTab T{(const int*)(F.lds + TOFF_OFF), (const int*)(F.lds + TOFF_OFF) + 72};
            SchedE2 S{T, F.HB(), F.WEXPD(), F.WSHD() + (size_t)l * D * FF, F.G, F.bid, F.wsb()};
            EpiE2 E{T, F.LIST(), F.LISTW(), F.Y2(), F.outp(), F.XC(), F.MOD(), l};
            run_gemm<false>(F, (MK_MFMA & 8) != 0, S, E, FF);
        } else phase_cmb(F, l, nrows);
#ifdef MK_REP_PH
        }
#endif
        if (ph != NPH - 1) xcd_barrier(bar);
    }
}

extern "C" void kernel_launch(void* const* d_in, const int* in_sizes, int n_in, void* d_out, int out_size, void* d_ws, size_t ws_size, hipStream_t stream) {
    static int grid = 0;
    if (grid == 0) {
        if (n_in != N_IN || in_sizes[0] != NLAT * D || out_size != NLAT * D || ws_size < WS_END) {
            fprintf(stderr, "kernel_launch: unexpected shapes / workspace (n_in %d, in0 %d, out %d, ws %zu need %zu); nothing launched\n", n_in, n_in > 0 ? in_sizes[0] : -1, out_size, ws_size, (size_t)WS_END);
            grid = -1; return; }
        int dev = 0, cus = 0, per_cu = 0;
        if (hipGetDevice(&dev) != hipSuccess || hipDeviceGetAttribute(&cus, hipDeviceAttributeMultiprocessorCount, dev) != hipSuccess) { grid = -1; return; }
        if (hipFuncSetAttribute((const void*)mk_fwd, hipFuncAttributeMaxDynamicSharedMemorySize, LDS_BYTES) != hipSuccess) { fprintf(stderr, "kernel_launch: hipFuncSetAttribute failed\n"); grid = -1; return; }
        if (hipOccupancyMaxActiveBlocksPerMultiprocessor(&per_cu, (const void*)mk_fwd, NTHR, LDS_BYTES) != hipSuccess || per_cu < 1) { fprintf(stderr, "kernel_launch: occupancy query says %d blocks/CU; nothing launched\n", per_cu); grid = -1; return; }
        (void)hipGetLastError();
        grid = cus;
    }
    if (grid < 0) return;
    if (hipMemsetAsync((char*)d_ws + WS_CTL, 0, CTL_ZERO_BYTES, stream) != hipSuccess) return;
    Params p{};
    for (int i = 0; i < N_IN; ++i) p.in[i] = (const float*)d_in[i];
    p.out = (float*)d_out; p.ws = (unsigned char*)d_ws;
    hipLaunchKernelGGL(mk_fwd, dim3(grid), dim3(NTHR), LDS_BYTES, stream, p);
}
```

```cpp
#include <hip/hip_runtime.h>
#include <cstdio>
#include <cstdint>

#define LAS __attribute__((address_space(3)))
typedef unsigned short bf16_t;
typedef float f32x4 __attribute__((ext_vector_type(4)));
typedef float f32x2 __attribute__((ext_vector_type(2)));
typedef unsigned u32x4 __attribute__((ext_vector_type(4)));
typedef unsigned u32x2 __attribute__((ext_vector_type(2)));
typedef __bf16 bf16x2_t __attribute__((ext_vector_type(2)));

constexpr int D = 1024, NB = 8, SEQ = 2048, CTXL = 256, HD = 64, INW = 2304, NE = 64, FF = 256, DEPTH = 2;
constexpr int NLAT = NB * SEQ, NCTX = NB * CTXL, NTOK = NLAT + NCTX;
constexpr int QA = 0, KA = 384, VA = 512, UB = 640, VB = 896, QN = 1152, KN = 1536, VN = 1920;
constexpr float EPS = 1e-6f, NEGF = -1e30f;
constexpr int NWAVES = 8, NTHR = 512;
enum { IN_X = 0, IN_C, IN_CTX, IN_CCTX, IN_MODW, IN_MODB, IN_N1G, IN_WIN, IN_SINK, IN_SGUG, IN_SGUW, IN_SGUB, IN_RPB, IN_GNG, IN_WOUT, IN_N2G,
       IN_RW, IN_RB, IN_EG, IN_EU, IN_ED, IN_SG, IN_SU, IN_SD, IN_FG, N_IN };

constexpr size_t MiB = 1u << 20;
constexpr size_t WS_CTL = 0, CTL_ZERO_BYTES = 64 * 1024;
constexpr size_t WS_MOD = 1 * MiB;
constexpr size_t WS_ROPE = 1 * MiB + 512 * 1024;
constexpr size_t WS_WIN = 2 * MiB;
constexpr size_t WS_WOUT = 11 * MiB;
constexpr size_t WS_WSHGU = 15 * MiB;
constexpr size_t WS_WSHD = 17 * MiB;
constexpr size_t WS_XC = 18 * MiB;
constexpr size_t WS_LIST = 26 * MiB;
constexpr size_t WS_LISTW = 26 * MiB + 4608 * 1024;
constexpr size_t WS_RWT = 35 * MiB;
constexpr size_t WS_SGUW = 35 * MiB + 768 * 1024;
constexpr size_t WS_H1 = 36 * MiB;
constexpr size_t WS_WEXPD = 72 * MiB;
constexpr size_t WS_ZH = 104 * MiB;
constexpr size_t WS_HLO = WS_ZH;
constexpr size_t WS_PL = WS_ZH + 40 * MiB;
constexpr size_t WS_Y2 = 194 * MiB;
constexpr size_t WS_Y = WS_Y2;
constexpr size_t WS_SSQ = WS_Y2 + 36 * MiB;
constexpr size_t WS_WEXPGU = WS_Y2 + 38 * MiB;
constexpr size_t WS_END = WS_Y2 + 288 * MiB;
constexpr int LIST_CAP = NTOK;
constexpr int CW_BAR = 4096, CW_CNT = 8192;

constexpr int RING_BYTES = 147456, MISC_OFF = RING_BYTES + 320, TOFF_OFF = RING_BYTES + 1024, LDS_BYTES = 163840;

__device__ __forceinline__ unsigned pk2(float lo, float hi) { f32x2 v = {lo, hi}; bf16x2_t b = __builtin_convertvector(v, bf16x2_t); return __builtin_bit_cast(unsigned, b); }
__device__ __forceinline__ float bf_lo(unsigned w) { return __uint_as_float(w << 16); }
__device__ __forceinline__ float bf_hi(unsigned w) { return __uint_as_float(w & 0xffff0000u); }
__device__ __forceinline__ float wave_sum(float v) {
#pragma unroll
    for (int o = 1; o < 64; o <<= 1) v += __shfl_xor(v, o);
    return v;
}
__device__ __forceinline__ float gelu_tanh(float x) {
    const float u = 0.7978845608028654f * (x + 0.044715f * x * x * x);
    const float e = __expf(2.f * u);
    const float t = 1.f - 2.f / (e + 1.f);
    return 0.5f * x * (1.f + t);
}
__device__ __forceinline__ float silu_f(float x) { return x / (1.f + __expf(-x)); }

#define XB_TMO      128
#define XB_XCNT(j)  (256  + 64 * (j))
#define XB_XSUB(j)  (1280 + 64 * (j))
#define XB_XGEN(j)  (2304 + 64 * (j))
#define XB_TOP      3328
#define XB_TOPGEN   3392
#define XCD_BAR_WORDS 3456
#define XB_SPIN_CAP (1u << 18)
__device__ __forceinline__ unsigned xb_ld(unsigned* p)              { return __hip_atomic_load(p, __ATOMIC_RELAXED, __HIP_MEMORY_SCOPE_AGENT); }
__device__ __forceinline__ unsigned xb_add(unsigned* p, unsigned v) { return __hip_atomic_fetch_add(p, v, __ATOMIC_RELAXED, __HIP_MEMORY_SCOPE_AGENT); }
__device__ __forceinline__ unsigned xb_xcc_id() { return (unsigned)__builtin_amdgcn_s_getreg((3 << 11) | 20) & 0xFu; }
#define XB_SPIN(cond, bar) do { unsigned _sp = 0; while (cond) { __builtin_amdgcn_s_sleep(1); \
    if ((++_sp & 255u) == 0u) { if (xb_ld(&(bar)[XB_TMO])) break; if (_sp > XB_SPIN_CAP) { atomicAdd(&(bar)[XB_TMO], 1u); break; } } } } while (0)
struct XcdBarrier { unsigned* bar; unsigned x; volatile LAS unsigned* st; };
__device__ __forceinline__ XcdBarrier xcd_barrier_post(unsigned* bar, volatile LAS unsigned* st) {
    XcdBarrier b; b.bar = bar; b.x = xb_xcc_id(); b.st = st;
    if (threadIdx.x == 0) (void)xb_add(&bar[XB_XCNT(b.x)], 1u);
    return b;
}
__device__ __forceinline__ void xcd_barrier_complete(unsigned* bar, unsigned x, unsigned& nloc, unsigned& nx) {
    const unsigned G = gridDim.x * gridDim.y * gridDim.z;
    unsigned sum, cnt, mine, sp = 0u;
    for (;;) {
        sum = 0u; cnt = 0u; mine = 0u;
#pragma unroll 1
        for (unsigned j = 0; j < 16; ++j) { const unsigned c = xb_ld(&bar[XB_XCNT(j)]); sum += c; cnt += (c > 0u) ? 1u : 0u; mine = (j == x) ? c : mine; }
        if (sum == G) break;
        __builtin_amdgcn_s_sleep(1);
        if ((++sp & 255u) == 0u) { if (xb_ld(&bar[XB_TMO])) break; if (sp > XB_SPIN_CAP) { atomicAdd(&bar[XB_TMO], 1u); break; } }
    }
    nloc = mine > 0u ? mine : 1u; nx = cnt > 0u ? cnt : 1u;
}
__device__ __forceinline__ void xcd_barrier(const XcdBarrier& b) {
    asm volatile("s_waitcnt vmcnt(0)" ::: "memory");
    __syncthreads();
    if (threadIdx.x == 0) {
        unsigned* bar = b.bar;
        __builtin_amdgcn_s_waitcnt(0);
        unsigned nloc = b.st[0], nx = b.st[1];
        if (nloc == 0u) { xcd_barrier_complete(bar, b.x, nloc, nx); b.st[0] = nloc; b.st[1] = nx; }
        const unsigned old = xb_add(&bar[XB_XSUB(b.x)], 1u);
        const unsigned gen = old / nloc;
        if (old + 1u == (gen + 1u) * nloc) {
            __builtin_amdgcn_fence(__ATOMIC_RELEASE, "agent");
            asm volatile("s_waitcnt vmcnt(0)" ::: "memory");
            const unsigned og = xb_add(&bar[XB_TOP], 1u);
            const unsigned tg = og / nx;
            if (og + 1u == (tg + 1u) * nx) xb_add(&bar[XB_TOPGEN], 1u);
            else XB_SPIN(xb_ld(&bar[XB_TOPGEN]) == tg, bar);
            __builtin_amdgcn_fence(__ATOMIC_ACQUIRE, "agent");
            xb_add(&bar[XB_XGEN(b.x)], 1u);
            asm volatile("s_waitcnt vmcnt(0)" ::: "memory");
        } else {
            XB_SPIN(xb_ld(&bar[XB_XGEN(b.x)]) == gen, bar);
            __builtin_amdgcn_fence(__ATOMIC_ACQUIRE, "agent");
            asm volatile("s_waitcnt vmcnt(0)" ::: "memory");
        }
    }
    __syncthreads();
}

struct Params { const float* in[N_IN]; float* out; unsigned char* ws; };

struct Frame {
    unsigned char* lds;
    int tid, lane, wave, bid, G;
    const Params* P;
    __device__ __forceinline__ const float* inp(int i) const { return P->in[i]; }
    __device__ __forceinline__ float* outp() const { return P->out; }
    __device__ __forceinline__ unsigned char* wsb() const { return P->ws; }
    __device__ __forceinline__ unsigned* ctl() const { return (unsigned*)(P->ws + WS_CTL); }
    __device__ __forceinline__ float* MOD() const { return (float*)(P->ws + WS_MOD); }
    __device__ __forceinline__ float* ROPE() const { return (float*)(P->ws + WS_ROPE); }
    __device__ __forceinline__ bf16_t* WIN() const { return (bf16_t*)(P->ws + WS_WIN); }
    __device__ __forceinline__ bf16_t* WOUT() const { return (bf16_t*)(P->ws + WS_WOUT); }
    __device__ __forceinline__ bf16_t* WSHGU() const { return (bf16_t*)(P->ws + WS_WSHGU); }
    __device__ __forceinline__ bf16_t* WSHD() const { return (bf16_t*)(P->ws + WS_WSHD); }
    __device__ __forceinline__ bf16_t* WEXPGU() const { return (bf16_t*)(P->ws + WS_WEXPGU); }
    __device__ __forceinline__ bf16_t* WEXPD() const { return (bf16_t*)(P->ws + WS_WEXPD); }
    __device__ __forceinline__ bf16_t* H1() const { return (bf16_t*)(P->ws + WS_H1); }
    __device__ __forceinline__ bf16_t* HLO() const { return (bf16_t*)(P->ws + WS_HLO); }
    __device__ __forceinline__ bf16_t* SGUW() const { return (bf16_t*)(P->ws + WS_SGUW); }
    __device__ __forceinline__ bf16_t* RWT() const { return (bf16_t*)(P->ws + WS_RWT); }
    __device__ __forceinline__ float* PL() const { return (float*)(P->ws + WS_PL); }
    __device__ __forceinline__ bf16_t* Z() const { return (bf16_t*)(P->ws + WS_ZH); }
    __device__ __forceinline__ bf16_t* HB() const { return (bf16_t*)(P->ws + WS_ZH); }
    __device__ __forceinline__ bf16_t* Y() const { return (bf16_t*)(P->ws + WS_Y); }
    __device__ __forceinline__ bf16_t* Y2() const { return (bf16_t*)(P->ws + WS_Y2); }
    __device__ __forceinline__ float* XC() const { return (float*)(P->ws + WS_XC); }
    __device__ __forceinline__ float* SSQ() const { return (float*)(P->ws + WS_SSQ); }
    __device__ __forceinline__ float* LISTW() const { return (float*)(P->ws + WS_LISTW); }
    __device__ __forceinline__ unsigned* LIST() const { return (unsigned*)(P->ws + WS_LIST); }
};
__device__ __forceinline__ float* xa_row(const Frame& F, int r) { return r < NLAT ? F.outp() + (size_t)r * D : F.XC() + (size_t)(r - NLAT) * D; }
__device__ __forceinline__ int mod_row(int r) { return r < NLAT ? (r >> 11) : 8; }
__device__ __forceinline__ const float* mod_ptr(const Frame& F, int l, int r, int chunk) { return F.MOD() + ((size_t)(l * 9 + mod_row(r)) * 6 + chunk) * D; }
__device__ __forceinline__ unsigned* cnt_ptr(const Frame& F, int l, int e) { return F.ctl() + CW_CNT + (l * 64 + e) * 16; }

__device__ __forceinline__ void transpose_item(const float* W, int K, int N, bf16_t* WT, int k0, int n0, int rbase, float* scr, int lane) {
#pragma unroll 8
    for (int i = 0; i < 32; ++i) { const int kk = 2 * i + (lane >> 5); scr[kk * 33 + (lane & 31)] = W[(size_t)(k0 + kk) * N + n0 + (lane & 31)]; }
    asm volatile("s_waitcnt lgkmcnt(0)" ::: "memory");
    const int c = lane & 7;
#pragma unroll
    for (int j = 0; j < 4; ++j) { const int n = (lane >> 3) + 8 * j; const float* s = scr + (8 * c) * 33 + n;
        u32x4 o; o.x = pk2(s[0 * 33], s[1 * 33]); o.y = pk2(s[2 * 33], s[3 * 33]); o.z = pk2(s[4 * 33], s[5 * 33]); o.w = pk2(s[6 * 33], s[7 * 33]);
        *(u32x4*)(WT + (size_t)(rbase + n) * K + k0 + 8 * c) = o; }
    asm volatile("s_waitcnt lgkmcnt(0)" ::: "memory");
}
__device__ __forceinline__ void conv_weight(const float* W, int K, int N, bf16_t* WT, int gu, int item, float* scr, int lane) {
    const int nblk = N / 32, kb = item / nblk, nb = item % nblk, n0 = 32 * nb;
    const int rbase = gu == 0 ? n0 : ((n0 >> 7) * 256 + (n0 & 127) + (gu == 2 ? 128 : 0));
    transpose_item(W, K, N, WT, 64 * kb, n0, rbase, scr, lane);
}
__device__ __forceinline__ void conv_experts(Frame& F, int l) {
    float* scr = (float*)(F.lds + F.wave * 16384);
    const int gw = F.bid * NWAVES + F.wave, NGW = F.G * NWAVES;
    constexpr int IG = (D / 64) * (FF / 32), ID = (FF / 64) * (D / 32);
    constexpr int PER = 2 * IG + ID;
    for (int it = gw; it < NE * PER; it += NGW) {
        const int e = it / PER; int r = it % PER;
        const size_t eo = (size_t)(l * NE + e) * D * FF;
        if (r < IG) { conv_weight(F.inp(IN_EG) + eo, D, FF, F.WEXPGU() + (size_t)e * 512 * D, 1, r, scr, F.lane); continue; } r -= IG;
        if (r < IG) { conv_weight(F.inp(IN_EU) + eo, D, FF, F.WEXPGU() + (size_t)e * 512 * D, 2, r, scr, F.lane); continue; } r -= IG;
        conv_weight(F.inp(IN_ED) + eo, FF, D, F.WEXPD() + (size_t)e * D * FF, 0, r, scr, F.lane);
    }
}
__device__ __forceinline__ void p0_prologue(Frame& F) {
    if (F.bid == 0) {
        for (int i = F.tid; i < 64 * 16; i += NTHR) { const int pos = i >> 4, f = i & 15;
            const float inv = powf(10000.0f, -(float)(2 * f) / 32.0f); const float a = (float)pos * inv;
            F.ROPE()[i] = cosf(a); F.ROPE()[1024 + i] = sinf(a); }
    }
    {
        float* sl = (float*)F.lds;
        float* red = (float*)(F.lds + 40960);
        bool have = false;
        for (int it = F.bid; it < 2 * 96; it += F.G) {
            if (!have) {
                for (int i = F.tid; i < 9 * D; i += NTHR) { const int r = i >> 10, k = i & 1023; const float v = r < 8 ? F.inp(IN_C)[r * D + k] : F.inp(IN_CCTX)[k]; sl[i] = silu_f(v); }
                __syncthreads(); have = true;
            }
            const int l = it / 96, jc = it % 96, c = F.tid & 63, kg = F.tid >> 6;
            const float* W = F.inp(IN_MODW) + (size_t)l * D * 6144 + 64 * jc + c;
            float acc[9];
#pragma unroll
            for (int r = 0; r < 9; ++r) acc[r] = 0.f;
#pragma unroll 8
            for (int k = 128 * kg; k < 128 * kg + 128; ++k) { const float w = W[(size_t)k * 6144];
#pragma unroll
                for (int r = 0; r < 9; ++r) acc[r] += sl[r * D + k] * w; }
#pragma unroll
            for (int r = 0; r < 9; ++r) red[(kg * 9 + r) * 64 + c] = acc[r];
            __syncthreads();
            for (int i = F.tid; i < 9 * 64; i += NTHR) { const int r = i >> 6, cc = i & 63; float s = 0.f;
#pragma unroll
                for (int g = 0; g < 8; ++g) s += red[(g * 9 + r) * 64 + cc];
                F.MOD()[(size_t)(l * 9 + r) * 6144 + 64 * jc + cc] = s + F.inp(IN_MODB)[l * 6144 + 64 * jc + cc]; }
            __syncthreads();
        }
        __syncthreads();
    }
    {
        float* scr = (float*)(F.lds + F.wave * 16384);
        const int gw = F.bid * NWAVES + F.wave, NGW = F.G * NWAVES;
        constexpr int I_IN = (D / 64) * (INW / 32), I_OUT = (D / 64) * (D / 32), I_SG = (D / 64) * (FF / 32), I_SD = (FF / 64) * (D / 32);
        constexpr int PER = I_IN + I_OUT + 2 * I_SG + I_SD;
        for (int it = gw; it < 2 * PER; it += NGW) {
            const int l = it / PER; int r = it % PER;
            if (r < I_IN) { conv_weight(F.inp(IN_WIN) + (size_t)l * D * INW, D, INW, F.WIN() + (size_t)l * INW * D, 0, r, scr, F.lane); continue; } r -= I_IN;
            if (r < I_OUT) { conv_weight(F.inp(IN_WOUT) + (size_t)l * D * D, D, D, F.WOUT() + (size_t)l * D * D, 0, r, scr, F.lane); continue; } r -= I_OUT;
            if (r < I_SG) { conv_weight(F.inp(IN_SG) + (size_t)l * D * FF, D, FF, F.WSHGU() + (size_t)l * 512 * D, 1, r, scr, F.lane); continue; } r -= I_SG;
            if (r < I_SG) { conv_weight(F.inp(IN_SU) + (size_t)l * D * FF, D, FF, F.WSHGU() + (size_t)l * 512 * D, 2, r, scr, F.lane); continue; } r -= I_SG;
            conv_weight(F.inp(IN_SD) + (size_t)l * FF * D, FF, D, F.WSHD() + (size_t)l * D * FF, 0, r, scr, F.lane);
        }
    }
    for (int idx = F.bid * NTHR + F.tid; idx < 2 * NE * D; idx += F.G * NTHR) {
        const int l = idx / (NE * D), e = (idx / D) % NE, k = idx % D;
        const float w = F.inp(IN_RW)[(size_t)l * D * NE + (size_t)k * NE + e];
        const unsigned hi = pk2(w, 0.f) & 0xffffu; const float lo = w - bf_lo(hi);
        F.RWT()[((size_t)l * 128 + e) * D + k] = (bf16_t)hi; F.RWT()[((size_t)l * 128 + 64 + e) * D + k] = (bf16_t)(pk2(lo, 0.f) & 0xffffu);
    }
    for (int idx = F.bid * NTHR + F.tid; idx < 2 * 4 * 128 * 128 / 2; idx += F.G * NTHR) {
        const f32x2 w = *(const f32x2*)(F.inp(IN_SGUW) + 2 * (size_t)idx); *(unsigned*)(F.SGUW() + 2 * (size_t)idx) = pk2(w.x, w.y); }
    conv_experts(F, 0);
}

__device__ __forceinline__ void load_row(const float* src, int lane, f32x4 (&v)[4]) {
#pragma unroll
    for (int j = 0; j < 4; ++j) v[j] = *(const f32x4*)(src + 4 * lane + 256 * j);
}
__device__ __forceinline__ float row_rstd(const f32x4 (&v)[4]) {
    float s = 0.f;
#pragma unroll
    for (int j = 0; j < 4; ++j) s += (v[j].x * v[j].x + v[j].y * v[j].y) + (v[j].z * v[j].z + v[j].w * v[j].w);
    return 1.0f / sqrtf(wave_sum(s) * (1.0f / D) + EPS);
}
__device__ __forceinline__ void norm_mod(const f32x4 (&v)[4], float rstd, const float* g, const float* sh, const float* sc, int lane, f32x4 (&h)[4]) {
#pragma unroll
    for (int j = 0; j < 4; ++j) { const int c = 4 * lane + 256 * j; const f32x4 gg = *(const f32x4*)(g + c), s1 = *(const f32x4*)(sh + c), s2 = *(const f32x4*)(sc + c);
        h[j] = v[j] * rstd * gg * (1.0f + s2) + s1; }
}
__device__ __forceinline__ void store_row_bf16(bf16_t* dst, int lane, const f32x4 (&h)[4]) {
#pragma unroll
    for (int j = 0; j < 4; ++j) { u32x2 w; w.x = pk2(h[j].x, h[j].y); w.y = pk2(h[j].z, h[j].w); *(u32x2*)(dst + 4 * lane + 256 * j) = w; }
}
__device__ __forceinline__ void phase_r1(Frame& F, int l) {
    const int gw = F.bid * NWAVES + F.wave, NGW = F.G * NWAVES;
    for (int r = gw; r < NTOK; r += NGW) {
        const float* src = (l == 0) ? (r < NLAT ? F.inp(IN_X) + (size_t)r * D : F.inp(IN_CTX) + (size_t)(r - NLAT) * D) : xa_row(F, r);
        f32x4 v[4], h[4]; load_row(src, F.lane, v);
        const float rstd = row_rstd(v);
        norm_mod(v, rstd, F.inp(IN_N1G) + l * D, mod_ptr(F, l, r, 0), mod_ptr(F, l, r, 1), F.lane, h);
        store_row_bf16(F.H1() + (size_t)r * D, F.lane, h);
    }
}
__device__ __forceinline__ void phase_nrm(Frame& F, int l, int nrows) {
    const int gw = F.bid * NWAVES + F.wave, NGW = F.G * NWAVES;
    for (int r = gw; r < nrows; r += NGW) {
        const float* sq = F.SSQ() + (size_t)r * 16;
        const float sA = sq[0] + sq[1] + sq[2] + sq[3] + sq[4] + sq[5], sB = sq[6] + sq[7] + sq[8] + sq[9], sC = sq[10] + sq[11] + sq[12] + sq[13] + sq[14] + sq[15];
        const float rA = 1.0f / sqrtf(sA * (1.0f / 384.0f) + EPS), rB = 1.0f / sqrtf(sB * (1.0f / 256.0f) + EPS), rC = 1.0f / sqrtf(sC * (1.0f / 384.0f) + EPS);
        bf16_t* yr = F.Y() + (size_t)r * D;
#pragma unroll
        for (int j = 0; j < 4; ++j) { const int c = 4 * F.lane + 256 * j; const float rs = c < 384 ? rA : (c < 640 ? rB : rC);
            const u32x2 w = *(const u32x2*)(yr + c); const f32x4 gg = *(const f32x4*)(F.inp(IN_GNG) + l * D + c);
            u32x2 o; o.x = pk2(bf_lo(w.x) * rs * gg.x, bf_hi(w.x) * rs * gg.y); o.y = pk2(bf_lo(w.y) * rs * gg.z, bf_hi(w.y) * rs * gg.w);
            *(u32x2*)(yr + c) = o; }
    }
}
__device__ __forceinline__ void phase_r2(Frame& F, int l, int nrows) {
    const int gw = F.bid * NWAVES + F.wave, NGW = F.G * NWAVES;
    for (int r = gw; r < nrows; r += NGW) {
        f32x4 v[4], h[4]; load_row(xa_row(F, r), F.lane, v);
        const float rstd = row_rstd(v);
        norm_mod(v, rstd, F.inp(IN_N2G) + l * D, mod_ptr(F, l, r, 3), mod_ptr(F, l, r, 4), F.lane, h);
        bf16_t* hp = F.H1() + (size_t)r * D; bf16_t* lp = F.HLO() + (size_t)r * D;
#pragma unroll
        for (int j = 0; j < 4; ++j) { u32x2 w; w.x = pk2(h[j].x, h[j].y); w.y = pk2(h[j].z, h[j].w); *(u32x2*)(hp + 4 * F.lane + 256 * j) = w;
            u32x2 q; q.x = pk2(h[j].x - bf_lo(w.x), h[j].y - bf_hi(w.x)); q.y = pk2(h[j].z - bf_lo(w.y), h[j].w - bf_hi(w.y)); *(u32x2*)(lp + 4 * F.lane + 256 * j) = q; }
    }
}
constexpr int TK_CAP = 96;
__device__ __forceinline__ void phase_topk(Frame& F, int l, int nrows) {
    unsigned* hist = (unsigned*)F.lds; unsigned* base = hist + 64; unsigned* stE = (unsigned*)(F.lds + 1024); float* stW = (float*)(F.lds + 1024 + NE * TK_CAP * 4);
    const int rpb = (nrows + F.G - 1) / F.G, r0 = F.bid * rpb, r1 = min(nrows, r0 + rpb);
    const float rbias = F.inp(IN_RB)[l * NE + F.lane];
    const float* PL = F.PL();
    if (F.tid < NE) hist[F.tid] = 0u;
    __syncthreads();
#pragma unroll 1
    for (int r = r0 + F.wave; r < r1; r += NWAVES) {
        const float logit = (PL[(size_t)r * NE + F.lane] + PL[(size_t)(NTOK + r) * NE + F.lane]) + PL[(size_t)(2 * NTOK + r) * NE + F.lane];
        const float score = 1.0f / (1.0f + expf(-logit));
        const float sel = score + rbias;
        float m1 = sel;
#pragma unroll
        for (int o = 1; o < 8; o <<= 1) m1 = fmaxf(m1, __shfl_xor(m1, o));
        const unsigned long long bal = __ballot(sel == m1);
        const unsigned gm = (unsigned)(bal >> (F.lane & ~7)) & 0xffu; const int first = __ffs(gm) - 1;
        float m2 = ((F.lane & 7) == first) ? -3.0e38f : sel;
#pragma unroll
        for (int o = 1; o < 8; o <<= 1) m2 = fmaxf(m2, __shfl_xor(m2, o));
        const float gs = m1 + m2; const int g = F.lane >> 3; int rank = 0;
#pragma unroll
        for (int j = 0; j < 8; ++j) { const float o = __shfl(gs, j * 8); rank += ((o > gs) || (o == gs && j < g)) ? 1 : 0; }
        const float msel = rank < 4 ? sel : NEGF;
        int r2 = 0;
#pragma unroll
        for (int j = 0; j < 64; ++j) { const float o = __shfl(msel, j); r2 += ((o > msel) || (o == msel && j < F.lane)) ? 1 : 0; }
        const bool chosen = r2 < 8;
        const float wsum = wave_sum(chosen ? score : 0.f);
        if (chosen) {
            const unsigned lp = atomicAdd(&hist[F.lane], 1u);
            if (lp < (unsigned)TK_CAP) { stE[F.lane * TK_CAP + lp] = (unsigned)r | ((unsigned)r2 << 16); stW[F.lane * TK_CAP + lp] = score / wsum * 2.5f; }
        }
    }
    __syncthreads();
    if (F.tid < NE) { const unsigned n = min(hist[F.tid], (unsigned)TK_CAP); base[F.tid] = n ? atomicAdd(cnt_ptr(F, l, F.tid), n) : 0u; }
    __syncthreads();
    for (int x = F.tid; x < NE * TK_CAP; x += NTHR) { const int e = x / TK_CAP, j = x % TK_CAP;
        if ((unsigned)j < min(hist[e], (unsigned)TK_CAP)) { F.LIST()[(size_t)e * LIST_CAP + base[e] + j] = stE[x]; F.LISTW()[(size_t)e * LIST_CAP + base[e] + j] = stW[x]; } }
    __syncthreads();
}
__device__ __forceinline__ void phase_cmb(Frame& F, int l, int nrows) {
    const int gw = F.bid * NWAVES + F.wave, NGW = F.G * NWAVES;
    for (int r = gw; r < nrows; r += NGW) {
        float* xr = xa_row(F, r);
        f32x4 v[4]; load_row(xr, F.lane, v);
        f32x4 s[4];
#pragma unroll
        for (int j = 0; j < 4; ++j) s[j] = (f32x4){0.f, 0.f, 0.f, 0.f};
        const bf16_t* yb = F.Y2() + (size_t)r * 8 * D;
#pragma unroll
        for (int k = 0; k < 8; ++k)
#pragma unroll
            for (int j = 0; j < 4; ++j) { const u32x2 w = *(const u32x2*)(yb + (size_t)k * D + 4 * F.lane + 256 * j);
                s[j].x += bf_lo(w.x); s[j].y += bf_hi(w.x); s[j].z += bf_lo(w.y); s[j].w += bf_hi(w.y); }
        const float* g2 = mod_ptr(F, l, r, 5);
#pragma unroll
        for (int j = 0; j < 4; ++j) v[j] = v[j] + *(const f32x4*)(g2 + 4 * F.lane + 256 * j) * s[j];
        const float rstd = row_rstd(v);
        if (l == 0) {
#pragma unroll
            for (int j = 0; j < 4; ++j) *(f32x4*)(xr + 4 * F.lane + 256 * j) = v[j];
            f32x4 h[4];
            norm_mod(v, rstd, F.inp(IN_N1G) + D, mod_ptr(F, 1, r, 0), mod_ptr(F, 1, r, 1), F.lane, h);
            store_row_bf16(F.H1() + (size_t)r * D, F.lane, h);
        } else {
#pragma unroll
            for (int j = 0; j < 4; ++j) { const f32x4 gg = *(const f32x4*)(F.inp(IN_FG) + 4 * F.lane + 256 * j); *(f32x4*)(xr + 4 * F.lane + 256 * j) = v[j] * rstd * gg; }
        }
    }
}

struct NoState {};
struct Unit { int pm, pn, e, lt; };

struct SchedDense {
    const bf16_t* A; const bf16_t* Bt; int K, nM, nN, G, c;
    __device__ __forceinline__ bool next(int i, Unit& u) const {
        const int L = i * G + c; if (L >= nM * nN) return false;
        u.pn = __builtin_amdgcn_readfirstlane(L % nN); u.pm = __builtin_amdgcn_readfirstlane(L / nN); u.e = 0; u.lt = 0; return true;
    }
    __device__ __forceinline__ const bf16_t* a_row(const Unit& u, int r) const { return A + (size_t)(u.pm * 256 + r) * K; }
    __device__ __forceinline__ const bf16_t* b_row(const Unit& u, int c_) const { return Bt + (size_t)(u.pn * 256 + c_) * K; }
    const unsigned char* ws;
    __device__ __forceinline__ unsigned a_off(const Unit& u) const { return (unsigned)((const unsigned char*)A - ws) + (unsigned)u.pm * (unsigned)(512 * K); }
    __device__ __forceinline__ unsigned b_off(const Unit& u) const { return (unsigned)((const unsigned char*)Bt - ws) + (unsigned)u.pn * (unsigned)(512 * K); }
};
struct SchedRG {
    const bf16_t* H1; const bf16_t* HLO; const bf16_t* RW; int nM, G, c; const unsigned char* ws;
    __device__ __forceinline__ bool next(int i, Unit& u) const {
        const int L = i * G + c; if (L >= nM * 2) return false;
        u.pm = __builtin_amdgcn_readfirstlane(L >> 1); u.pn = 0; u.e = __builtin_amdgcn_readfirstlane(L & 1); u.lt = 0; return true;
    }
    __device__ __forceinline__ const bf16_t* a_row(const Unit& u, int r) const { return (u.e ? HLO : H1) + (size_t)(u.pm * 256 + r) * D; }
    __device__ __forceinline__ const bf16_t* b_row(const Unit& u, int c_) const { return RW + (size_t)c_ * D; }
    __device__ __forceinline__ unsigned a_off(const Unit& u) const { return (u.e ? (unsigned)((const unsigned char*)HLO - ws) : (unsigned)((const unsigned char*)H1 - ws)) + (unsigned)u.pm * (unsigned)(512 * D); }
    __device__ __forceinline__ unsigned b_off(const Unit&) const { return (unsigned)((const unsigned char*)RW - ws); }
};
struct EpiRG {
    float* PL;
    typedef NoState US; typedef NoState Pre;
    __device__ __forceinline__ US ubegin(const Unit&, int) const { return US(); }
    __device__ __forceinline__ Pre pre(const Unit&, int, int) const { return Pre(); }
    __device__ __forceinline__ void fin(const Unit& u, int r, int cbase, const f32x4 (&v)[2][2], const Pre&, const US&) const {
        const int grow = u.pm * 256 + r;
#pragma unroll
        for (int n = 0; n < 2; ++n) { const int c = cbase + 16 * n;
            if (u.e == 0) *(f32x4*)(PL + ((size_t)(c < 64 ? 0 : NTOK) + grow) * NE + (c & 63)) = v[0][n];
            else if (c < 64) *(f32x4*)(PL + ((size_t)(2 * NTOK) + grow) * NE + c) = v[0][n]; }
    }
};
struct MoeTab { const int* toff; const int* cnt; };
__device__ __forceinline__ void moe_build_tab(Frame& F, int l, int nrows_shared) {
    int* toff = (int*)(F.lds + TOFF_OFF); int* cnt = toff + 72;
    __syncthreads();
    if (F.tid == 0) { int acc = 0;
        for (int e = 0; e < NE; ++e) { const int c = (int)__hip_atomic_load(cnt_ptr(F, l, e), __ATOMIC_RELAXED, __HIP_MEMORY_SCOPE_AGENT); cnt[e] = c; toff[e] = acc; acc += (c + 255) >> 8; }
        cnt[NE] = nrows_shared; toff[NE] = acc; acc += nrows_shared >> 8; toff[NE + 1] = acc; }
    __syncthreads();
}
__device__ __forceinline__ void moe_find(const MoeTab& T, int tg, Unit& u) {
    const int lane = (int)__builtin_amdgcn_mbcnt_hi(~0u, __builtin_amdgcn_mbcnt_lo(~0u, 0u));
    const int e = __popcll(__ballot(T.toff[lane + 1] <= tg));
    u.pm = __builtin_amdgcn_readfirstlane(tg); u.e = __builtin_amdgcn_readfirstlane(e); u.lt = __builtin_amdgcn_readfirstlane(tg - T.toff[e]);
}
struct SchedE1 {
    MoeTab T; const unsigned* LIST; const bf16_t* H1; const bf16_t* WGU; const bf16_t* WSH; int G, c;
    __device__ __forceinline__ bool next(int i, Unit& u) const {
        const int L = i * G + c; if (L >= __builtin_amdgcn_readfirstlane(T.toff[NE + 1]) * 2) return false;
        u.pn = __builtin_amdgcn_readfirstlane(L & 1); moe_find(T, L >> 1, u); return true;
    }
    __device__ __forceinline__ int token(const Unit& u, int r) const {
        const int idx = u.lt * 256 + r;
        if (u.e == NE) return idx;
        return idx < T.cnt[u.e] ? (int)(LIST[(size_t)u.e * LIST_CAP + idx] & 0xffffu) : 0;
    }
    __device__ __forceinline__ const bf16_t* a_row(const Unit& u, int r) const { return H1 + (size_t)token(u, r) * D; }
    __device__ __forceinline__ const bf16_t* b_row(const Unit& u, int c_) const { return (u.e == NE ? WSH : WGU + (size_t)u.e * 512 * D) + (size_t)(u.pn * 256 + c_) * D; }
    const unsigned char* ws;
    __device__ __forceinline__ unsigned a_org() const { return (unsigned)((const unsigned char*)H1 - ws); }
    __device__ __forceinline__ unsigned a_rowoff(const Unit& u, int r) const { return (unsigned)token(u, r) * (unsigned)(D * 2); }
    __device__ __forceinline__ unsigned b_off(const Unit& u) const {
        const unsigned sh = (unsigned)((const unsigned char*)WSH - ws), ex = (unsigned)((const unsigned char*)WGU - ws) + (unsigned)u.e * (unsigned)(512 * D * 2);
        return (u.e == NE ? sh : ex) + (unsigned)u.pn * (unsigned)(256 * D * 2); }
};
struct SchedE2 {
    MoeTab T; const bf16_t* HB; const bf16_t* WD; const bf16_t* WSH; int G, c;
    __device__ __forceinline__ bool next(int i, Unit& u) const {
        const int L = i * G + c; if (L >= __builtin_amdgcn_readfirstlane(T.toff[NE + 1]) * 4) return false;
        u.pn = __builtin_amdgcn_readfirstlane(L & 3); moe_find(T, L >> 2, u); return true;
    }
    __device__ __forceinline__ const bf16_t* a_row(const Unit& u, int r) const { return HB + (size_t)(u.pm * 256 + r) * FF; }
    __device__ __forceinline__ const bf16_t* b_row(const Unit& u, int c_) const { return (u.e == NE ? WSH : WD + (size_t)u.e * D * FF) + (size_t)(u.pn * 256 + c_) * FF; }
    const unsigned char* ws;
    __device__ __forceinline__ unsigned a_off(const Unit& u) const { return (unsigned)((const unsigned char*)HB - ws) + (unsigned)u.pm * (unsigned)(256 * FF * 2); }
    __device__ __forceinline__ unsigned b_off(const Unit& u) const {
        const unsigned sh = (unsigned)((const unsigned char*)WSH - ws), ex = (unsigned)((const unsigned char*)WD - ws) + (unsigned)u.e * (unsigned)(D * FF * 2);
        return (u.e == NE ? sh : ex) + (unsigned)u.pn * (unsigned)(256 * FF * 2); }
};

struct EpiG1 {
    bf16_t* Z; const float* ROPE;
    typedef NoState US; struct Pre { f32x4 cs[2], sn[2]; };
    __device__ __forceinline__ US ubegin(const Unit&, int) const { return US(); }
    __device__ __forceinline__ Pre pre(const Unit& u, int r, int cbase) const {
        Pre p; const int grow = u.pm * 256 + r;
#pragma unroll
        for (int bj = 0; bj < 2; ++bj) { const int col0 = u.pn * 256 + bj * 128 + cbase;
            if ((col0 < VA) && (grow < NLAT)) { const int t = grow & (SEQ - 1); const int pos = ((col0 & 32) == 0) ? (t >> 6) : (t & 63); const int f0 = col0 & 15;
                p.cs[bj] = *(const f32x4*)(ROPE + pos * 16 + f0); p.sn[bj] = *(const f32x4*)(ROPE + 1024 + pos * 16 + f0); }
            else { p.cs[bj] = (f32x4){1.f, 1.f, 1.f, 1.f}; p.sn[bj] = (f32x4){0.f, 0.f, 0.f, 0.f}; } }
        return p;
    }
    __device__ __forceinline__ void fin(const Unit& u, int r, int cbase, const f32x4 (&v)[2][2], const Pre& p, const US&) const {
        const int grow = u.pm * 256 + r;
#pragma unroll
        for (int bj = 0; bj < 2; ++bj) {
            const int col0 = u.pn * 256 + bj * 128 + cbase;
            f32x4 a = v[bj][0], b = v[bj][1];
            if (col0 < VA) { const f32x4 a2 = a * p.cs[bj] - b * p.sn[bj], b2 = b * p.cs[bj] + a * p.sn[bj]; a = a2; b = b2; }
            if (col0 < KA || (col0 >= QN && col0 < KN)) { a = a * 0.125f; b = b * 0.125f; }
            if (col0 >= UB && col0 < QN) {
                a = (f32x4){gelu_tanh(a.x), gelu_tanh(a.y), gelu_tanh(a.z), gelu_tanh(a.w)};
                b = (f32x4){gelu_tanh(b.x), gelu_tanh(b.y), gelu_tanh(b.z), gelu_tanh(b.w)};
            }
            bf16_t* zr = Z + (size_t)grow * INW + col0;
            u32x2 w0, w1; w0.x = pk2(a.x, a.y); w0.y = pk2(a.z, a.w); w1.x = pk2(b.x, b.y); w1.y = pk2(b.z, b.w);
            *(u32x2*)zr = w0; *(u32x2*)(zr + 16) = w1;
        }
    }
};
struct EpiG2 {
    const float* xlat; const float* xctx; float* out; float* XC; const float* MOD; int l;
    struct US { f32x4 g1[2][2]; }; struct Pre { f32x4 x[2][2]; };
    __device__ __forceinline__ US ubegin(const Unit& u, int cbase) const {
        US s; const float* g1 = MOD + ((size_t)(l * 9 + mod_row(u.pm * 256)) * 6 + 2) * D + u.pn * 256 + cbase;
#pragma unroll
        for (int bj = 0; bj < 2; ++bj)
#pragma unroll
            for (int n = 0; n < 2; ++n) s.g1[bj][n] = *(const f32x4*)(g1 + bj * 128 + 16 * n);
        return s;
    }
    __device__ __forceinline__ Pre pre(const Unit& u, int r, int cbase) const {
        Pre p; const int grow = u.pm * 256 + r;
        const float* src = (grow < NLAT ? xlat + (size_t)grow * D : xctx + (size_t)(grow - NLAT) * D) + u.pn * 256 + cbase;
#pragma unroll
        for (int bj = 0; bj < 2; ++bj)
#pragma unroll
            for (int n = 0; n < 2; ++n) p.x[bj][n] = *(const f32x4*)(src + bj * 128 + 16 * n);
        return p;
    }
    __device__ __forceinline__ void fin(const Unit& u, int r, int cbase, const f32x4 (&v)[2][2], const Pre& p, const US& s) const {
        const int grow = u.pm * 256 + r;
        float* dst = (grow < NLAT ? out + (size_t)grow * D : XC + (size_t)(grow - NLAT) * D) + u.pn * 256 + cbase;
#pragma unroll
        for (int bj = 0; bj < 2; ++bj)
#pragma unroll
            for (int n = 0; n < 2; ++n) *(f32x4*)(dst + bj * 128 + 16 * n) = p.x[bj][n] + s.g1[bj][n] * v[bj][n];
    }
};
struct EpiE1 {
    bf16_t* HB;
    typedef NoState US; typedef NoState Pre;
    __device__ __forceinline__ US ubegin(const Unit&, int) const { return US(); }
    __device__ __forceinline__ Pre pre(const Unit&, int, int) const { return Pre(); }
    __device__ __forceinline__ void fin(const Unit& u, int r, int cbase, const f32x4 (&v)[2][2], const Pre&, const US&) const {
        bf16_t* hr = HB + (size_t)(u.pm * 256 + r) * FF + u.pn * 128 + cbase;
#pragma unroll
        for (int n = 0; n < 2; ++n) { const f32x4 g = v[0][n], up = v[1][n];
            u32x2 w; w.x = pk2(silu_f(g.x) * up.x, silu_f(g.y) * up.y); w.y = pk2(silu_f(g.z) * up.z, silu_f(g.w) * up.w);
            *(u32x2*)(hr + 16 * n) = w; }
    }
};
struct EpiE2 {
    MoeTab T; const unsigned* LIST; const float* LISTW; bf16_t* Y2; float* out; float* XC; const float* MOD; int l;
    struct US { f32x4 g2[2][2]; }; struct Pre { f32x4 x[2][2]; unsigned ent; float w; };
    __device__ __forceinline__ US ubegin(const Unit& u, int cbase) const {
        US s;
        if (u.e == NE) { const float* g2 = MOD + ((size_t)(l * 9 + mod_row(u.lt * 256)) * 6 + 5) * D + u.pn * 256 + cbase;
#pragma unroll
            for (int bj = 0; bj < 2; ++bj)
#pragma unroll
                for (int n = 0; n < 2; ++n) s.g2[bj][n] = *(const f32x4*)(g2 + bj * 128 + 16 * n); }
        return s;
    }
    __device__ __forceinline__ Pre pre(const Unit& u, int r, int cbase) const {
        Pre p; const int idx = u.lt * 256 + r; p.ent = 0u; p.w = 0.f;
        if (u.e == NE) { const float* dst = (idx < NLAT ? out + (size_t)idx * D : XC + (size_t)(idx - NLAT) * D) + u.pn * 256 + cbase;
#pragma unroll
            for (int bj = 0; bj < 2; ++bj)
#pragma unroll
                for (int n = 0; n < 2; ++n) p.x[bj][n] = *(const f32x4*)(dst + bj * 128 + 16 * n); }
        else if (idx < T.cnt[u.e]) { p.ent = LIST[(size_t)u.e * LIST_CAP + idx]; p.w = LISTW[(size_t)u.e * LIST_CAP + idx]; }
        return p;
    }
    __device__ __forceinline__ void fin(const Unit& u, int r, int cbase, const f32x4 (&v)[2][2], const Pre& p, const US& s) const {
        const int idx = u.lt * 256 + r;
        if (u.e == NE) {
            float* dst = (idx < NLAT ? out + (size_t)idx * D : XC + (size_t)(idx - NLAT) * D) + u.pn * 256 + cbase;
#pragma unroll
            for (int bj = 0; bj < 2; ++bj)
#pragma unroll
                for (int n = 0; n < 2; ++n) *(f32x4*)(dst + bj * 128 + 16 * n) = p.x[bj][n] + s.g2[bj][n] * v[bj][n];
        } else if (idx < T.cnt[u.e]) {
            bf16_t* yr = Y2 + ((size_t)(p.ent & 0xffffu) * 8 + (p.ent >> 16)) * D + u.pn * 256 + cbase;
#pragma unroll
            for (int bj = 0; bj < 2; ++bj)
#pragma unroll
                for (int n = 0; n < 2; ++n) { const f32x4 x = v[bj][n] * p.w; u32x2 o; o.x = pk2(x.x, x.y); o.y = pk2(x.z, x.w); *(u32x2*)(yr + bj * 128 + 16 * n) = o; }
        }
    }
};

template <class Sched, class Epi>
__device__ __forceinline__ void gemm_simple(Frame& F, const Sched& S, const Epi& E, int K) {
    float* As = (float*)F.lds;
    float* Bs = (float*)(F.lds + 32 * 132 * 4);
    const int tid = F.tid, cg = tid & 15, rg = tid >> 4, wc = cg >> 2, fq = cg & 3, cbase = 32 * wc + 4 * fq;
    Unit u;
    for (int i = 0; S.next(i, u); ++i) {
        const bf16_t* bp = S.b_row(u, tid >> 1) + 16 * (tid & 1);
        for (int ai = 0; ai < 2; ++ai) {
            const bf16_t* ap = S.a_row(u, ai * 128 + (tid >> 2)) + 8 * (tid & 3);
            f32x4 acc[4][2][2];
#pragma unroll
            for (int a = 0; a < 4; ++a)
#pragma unroll
                for (int b = 0; b < 2; ++b)
#pragma unroll
                    for (int n = 0; n < 2; ++n) acc[a][b][n] = (f32x4){0.f, 0.f, 0.f, 0.f};
            for (int k0 = 0; k0 < K; k0 += 32) {
                const u32x4 wa = *(const u32x4*)(ap + k0);
                const u32x4 wb0 = *(const u32x4*)(bp + k0), wb1 = *(const u32x4*)(bp + k0 + 8);
                __syncthreads();
                { const int row = tid >> 2, kc = 8 * (tid & 3);
                  As[(kc + 0) * 132 + row] = bf_lo(wa.x); As[(kc + 1) * 132 + row] = bf_hi(wa.x); As[(kc + 2) * 132 + row] = bf_lo(wa.y); As[(kc + 3) * 132 + row] = bf_hi(wa.y);
                  As[(kc + 4) * 132 + row] = bf_lo(wa.z); As[(kc + 5) * 132 + row] = bf_hi(wa.z); As[(kc + 6) * 132 + row] = bf_lo(wa.w); As[(kc + 7) * 132 + row] = bf_hi(wa.w); }
                { const int col = tid >> 1, kc = 16 * (tid & 1);
                  Bs[(kc + 0) * 260 + col] = bf_lo(wb0.x); Bs[(kc + 1) * 260 + col] = bf_hi(wb0.x); Bs[(kc + 2) * 260 + col] = bf_lo(wb0.y); Bs[(kc + 3) * 260 + col] = bf_hi(wb0.y);
                  Bs[(kc + 4) * 260 + col] = bf_lo(wb0.z); Bs[(kc + 5) * 260 + col] = bf_hi(wb0.z); Bs[(kc + 6) * 260 + col] = bf_lo(wb0.w); Bs[(kc + 7) * 260 + col] = bf_hi(wb0.w);
                  Bs[(kc + 8) * 260 + col] = bf_lo(wb1.x); Bs[(kc + 9) * 260 + col] = bf_hi(wb1.x); Bs[(kc + 10) * 260 + col] = bf_lo(wb1.y); Bs[(kc + 11) * 260 + col] = bf_hi(wb1.y);
                  Bs[(kc + 12) * 260 + col] = bf_lo(wb1.z); Bs[(kc + 13) * 260 + col] = bf_hi(wb1.z); Bs[(kc + 14) * 260 + col] = bf_lo(wb1.w); Bs[(kc + 15) * 260 + col] = bf_hi(wb1.w); }
                __syncthreads();
#pragma unroll 4
                for (int kk = 0; kk < 32; ++kk) {
                    const f32x4 a = *(const f32x4*)(As + kk * 132 + 4 * rg);
                    f32x4 b[2][2];
#pragma unroll
                    for (int bj = 0; bj < 2; ++bj)
#pragma unroll
                        for (int n = 0; n < 2; ++n) b[bj][n] = *(const f32x4*)(Bs + kk * 260 + 128 * bj + cbase + 16 * n);
#pragma unroll
                    for (int bj = 0; bj < 2; ++bj)
#pragma unroll
                        for (int n = 0; n < 2; ++n) { acc[0][bj][n] += a.x * b[bj][n]; acc[1][bj][n] += a.y * b[bj][n]; acc[2][bj][n] += a.z * b[bj][n]; acc[3][bj][n] += a.w * b[bj][n]; }
                }
            }
            { const typename Epi::US us = E.ubegin(u, cbase);
#pragma unroll
              for (int a = 0; a < 4; ++a) { const typename Epi::Pre p = E.pre(u, ai * 128 + 4 * rg + a, cbase); E.fin(u, ai * 128 + 4 * rg + a, cbase, acc[a], p, us); } }
        }
    }
    __syncthreads();
}


namespace pg8 {
typedef short bf16x8 __attribute__((ext_vector_type(8)));
constexpr int BM = 256, BK = 64, HALF = 128, HTB = HALF * BK * 2, STAGE_BYTES = 8 * HTB;
__device__ __forceinline__ int lds_byte(int r, int c) { const int st = (r >> 4) * 2 + (c >> 5), rr = r & 15, cc = c & 31, ob = rr * 64 + cc * 2; return st * 1024 + (ob ^ (((ob >> 9) & 1) << 5)); }
__device__ __forceinline__ void stage_rc(int b, int& R, int& C) { const int st = b / 1024, sb = b % 1024, swz = sb ^ (((sb >> 9) & 1) << 5); R = (st >> 1) * 16 + swz / 64; C = (st & 1) * 32 + (swz % 64) / 2; }

template <class Sched, class REpi, bool GATHER, bool ALIGN_EPI, bool SP2>
__device__ __forceinline__ void gemm_phase(LAS unsigned char* lds, const unsigned char* wsbase, const Sched& S, const REpi& RE, const int K, const int tid, const int wid) {
    const int lane = tid & 63, wr = wid >> 2, wc = wid & 3, fr = lane & 15, fq = lane >> 4;
    const int nt = K / BK;
    const __amdgpu_buffer_rsrc_t rsrc = __builtin_amdgcn_make_buffer_rsrc((void*)wsbase, 0, 0x7fffffff, 0x00020000);
    int R0, C0; stage_rc(tid * 16, R0, C0);
    const unsigned vo0 = (unsigned)(R0 * K + C0) * 2u, vo1 = (unsigned)((R0 + 64) * K + C0) * 2u;
    const unsigned kstep = (unsigned)(BK * 2), hstep = (unsigned)(HALF * K * 2);
    const unsigned ldsw = (unsigned)wid * 1024u;
    const int aoff = lds_byte(wr * 64 + fr, fq * 8), boff = lds_byte(wc * 32 + fr, fq * 8);
#define PG8_SA(b, h) (((b) * 2 + (h)) * HTB)
#define PG8_SB(b, h) ((4 + (b) * 2 + (h)) * HTB)
#define PG8_STAGE2(bufoff, soff, o0, o1) do { \
        const int _so = __builtin_amdgcn_readfirstlane((int)(soff)); \
        __builtin_amdgcn_raw_ptr_buffer_load_lds(rsrc, (LAS void*)(lds + (bufoff) + ldsw), 16, (int)(o0), _so, 0, 0); \
        __builtin_amdgcn_raw_ptr_buffer_load_lds(rsrc, (LAS void*)(lds + (bufoff) + ldsw + 8192), 16, (int)(o1), _so, 0, 0); } while (0)
#define PG8_STAGEB(bufoff, soff) PG8_STAGE2(bufoff, soff, vo0, vo1)
#define PG8_STAGEA(bufoff, soff, h, G) do { if constexpr (GATHER) PG8_STAGE2(bufoff, soff, (G)[h][0], (G)[h][1]); else PG8_STAGE2(bufoff, (soff) + (h) * hstep, vo0, vo1); } while (0)
#define PG8_LDA(dst, b, h) do { _Pragma("unroll") for (int m = 0; m < 4; ++m) _Pragma("unroll") for (int k = 0; k < 2; ++k) dst[m][k] = *(const LAS bf16x8*)(lds + PG8_SA(b, h) + aoff + m * 2048 + k * 1024); } while (0)
#define PG8_LDB(dst, b, h) do { _Pragma("unroll") for (int n = 0; n < 2; ++n) _Pragma("unroll") for (int k = 0; k < 2; ++k) dst[n][k] = *(const LAS bf16x8*)(lds + PG8_SB(b, h) + boff + n * 2048 + k * 1024); } while (0)
#define PG8_MMA(ai, bj, At, Bt) do { __builtin_amdgcn_s_setprio(1); _Pragma("unroll") for (int m = 0; m < 4; ++m) _Pragma("unroll") for (int n = 0; n < 2; ++n) _Pragma("unroll") for (int k = 0; k < 2; ++k) \
        acc[ai][bj][m][n] = __builtin_amdgcn_mfma_f32_16x16x32_bf16(Bt[n][k], At[m][k], acc[ai][bj][m][n], 0, 0, 0); __builtin_amdgcn_s_setprio(0); } while (0)
#define PG8_WAIT_V(n) asm volatile("s_waitcnt vmcnt(" #n ")" ::: "memory")
#define PG8_WAIT_L(n) asm volatile("s_waitcnt lgkmcnt(" #n ")" ::: "memory")
#define PG8_BAR __builtin_amdgcn_s_barrier()
#define PG8_SCHED __builtin_amdgcn_sched_barrier(0)
    Unit cur, nxt; int ui = 0;
    if (!S.next(0, cur)) return;
    f32x4 acc[2][2][4][2];
#pragma unroll
    for (int a = 0; a < 2; ++a)
#pragma unroll
        for (int b = 0; b < 2; ++b)
#pragma unroll
            for (int m = 0; m < 4; ++m)
#pragma unroll
                for (int n = 0; n < 2; ++n) acc[a][b][m][n] = (f32x4){0.f, 0.f, 0.f, 0.f};
    bf16x8 At[4][2], B0[2][2], B1[2][2];
    unsigned gc[2][2], gn[2][2];
    unsigned cA, cB = S.b_off(cur);
    if constexpr (GATHER) { cA = S.a_org();
#pragma unroll
        for (int h = 0; h < 2; ++h)
#pragma unroll
            for (int i = 0; i < 2; ++i) gc[h][i] = S.a_rowoff(cur, h * HALF + R0 + 64 * i) + (unsigned)C0 * 2u;
        asm volatile("s_waitcnt vmcnt(0) lgkmcnt(0)" : "+v"(gc[0][0]), "+v"(gc[0][1]), "+v"(gc[1][0]), "+v"(gc[1][1]) :: "memory");
    } else { cA = S.a_off(cur); gc[0][0] = gc[0][1] = gc[1][0] = gc[1][1] = 0u; }
    if constexpr (SP2) {
        PG8_STAGEB(PG8_SB(0, 0), cB); PG8_STAGEB(PG8_SB(0, 1), cB + hstep); PG8_STAGEA(PG8_SA(0, 0), cA, 0, gc); PG8_STAGEA(PG8_SA(0, 1), cA, 1, gc);
        if (wr == 1) PG8_BAR;
        PG8_WAIT_V(2); PG8_BAR;
        PG8_STAGEB(PG8_SB(1, 0), cB + kstep); PG8_STAGEA(PG8_SA(1, 0), cA + kstep, 0, gc); PG8_STAGEB(PG8_SB(1, 1), cB + hstep + kstep);
        PG8_WAIT_V(6); PG8_BAR;
    } else {
        PG8_STAGEB(PG8_SB(0, 0), cB); PG8_STAGEA(PG8_SA(0, 0), cA, 0, gc); PG8_STAGEB(PG8_SB(0, 1), cB + hstep); PG8_STAGEA(PG8_SA(0, 1), cA, 1, gc);
        if (wr == 1) PG8_BAR;
        PG8_WAIT_V(4); PG8_BAR;
        PG8_STAGEB(PG8_SB(1, 0), cB + kstep); PG8_STAGEA(PG8_SA(1, 0), cA + kstep, 0, gc); PG8_STAGEB(PG8_SB(1, 1), cB + hstep + kstep);
        PG8_WAIT_V(6); PG8_BAR;
    }
    for (;;) {
        const bool has_next = S.next(ui + 1, nxt);
        unsigned nA; const unsigned nB = has_next ? S.b_off(nxt) : cB;
        if constexpr (GATHER) { nA = cA;
#pragma unroll
            for (int h = 0; h < 2; ++h)
#pragma unroll
                for (int i = 0; i < 2; ++i) gn[h][i] = has_next ? S.a_rowoff(nxt, h * HALF + R0 + 64 * i) + (unsigned)C0 * 2u : gc[h][i];
            asm volatile("s_waitcnt vmcnt(0) lgkmcnt(0)" : "+v"(gn[0][0]), "+v"(gn[0][1]), "+v"(gn[1][0]), "+v"(gn[1][1]) :: "memory");
        } else { nA = has_next ? S.a_off(nxt) : cA; }
#pragma unroll 1
        for (int t = 0; t < nt; t += 2) {
            const bool last = (t == nt - 2);
            const unsigned a1 = cA + (unsigned)(t + 1) * kstep;
            unsigned a2; const unsigned b2 = last ? nB : cB + (unsigned)(t + 2) * kstep;
            unsigned g2[2][2];
            if constexpr (GATHER) { a2 = last ? cA : cA + (unsigned)(t + 2) * kstep;
#pragma unroll
                for (int h = 0; h < 2; ++h)
#pragma unroll
                    for (int i = 0; i < 2; ++i) g2[h][i] = last ? gn[h][i] : gc[h][i];
            } else { a2 = last ? nA : cA + (unsigned)(t + 2) * kstep; g2[0][0] = g2[0][1] = g2[1][0] = g2[1][1] = 0u; }
            const unsigned a3 = a2 + kstep, b3 = b2 + kstep;
            if constexpr (SP2) {
            PG8_LDB(B0, 0, 0); PG8_LDB(B1, 0, 1); PG8_SCHED; PG8_LDA(At, 0, 0); PG8_STAGEA(PG8_SA(1, 1), a1, 1, gc);
            PG8_WAIT_V(8); PG8_WAIT_L(0); PG8_BAR; PG8_MMA(0, 0, At, B0); PG8_MMA(0, 1, At, B1); PG8_BAR; PG8_SCHED;
            PG8_LDA(At, 0, 1); PG8_STAGEB(PG8_SB(0, 0), b2); PG8_STAGEB(PG8_SB(0, 1), b2 + hstep); PG8_STAGEA(PG8_SA(0, 0), a2, 0, g2);
            PG8_WAIT_V(8); PG8_WAIT_L(0); PG8_BAR; PG8_MMA(1, 0, At, B0); PG8_MMA(1, 1, At, B1); PG8_BAR; PG8_SCHED;
            PG8_LDB(B0, 1, 0); PG8_LDB(B1, 1, 1); PG8_SCHED; PG8_LDA(At, 1, 0); PG8_STAGEA(PG8_SA(0, 1), a2, 1, g2);
            PG8_WAIT_V(8); PG8_WAIT_L(0); PG8_BAR; PG8_MMA(0, 0, At, B0); PG8_MMA(0, 1, At, B1); PG8_BAR; PG8_SCHED;
            PG8_LDA(At, 1, 1); PG8_STAGEB(PG8_SB(1, 0), b3); PG8_STAGEB(PG8_SB(1, 1), b3 + hstep); PG8_STAGEA(PG8_SA(1, 0), a3, 0, g2);
            PG8_WAIT_V(8); PG8_WAIT_L(0); PG8_BAR; PG8_MMA(1, 0, At, B0); PG8_MMA(1, 1, At, B1); PG8_BAR; PG8_SCHED;
            } else {
            PG8_LDB(B0, 0, 0); PG8_SCHED; PG8_LDA(At, 0, 0); PG8_STAGEA(PG8_SA(1, 1), a1, 1, gc);
            PG8_WAIT_L(8); PG8_BAR; PG8_WAIT_L(0); PG8_MMA(0, 0, At, B0); PG8_BAR; PG8_SCHED;
            PG8_LDB(B1, 0, 1); PG8_STAGEB(PG8_SB(0, 0), b2);
            PG8_BAR; PG8_WAIT_L(0); PG8_MMA(0, 1, At, B1); PG8_BAR;
            PG8_LDA(At, 0, 1); PG8_STAGEA(PG8_SA(0, 0), a2, 0, g2);
            PG8_BAR; PG8_WAIT_L(0); PG8_MMA(1, 0, At, B0); PG8_BAR; PG8_SCHED;
            PG8_STAGEB(PG8_SB(0, 1), b2 + hstep);
            PG8_WAIT_V(6); PG8_BAR; PG8_MMA(1, 1, At, B1); PG8_BAR;
            PG8_LDB(B0, 1, 0); PG8_SCHED; PG8_LDA(At, 1, 0); PG8_STAGEA(PG8_SA(0, 1), a2, 1, g2);
            PG8_WAIT_L(8); PG8_BAR; PG8_WAIT_L(0); PG8_MMA(0, 0, At, B0); PG8_BAR; PG8_SCHED;
            PG8_LDB(B1, 1, 1); PG8_STAGEB(PG8_SB(1, 0), b3);
            PG8_BAR; PG8_WAIT_L(0); PG8_MMA(0, 1, At, B1); PG8_BAR;
            PG8_LDA(At, 1, 1); PG8_STAGEA(PG8_SA(1, 0), a3, 0, g2);
            PG8_BAR; PG8_WAIT_L(0); PG8_MMA(1, 0, At, B0); PG8_BAR; PG8_SCHED;
            PG8_STAGEB(PG8_SB(1, 1), b3 + hstep);
            PG8_WAIT_V(6); PG8_BAR; PG8_MMA(1, 1, At, B1); PG8_BAR;
            }
        }
        if constexpr (ALIGN_EPI) { if (wr == 0) PG8_BAR; }
        {
            const int cb = wc * 32 + 4 * fq, rb = wr * 64 + fr;
            const typename REpi::US us = RE.ubegin(cur, cb);
            typename REpi::Pre p0 = RE.pre(cur, rb, cb), p1;
#pragma unroll
            for (int x = 0; x < 8; ++x) { const int ai = x >> 2, m = x & 3;
                asm volatile("" ::: "memory");
                if (x < 7) { const int x1 = x + 1; p1 = RE.pre(cur, (x1 >> 2) * HALF + rb + (x1 & 3) * 16, cb); }
                const f32x4 v[2][2] = {{acc[ai][0][m][0], acc[ai][0][m][1]}, {acc[ai][1][m][0], acc[ai][1][m][1]}};
                RE.fin(cur, ai * HALF + rb + m * 16, cb, v, p0, us);
                p0 = p1; }
        }
        if (!has_next) break;
#pragma unroll
        for (int a = 0; a < 2; ++a)
#pragma unroll
            for (int b = 0; b < 2; ++b)
#pragma unroll
                for (int m = 0; m < 4; ++m)
#pragma unroll
                    for (int n = 0; n < 2; ++n) acc[a][b][m][n] = (f32x4){0.f, 0.f, 0.f, 0.f};
        cur = nxt; cA = nA; cB = nB; ++ui;
        if constexpr (GATHER) {
#pragma unroll
            for (int h = 0; h < 2; ++h)
#pragma unroll
                for (int i = 0; i < 2; ++i) gc[h][i] = gn[h][i];
        }
        if constexpr (ALIGN_EPI) { if (wr == 1) PG8_BAR; }
    }
    PG8_WAIT_V(0);
    if constexpr (!ALIGN_EPI) { if (wr == 0) PG8_BAR; }
    PG8_BAR;
#undef PG8_SA
#undef PG8_SB
#undef PG8_STAGE2
#undef PG8_STAGEB
#undef PG8_STAGEA
#undef PG8_LDA
#undef PG8_LDB
#undef PG8_MMA
#undef PG8_WAIT_V
#undef PG8_WAIT_L
#undef PG8_BAR
#undef PG8_SCHED
}
}
#ifndef MK_SP2
#define MK_SP2 true
#endif
#ifndef MK_ALIGN
#define MK_ALIGN true
#endif
#ifndef MK_MFMA
#define MK_MFMA 0xF
#endif
template <bool GATHER, class Sched, class Epi>
__device__ __forceinline__ void run_gemm(Frame& F, bool mfma, const Sched& S, const Epi& E, int K) {
    if (mfma) pg8::gemm_phase<Sched, Epi, GATHER, MK_ALIGN, MK_SP2>((LAS unsigned char*)F.lds, F.wsb(), S, E, K, F.tid, F.wave);
    else gemm_simple(F, S, E, K);
}

__device__ __forceinline__ void load_q64(const bf16_t* p, float (&q)[64]) {
#pragma unroll
    for (int c = 0; c < 8; ++c) { const u32x4 w = *(const u32x4*)(p + 8 * c);
        q[8 * c + 0] = bf_lo(w.x); q[8 * c + 1] = bf_hi(w.x); q[8 * c + 2] = bf_lo(w.y); q[8 * c + 3] = bf_hi(w.y);
        q[8 * c + 4] = bf_lo(w.z); q[8 * c + 5] = bf_hi(w.z); q[8 * c + 6] = bf_lo(w.w); q[8 * c + 7] = bf_hi(w.w); }
}
__device__ __forceinline__ void attn_key(const float (&q)[64], const bf16_t* kp, const bf16_t* vp, float bias, float& m, float& l, float (&o)[64]) {
    float s0 = bias, s1 = 0.f;
#pragma unroll
    for (int c = 0; c < 8; ++c) { const u32x4 w = *(const u32x4*)(kp + 8 * c);
        s0 += q[8 * c + 0] * bf_lo(w.x) + q[8 * c + 2] * bf_lo(w.y) + q[8 * c + 4] * bf_lo(w.z) + q[8 * c + 6] * bf_lo(w.w);
        s1 += q[8 * c + 1] * bf_hi(w.x) + q[8 * c + 3] * bf_hi(w.y) + q[8 * c + 5] * bf_hi(w.z) + q[8 * c + 7] * bf_hi(w.w); }
    const float s = s0 + s1;
    const float mn = fmaxf(m, s), sc = __expf(m - mn), p = __expf(s - mn);
    l = l * sc + p; m = mn;
#pragma unroll
    for (int c = 0; c < 8; ++c) { const u32x4 w = *(const u32x4*)(vp + 8 * c);
        o[8 * c + 0] = o[8 * c + 0] * sc + p * bf_lo(w.x); o[8 * c + 1] = o[8 * c + 1] * sc + p * bf_hi(w.x);
        o[8 * c + 2] = o[8 * c + 2] * sc + p * bf_lo(w.y); o[8 * c + 3] = o[8 * c + 3] * sc + p * bf_hi(w.y);
        o[8 * c + 4] = o[8 * c + 4] * sc + p * bf_lo(w.z); o[8 * c + 5] = o[8 * c + 5] * sc + p * bf_hi(w.z);
        o[8 * c + 6] = o[8 * c + 6] * sc + p * bf_lo(w.w); o[8 * c + 7] = o[8 * c + 7] * sc + p * bf_hi(w.w); }
}
__device__ __forceinline__ void attn_finish(Frame& F, int r, int ycol, int slot, float l, float (&o)[64]) {
    const float inv = 1.0f / l; float ss = 0.f;
    bf16_t* yp = F.Y() + (size_t)r * D + ycol;
#pragma unroll
    for (int c = 0; c < 8; ++c) { float t[8];
#pragma unroll
        for (int j = 0; j < 8; ++j) { t[j] = o[8 * c + j] * inv; ss += t[j] * t[j]; }
        u32x4 w; w.x = pk2(t[0], t[1]); w.y = pk2(t[2], t[3]); w.z = pk2(t[4], t[5]); w.w = pk2(t[6], t[7]);
        *(u32x4*)(yp + 8 * c) = w; }
    F.SSQ()[(size_t)r * 16 + slot] = ss;
}
__device__ __forceinline__ void attn_item(Frame& F, int l, int variant, int qb, int h) {
    const bool latent = variant < 2; const bool isA = (variant == 0 || variant == 2);
    const int r = (latent ? 0 : NLAT) + qb * NTHR + F.tid;
    const int b = latent ? (r >> 11) : ((r - NLAT) >> 8);
    const int qcol = isA ? QA + 64 * h : QN + 64 * h;
    const int kcol = isA ? KA + 64 * (h / 3) : KN + 64 * h, vcol = isA ? VA + 64 * (h / 3) : VN + 64 * h;
    float q[64], o[64];
    load_q64(F.Z() + (size_t)r * INW + qcol, q);
#pragma unroll
    for (int i = 0; i < 64; ++i) o[i] = 0.f;
    float m, ls;
    if (isA) { m = F.inp(IN_SINK)[l * 6 + h]; ls = 1.0f; } else { m = NEGF; ls = 0.f; }
    const bf16_t* zc = F.Z() + (size_t)(NLAT + b * CTXL) * INW;
#pragma unroll 1
    for (int c = 0; c < CTXL; ++c) attn_key(q, zc + (size_t)c * INW + kcol, zc + (size_t)c * INW + vcol, 0.f, m, ls, o);
    if (variant == 0) {
        const int t = r & (SEQ - 1); const int lo = max(0, t - 128), hi = min(SEQ - 1, t + 128);
        const bf16_t* zb = F.Z() + (size_t)(b * SEQ) * INW;
#pragma unroll 1
        for (int kp = lo; kp <= hi; ++kp) attn_key(q, zb + (size_t)kp * INW + kcol, zb + (size_t)kp * INW + vcol, 0.f, m, ls, o);
    } else if (variant == 1) {
        const int t = r & (SEQ - 1), row = t >> 6, col = t & 63;
        const int rs = min(max(row - 4, 0), 24), cs = min(max(col - 8, 0), 48);
        const bf16_t* zb = F.Z() + (size_t)(b * SEQ) * INW;
        const float* rpb = F.inp(IN_RPB) + (size_t)(l * 6 + h) * 15 * 31;
#pragma unroll 1
        for (int j = 0; j < 8; ++j)
#pragma unroll 1
            for (int cc = 0; cc < 16; ++cc) { const int kr = rs + j, kc = cs + cc; const size_t ko = (size_t)(kr * 64 + kc) * INW;
                const float bias = rpb[(kr - row + 7) * 31 + (kc - col + 15)];
                attn_key(q, zb + ko + kcol, zb + ko + vcol, bias, m, ls, o); }
    }
    attn_finish(F, r, (isA ? 0 : 640) + 64 * h, (isA ? 0 : 10) + h, ls, o);
}

typedef short bf16x8 __attribute__((ext_vector_type(8)));
typedef short s16x4 __attribute__((ext_vector_type(4)));
struct QS { bf16x8 q0, q1; float m, l; f32x4 o[4]; };
__device__ __forceinline__ void qs_init(QS& T, const bf16_t* qp, int g, float m0, float l0) {
    T.q0 = *(const bf16x8*)(qp + 8 * g); T.q1 = *(const bf16x8*)(qp + 32 + 8 * g); T.m = m0; T.l = l0;
#pragma unroll
    for (int d = 0; d < 4; ++d) T.o[d] = (f32x4){0.f, 0.f, 0.f, 0.f};
}
__device__ __forceinline__ s16x4 lds_tr(LAS unsigned char* p) { return __builtin_bit_cast(s16x4, __builtin_amdgcn_ds_read_tr16_b64_v4i16((LAS s16x4*)p)); }
__device__ __forceinline__ void stage_kv(const unsigned char* wsbase, unsigned zoff, int zrow0, int nkeys, int kcol, int vcol, LAS unsigned char* Kl, LAS unsigned char* Vl, int tid, int wave) {
    const __amdgpu_buffer_rsrc_t rsrc = __builtin_amdgcn_make_buffer_rsrc((void*)wsbase, 0, 0x7fffffff, 0x00020000);
    const int lane = tid & 63, kr = lane >> 3, p = lane & 7;
    const int ck = p ^ kr, cv = (((p >> 1) ^ ((kr >> 1) & 3)) << 1) | (p & 1);
    const unsigned vk = (unsigned)kr * (unsigned)(INW * 2) + (unsigned)(kcol + 8 * ck) * 2u, vv = (unsigned)kr * (unsigned)(INW * 2) + (unsigned)(vcol + 8 * cv) * 2u;
    const int nwi = nkeys >> 3;
#pragma unroll 1
    for (int wi = wave; wi < nwi; wi += NWAVES) {
        const int so = __builtin_amdgcn_readfirstlane((int)(zoff + (unsigned)(zrow0 + 8 * wi) * (unsigned)(INW * 2)));
        __builtin_amdgcn_raw_ptr_buffer_load_lds(rsrc, (LAS void*)(Kl + wi * 1024), 16, (int)vk, so, 0, 0);
        __builtin_amdgcn_raw_ptr_buffer_load_lds(rsrc, (LAS void*)(Vl + wi * 1024), 16, (int)vv, so, 0, 0);
    }
    asm volatile("s_waitcnt vmcnt(0)" ::: "memory");
}
template <class MF>
__device__ __forceinline__ void attn_tile64(QS& T, LAS unsigned char* Kt, LAS unsigned char* Vt, int i, int g, const MF& mf, int kt_lo, int kt_hi) {
    f32x4 s[4];
#pragma unroll
    for (int kt = 0; kt < 4; ++kt) {
        if (kt >= kt_lo && kt <= kt_hi) {
            LAS unsigned char* kr = Kt + (kt * 16 + i) * 128;
            const bf16x8 k0 = *(const LAS bf16x8*)(kr + ((g ^ (i & 7)) << 4)), k1 = *(const LAS bf16x8*)(kr + (((4 + g) ^ (i & 7)) << 4));
            f32x4 a = (f32x4){0.f, 0.f, 0.f, 0.f};
            a = __builtin_amdgcn_mfma_f32_16x16x32_bf16(k0, T.q0, a, 0, 0, 0);
            a = __builtin_amdgcn_mfma_f32_16x16x32_bf16(k1, T.q1, a, 0, 0, 0);
            s[kt] = (f32x4){mf(kt, 0, a.x), mf(kt, 1, a.y), mf(kt, 2, a.z), mf(kt, 3, a.w)};
        } else s[kt] = (f32x4){NEGF, NEGF, NEGF, NEGF};
    }
    float mx = fmaxf(fmaxf(fmaxf(s[0].x, s[0].y), fmaxf(s[0].z, s[0].w)), fmaxf(fmaxf(s[1].x, s[1].y), fmaxf(s[1].z, s[1].w)));
    mx = fmaxf(mx, fmaxf(fmaxf(fmaxf(s[2].x, s[2].y), fmaxf(s[2].z, s[2].w)), fmaxf(fmaxf(s[3].x, s[3].y), fmaxf(s[3].z, s[3].w))));
    mx = fmaxf(mx, __shfl_xor(mx, 16)); mx = fmaxf(mx, __shfl_xor(mx, 32));
    const float mn = fmaxf(T.m, mx), sc = __expf(T.m - mn);
    T.m = mn;
    float ps = 0.f;
#pragma unroll
    for (int kt = 0; kt < 4; ++kt) { s[kt].x = __expf(s[kt].x - mn); s[kt].y = __expf(s[kt].y - mn); s[kt].z = __expf(s[kt].z - mn); s[kt].w = __expf(s[kt].w - mn);
        ps += (s[kt].x + s[kt].y) + (s[kt].z + s[kt].w); }
    T.l = T.l * sc + ps;
#pragma unroll
    for (int d = 0; d < 4; ++d) T.o[d] = T.o[d] * sc;
#pragma unroll
    for (int c = 0; c < 2; ++c) {
        if (2 * c + 1 >= kt_lo && 2 * c <= kt_hi) {
            u32x4 pw; pw.x = pk2(s[2 * c].x, s[2 * c].y); pw.y = pk2(s[2 * c].z, s[2 * c].w); pw.z = pk2(s[2 * c + 1].x, s[2 * c + 1].y); pw.w = pk2(s[2 * c + 1].z, s[2 * c + 1].w);
            const bf16x8 pf = __builtin_bit_cast(bf16x8, pw);
            const int key = 32 * c + 4 * g + (i >> 2);
            LAS unsigned char* vr = Vt + key * 128 + (i & 3) * 8;
            const int sw = (key >> 1) & 3;
#pragma unroll
            for (int dt = 0; dt < 4; ++dt) {
                LAS unsigned char* va = vr + ((dt ^ sw) << 5);
                const s16x4 lo = lds_tr(va), hi = lds_tr(va + 2048);
                const bf16x8 vf = {lo[0], lo[1], lo[2], lo[3], hi[0], hi[1], hi[2], hi[3]};
                T.o[dt] = __builtin_amdgcn_mfma_f32_16x16x32_bf16(vf, pf, T.o[dt], 0, 0, 0);
            }
        }
    }
}
__device__ __forceinline__ void qs_finish(const QS& T, float lsum, bf16_t* Y, float* SSQ, int yrow, int ycol, int slot, int g) {
    const float inv = 1.0f / lsum; float ss = 0.f;
    bf16_t* yp = Y + (size_t)yrow * D + ycol + 4 * g;
#pragma unroll
    for (int dt = 0; dt < 4; ++dt) { const f32x4 v = T.o[dt] * inv; ss += (v.x * v.x + v.y * v.y) + (v.z * v.z + v.w * v.w);
        u32x2 w; w.x = pk2(v.x, v.y); w.y = pk2(v.z, v.w); *(u32x2*)(yp + 16 * dt) = w; }
    ss += __shfl_xor(ss, 16); ss += __shfl_xor(ss, 32);
    if (g == 0) SSQ[(size_t)yrow * 16 + slot] = ss;
}
struct MaskNone { __device__ __forceinline__ float operator()(int, int, float s) const { return s; } };
struct MaskBand { int kb4g, qp;
    __device__ __forceinline__ float operator()(int kt, int r, float s) const { const int d = kb4g + 16 * kt + r - qp; return (d >= -128 && d <= 128) ? s : NEGF; } };
struct MaskNA { const LAS float* rp; int g4, cq, cs;
    __device__ __forceinline__ float operator()(int kt, int r, float s) const { const int kc = 16 * kt + g4 + r; return (kc >= cs && kc < cs + 16) ? s + rp[kc - cq + 15] : NEGF; } };

__device__ __forceinline__ void attnA_item(Frame& F, int l, int b, int n, int half, int kvh) {
    LAS unsigned char* L = (LAS unsigned char*)F.lds;
    const int lane = F.tid & 63, i = lane & 15, g = lane >> 4, w = F.wave;
    const bool latent = n >= 0;
    const int qrow0 = latent ? b * SEQ + n * 128 : NLAT + b * CTXL + half * 128;
    const bf16_t* Z = F.Z();
    QS T[3];
#pragma unroll
    for (int j = 0; j < 3; ++j) { const int tq = 3 * w + j, hq = 3 * kvh + (tq >> 3);
        qs_init(T[j], Z + (size_t)(qrow0 + (tq & 7) * 16 + i) * INW + QA + 64 * hq, g, F.inp(IN_SINK)[l * 6 + hq], g == 0 ? 1.0f : 0.f); }
    __syncthreads();
    stage_kv(F.wsb(), (unsigned)WS_ZH, NLAT + b * CTXL, CTXL, KA + 64 * kvh, VA + 64 * kvh, L, L + 32768, F.tid, w);
    __syncthreads();
#pragma unroll
    for (int j = 0; j < 3; ++j)
#pragma unroll 1
        for (int t = 0; t < 4; ++t) attn_tile64(T[j], L + t * 8192, L + 32768 + t * 8192, i, g, MaskNone(), 0, 3);
    if (latent) {
        const int j_lo = (n == 0) ? 2 : 0, j_hi = (n == SEQ / 128 - 1) ? 3 : 5;
        __syncthreads();
        stage_kv(F.wsb(), (unsigned)WS_ZH, b * SEQ + (n - 1) * 128 + 64 * j_lo, 64 * (j_hi - j_lo + 1), KA + 64 * kvh, VA + 64 * kvh, L + j_lo * 8192, L + 49152 + j_lo * 8192, F.tid, w);
        __syncthreads();
#pragma unroll
        for (int j = 0; j < 3; ++j) { const int tq = 3 * w + j, qp0 = n * 128 + (tq & 7) * 16;
#pragma unroll 1
            for (int t = j_lo; t <= j_hi; ++t) { const int kb = (n - 1) * 128 + 64 * t;
                if (kb + 63 < qp0 - 128 || kb > qp0 + 15 + 128) continue;
                attn_tile64(T[j], L + t * 8192, L + 49152 + t * 8192, i, g, MaskBand{kb + 4 * g, qp0 + i}, 0, 3); } }
    }
#pragma unroll
    for (int j = 0; j < 3; ++j) { const int tq = 3 * w + j, hq = 3 * kvh + (tq >> 3);
        float ls = T[j].l; ls += __shfl_xor(ls, 16); ls += __shfl_xor(ls, 32);
        qs_finish(T[j], ls, F.Y(), F.SSQ(), qrow0 + (tq & 7) * 16 + i, 64 * hq, hq, g); }
}
constexpr int RPB_OFF = RING_BYTES + 4096;
__device__ __forceinline__ void attnC_item(Frame& F, int l, int b, int rp, int half, int h) {
    LAS unsigned char* L = (LAS unsigned char*)F.lds;
    const int lane = F.tid & 63, i = lane & 15, g = lane >> 4, w = F.wave, qt = w & 3, qr = w >> 2;
    const bool latent = rp >= 0;
    const int rr = 2 * rp + qr;
    const int qrow = (latent ? b * SEQ + rr * 64 : NLAT + b * CTXL + half * 128 + qr * 64) + qt * 16 + i;
    const bf16_t* Z = F.Z();
    QS T; qs_init(T, Z + (size_t)qrow * INW + QN + 64 * h, g, NEGF, 0.f);
    __syncthreads();
    stage_kv(F.wsb(), (unsigned)WS_ZH, NLAT + b * CTXL, CTXL, KN + 64 * h, VN + 64 * h, L, L + 32768, F.tid, w);
    if (latent) { LAS float* rl = (LAS float*)(L + RPB_OFF); const float* rg = F.inp(IN_RPB) + (size_t)(l * 6 + h) * 15 * 31;
        for (int x = F.tid; x < 15 * 31; x += NTHR) rl[x] = rg[x]; }
    __syncthreads();
#pragma unroll 1
    for (int t = 0; t < 4; ++t) attn_tile64(T, L + t * 8192, L + 32768 + t * 8192, i, g, MaskNone(), 0, 3);
    if (latent) {
        const int rs0 = min(max(2 * rp - 4, 0), SEQ / 64 - 8), rs1 = min(max(2 * rp + 1 - 4, 0), SEQ / 64 - 8);
        const int nrow = rs1 - rs0 + 8;
        __syncthreads();
        stage_kv(F.wsb(), (unsigned)WS_ZH, b * SEQ + rs0 * 64, nrow * 64, KN + 64 * h, VN + 64 * h, L, L + 73728, F.tid, w);
        __syncthreads();
        const int rs = qr ? rs1 : rs0;
        const int cq = qt * 16 + i, cs = min(max(cq - 8, 0), 48);
        const int kt_lo = qt < 2 ? 0 : qt - 1, kt_hi = qt == 0 ? 1 : (qt == 1 ? 2 : 3);
#pragma unroll 1
        for (int j = 0; j < 8; ++j) { const int lr = rs - rs0 + j;
            attn_tile64(T, L + lr * 8192, L + 73728 + lr * 8192, i, g, MaskNA{(const LAS float*)(L + RPB_OFF) + (rs + j - rr + 7) * 31, 4 * g, cq, cs}, kt_lo, kt_hi); }
    }
    float ls = T.l; ls += __shfl_xor(ls, 16); ls += __shfl_xor(ls, 32);
    qs_finish(T, ls, F.Y(), F.SSQ(), qrow, 640 + 64 * h, 10 + h, g);
}
__device__ __forceinline__ void sgu_item(Frame& F, int l, int ch, int g) {
    float* vg = (float*)F.lds;
    const int row0 = ch < 128 ? ch * 128 : NLAT + (ch - 128) * 128;
    const int p = F.tid >> 2, dq = F.tid & 3;
    __syncthreads();
    {
        const bf16_t* zp = F.Z() + (size_t)(row0 + p) * INW + VB + 64 * g + 16 * dq;
        const u32x4 w0 = *(const u32x4*)zp, w1 = *(const u32x4*)(zp + 8);
        float t[16] = {bf_lo(w0.x), bf_hi(w0.x), bf_lo(w0.y), bf_hi(w0.y), bf_lo(w0.z), bf_hi(w0.z), bf_lo(w0.w), bf_hi(w0.w),
                       bf_lo(w1.x), bf_hi(w1.x), bf_lo(w1.y), bf_hi(w1.y), bf_lo(w1.z), bf_hi(w1.z), bf_lo(w1.w), bf_hi(w1.w)};
        float ss = 0.f;
#pragma unroll
        for (int i = 0; i < 16; ++i) ss += t[i] * t[i];
        ss += __shfl_xor(ss, 1); ss += __shfl_xor(ss, 2);
        const float rstd = 1.0f / sqrtf(ss * (1.0f / 64.0f) + EPS);
        const float* ng = F.inp(IN_SGUG) + l * 256 + 64 * g + 16 * dq;
#pragma unroll
        for (int i = 0; i < 16; ++i) vg[p * 65 + 16 * dq + i] = t[i] * rstd * ng[i];
    }
    __syncthreads();
    float acc[16];
#pragma unroll
    for (int i = 0; i < 16; ++i) acc[i] = 0.f;
    const float* ws = F.inp(IN_SGUW) + ((size_t)(l * 4 + g) * 128 + p) * 128;
#pragma unroll 4
    for (int qq = 0; qq < 128; ++qq) { const float w = ws[qq];
#pragma unroll
        for (int i = 0; i < 16; ++i) acc[i] += w * vg[qq * 65 + 16 * dq + i]; }
    const float bs = F.inp(IN_SGUB)[(l * 4 + g) * 128 + p];
    const bf16_t* up = F.Z() + (size_t)(row0 + p) * INW + UB + 64 * g + 16 * dq;
    const u32x4 u0 = *(const u32x4*)up, u1 = *(const u32x4*)(up + 8);
    const float uu[16] = {bf_lo(u0.x), bf_hi(u0.x), bf_lo(u0.y), bf_hi(u0.y), bf_lo(u0.z), bf_hi(u0.z), bf_lo(u0.w), bf_hi(u0.w),
                          bf_lo(u1.x), bf_hi(u1.x), bf_lo(u1.y), bf_hi(u1.y), bf_lo(u1.z), bf_hi(u1.z), bf_lo(u1.w), bf_hi(u1.w)};
    float ss = 0.f;
#pragma unroll
    for (int i = 0; i < 16; ++i) { acc[i] = uu[i] * (acc[i] + bs); ss += acc[i] * acc[i]; }
    ss += __shfl_xor(ss, 1); ss += __shfl_xor(ss, 2);
    bf16_t* yp = F.Y() + (size_t)(row0 + p) * D + 384 + 64 * g + 16 * dq;
    u32x4 o0, o1; o0.x = pk2(acc[0], acc[1]); o0.y = pk2(acc[2], acc[3]); o0.z = pk2(acc[4], acc[5]); o0.w = pk2(acc[6], acc[7]);
    o1.x = pk2(acc[8], acc[9]); o1.y = pk2(acc[10], acc[11]); o1.z = pk2(acc[12], acc[13]); o1.w = pk2(acc[14], acc[15]);
    *(u32x4*)yp = o0; *(u32x4*)(yp + 8) = o1;
    if (dq == 0) F.SSQ()[(size_t)(row0 + p) * 16 + 6 + g] = ss;
}
__device__ __forceinline__ void sgu_item_mfma(Frame& F, int l, int ch, int g4) {
    LAS unsigned char* L = (LAS unsigned char*)F.lds;
    const int lane = F.tid & 63, i = lane & 15, g = lane >> 4, w = F.wave;
    const int row0 = ch < 128 ? ch * 128 : NLAT + (ch - 128) * 128;
    const bf16_t* Z = F.Z();
    __syncthreads();
    {
        const __amdgpu_buffer_rsrc_t rsrc = __builtin_amdgcn_make_buffer_rsrc((void*)F.wsb(), 0, 0x7fffffff, 0x00020000);
        const int pr = lane >> 4, pc = lane & 15;
#pragma unroll
        for (int it = 0; it < 4; ++it) { const int wi = it * NWAVES + w, p = 4 * wi + pr;
            const unsigned vo = (unsigned)p * 256u + (unsigned)((pc ^ (p & 15)) << 4);
            __builtin_amdgcn_raw_ptr_buffer_load_lds(rsrc, (LAS void*)(L + wi * 1024), 16, (int)vo, __builtin_amdgcn_readfirstlane((int)(WS_SGUW + (size_t)(l * 4 + g4) * 32768)), 0, 0); }
    }
    {
        const int q = F.tid >> 2, dq = F.tid & 3;
        const bf16_t* zp = Z + (size_t)(row0 + q) * INW + VB + 64 * g4 + 16 * dq;
        const u32x4 w0 = *(const u32x4*)zp, w1 = *(const u32x4*)(zp + 8);
        float t[16] = {bf_lo(w0.x), bf_hi(w0.x), bf_lo(w0.y), bf_hi(w0.y), bf_lo(w0.z), bf_hi(w0.z), bf_lo(w0.w), bf_hi(w0.w),
                       bf_lo(w1.x), bf_hi(w1.x), bf_lo(w1.y), bf_hi(w1.y), bf_lo(w1.z), bf_hi(w1.z), bf_lo(w1.w), bf_hi(w1.w)};
        float ss = 0.f;
#pragma unroll
        for (int x = 0; x < 16; ++x) ss += t[x] * t[x];
        ss += __shfl_xor(ss, 1); ss += __shfl_xor(ss, 2);
        const float rstd = 1.0f / sqrtf(ss * (1.0f / 64.0f) + EPS);
        const float* ng = F.inp(IN_SGUG) + l * 256 + 64 * g4 + 16 * dq;
#pragma unroll
        for (int x = 0; x < 16; ++x) t[x] = t[x] * rstd * ng[x];
        u32x4 o0, o1; o0.x = pk2(t[0], t[1]); o0.y = pk2(t[2], t[3]); o0.z = pk2(t[4], t[5]); o0.w = pk2(t[6], t[7]);
        o1.x = pk2(t[8], t[9]); o1.y = pk2(t[10], t[11]); o1.z = pk2(t[12], t[13]); o1.w = pk2(t[14], t[15]);
        LAS unsigned char* vr = L + 32768 + q * 128 + ((dq ^ ((q >> 1) & 3)) << 5);
        *(LAS u32x4*)vr = o0; *(LAS u32x4*)(vr + 16) = o1;
    }
    asm volatile("s_waitcnt vmcnt(0)" ::: "memory");
    __syncthreads();
    f32x4 o[4];
#pragma unroll
    for (int d = 0; d < 4; ++d) o[d] = (f32x4){0.f, 0.f, 0.f, 0.f};
    const int p = 16 * w + i;
    LAS unsigned char* wr = L + p * 256;
#pragma unroll
    for (int ks = 0; ks < 4; ++ks) {
        const int qa = 32 * ks + 4 * g;
        const u32x2 b0 = *(const LAS u32x2*)(wr + ((((qa >> 3)) ^ (p & 15)) << 4) + (((qa >> 2) & 1) << 3));
        const u32x2 b1 = *(const LAS u32x2*)(wr + (((((qa + 16) >> 3)) ^ (p & 15)) << 4) + ((((qa + 16) >> 2) & 1) << 3));
        u32x4 bw; bw.x = b0.x; bw.y = b0.y; bw.z = b1.x; bw.w = b1.y;
        const bf16x8 bf = __builtin_bit_cast(bf16x8, bw);
        const int key = 32 * ks + 4 * g + (i >> 2);
        LAS unsigned char* vr = L + 32768 + key * 128 + (i & 3) * 8;
        const int sw = (key >> 1) & 3;
#pragma unroll
        for (int dt = 0; dt < 4; ++dt) { LAS unsigned char* va = vr + ((dt ^ sw) << 5);
            const s16x4 lo = lds_tr(va), hi = lds_tr(va + 2048);
            const bf16x8 vf = {lo[0], lo[1], lo[2], lo[3], hi[0], hi[1], hi[2], hi[3]};
            o[dt] = __builtin_amdgcn_mfma_f32_16x16x32_bf16(vf, bf, o[dt], 0, 0, 0); }
    }
    const float bs = F.inp(IN_SGUB)[(l * 4 + g4) * 128 + p];
    const bf16_t* up = Z + (size_t)(row0 + p) * INW + UB + 64 * g4 + 4 * g;
    bf16_t* yp = F.Y() + (size_t)(row0 + p) * D + 384 + 64 * g4 + 4 * g;
    float ss = 0.f;
#pragma unroll
    for (int dt = 0; dt < 4; ++dt) { const u32x2 uw = *(const u32x2*)(up + 16 * dt);
        const f32x4 v = {bf_lo(uw.x) * (o[dt].x + bs), bf_hi(uw.x) * (o[dt].y + bs), bf_lo(uw.y) * (o[dt].z + bs), bf_hi(uw.y) * (o[dt].w + bs)};
        ss += (v.x * v.x + v.y * v.y) + (v.z * v.z + v.w * v.w);
        u32x2 ow; ow.x = pk2(v.x, v.y); ow.y = pk2(v.z, v.w); *(u32x2*)(yp + 16 * dt) = ow; }
    ss += __shfl_xor(ss, 16); ss += __shfl_xor(ss, 32);
    if (g == 0) F.SSQ()[(size_t)(row0 + p) * 16 + 6 + g4] = ss;
}
#ifndef MK_MIXREF
#define MK_MIXREF 0
#endif
__device__ __forceinline__ void phase_mix(Frame& F, int l) {
    const bool refA = (MK_MIXREF & 1) != 0, refC = (MK_MIXREF & 2) != 0;
    const int nC = refC ? 192 : NB * 6 * (SEQ / 128), nA = refA ? 192 : NB * (SEQ / 128) * 2, nS = 512;
    const int nAc = (l == 0) ? (refA ? 24 : NB * 2 * 2) : 0, nCc = (l == 0) ? (refC ? 24 : NB * 6 * 2) : 0, nSc = (l == 0) ? 64 : 0;
    const int total = nA + nC + nS + nAc + nCc + nSc;
    for (int it = F.bid; it < total; it += F.G) {
        int r = it;
        if (r < nC) { if (refC) attn_item(F, l, 1, r / 6, r % 6); else { const int h = r % 6, q = r / 6; attnC_item(F, l, q >> 4, q & 15, 0, h); } continue; } r -= nC;
        if (r < nA) { if (refA) attn_item(F, l, 0, r / 6, r % 6); else { const int kvh = r & 1, q = r >> 1; attnA_item(F, l, q >> 4, q & 15, 0, kvh); } continue; } r -= nA;
        if (r < nS) { if (MK_MIXREF & 4) sgu_item(F, l, r >> 2, r & 3); else sgu_item_mfma(F, l, r >> 2, r & 3); continue; } r -= nS;
        if (r < nAc) { if (refA) attn_item(F, l, 2, r / 6, r % 6); else { const int kvh = r & 1, hf = (r >> 1) & 1, b = r >> 2; attnA_item(F, l, b, -1, hf, kvh); } continue; } r -= nAc;
        if (r < nCc) { if (refC) attn_item(F, l, 3, r / 6, r % 6); else { const int h = r % 6, q = r / 6; attnC_item(F, l, q >> 1, -1, q & 1, h); } continue; } r -= nCc;
        if (MK_MIXREF & 4) sgu_item(F, l, 128 + (r >> 2), r & 3); else sgu_item_mfma(F, l, 128 + (r >> 2), r & 3);
    }
    __syncthreads();
}

__global__ void __launch_bounds__(NTHR, 2) mk_fwd(Params P) {
    extern __shared__ __attribute__((aligned(16))) unsigned char lds[];
    Frame F;
    F.lds = lds; F.tid = threadIdx.x; F.lane = F.tid & 63; F.wave = __builtin_amdgcn_readfirstlane(F.tid >> 6); F.bid = blockIdx.x; F.G = gridDim.x;
    F.P = &P;
    volatile LAS unsigned* MISC = (volatile LAS unsigned*)((LAS unsigned char*)lds + MISC_OFF);
    for (int u = F.tid; u < (LDS_BYTES - RING_BYTES) / 4; u += NTHR) ((LAS unsigned*)((LAS unsigned char*)lds + RING_BYTES))[u] = 0u;
    __syncthreads();
    XcdBarrier bar = xcd_barrier_post(F.ctl() + CW_BAR, MISC + 8);
#define LAUNDER() do { asm volatile("" : "+v"(F.tid)); asm volatile("" : "+v"(F.lane)); asm volatile("" : "+s"(F.bid)); asm volatile("" : "+s"(F.wave)); } while (0)

    constexpr int NPH = 2 + 10 * DEPTH;
#pragma unroll 1
    for (int ph = 0; ph < NPH; ++ph) {
        LAUNDER();
        const int l = ph < 2 ? 0 : (ph - 2) / 10;
        const int k = ph < 2 ? ph - 2 : (ph - 2) % 10;
        const int nrows = (l == 0) ? NTOK : NLAT;
#ifdef MK_REP_PH
        const int nrep = (ph == MK_REP_PH) ? MK_REP_N : 1;
#pragma unroll 1
        for (int rep = 0; rep < nrep; ++rep) {
        if (rep) { xcd_barrier(bar); LAUNDER(); }
#endif
        if (k == -2) p0_prologue(F);
        else if (k == -1) phase_r1(F, 0);
        else if (k == 0) {
            SchedDense S{F.H1(), F.WIN() + (size_t)l * INW * D, D, NTOK / 256, INW / 256, F.G, F.bid, F.wsb()};
            EpiG1 E{F.Z(), F.ROPE()};
            run_gemm<false>(F, (MK_MFMA & 1) != 0, S, E, D);
            if (l == 1) conv_experts(F, 1);
        } else if (k == 1) phase_mix(F, l);
        else if (k == 2) phase_nrm(F, l, nrows);
        else if (k == 3) {
            SchedDense S{F.Y(), F.WOUT() + (size_t)l * D * D, D, nrows / 256, D / 256, F.G, F.bid, F.wsb()};
            EpiG2 E{l == 0 ? F.inp(IN_X) : F.outp(), l == 0 ? F.inp(IN_CTX) : F.XC(), F.outp(), F.XC(), F.MOD(), l};
            run_gemm<false>(F, (MK_MFMA & 2) != 0, S, E, D);
        } else if (k == 4) phase_r2(F, l, nrows);
        else if (k == 5) {
            SchedRG S{F.H1(), F.HLO(), F.RWT() + (size_t)l * 128 * D, nrows / 256, F.G, F.bid, F.wsb()};
            EpiRG E{F.PL()};
            run_gemm<false>(F, true, S, E, D);
        } else if (k == 6) phase_topk(F, l, nrows);
        else if (k == 7) {
            moe_build_tab(F, l, nrows);
            const MoeTab T{(const int*)(F.lds + TOFF_OFF), (const int*)(F.lds + TOFF_OFF) + 72};
            SchedE1 S{T, F.LIST(), F.H1(), F.WEXPGU(), F.WSHGU() + (size_t)l * 512 * D, F.G, F.bid, F.wsb()};
            EpiE1 E{F.HB()};
            run_gemm<true>(F, (MK_MFMA & 4) != 0, S, E, D);
        } else if (k == 8) {
            moe_build_tab(F, l, nrows);
            const MoeTab T{(const int*)(F.lds + TOFF_OFF), (const int*)(F.lds + TOFF_OFF) + 72};
            SchedE2 S{T, F.HB(), F.WEXPD(), F.WSHD() + (size_t)l * D * FF, F.G, F.bid, F.wsb()};
            EpiE2 E{T, F.LIST(), F.LISTW(), F.Y2(), F.outp(), F.XC(), F.MOD(), l};
            run_gemm<false>(F, (MK_MFMA & 8) != 0, S, E, FF);
        } else phase_cmb(F, l, nrows);
#ifdef MK_REP_PH
        }
#endif
        if (ph != NPH - 1) xcd_barrier(bar);
    }
}

extern "C" void kernel_launch(void* const* d_in, const int* in_sizes, int n_in, void* d_out, int out_size, void* d_ws, size_t ws_size, hipStream_t stream) {
    static int grid = 0;
    if (grid == 0) {
        if (n_in != N_IN || in_sizes[0] != NLAT * D || out_size != NLAT * D || ws_size < WS_END) {
            fprintf(stderr, "kernel_launch: unexpected shapes / workspace (n_in %d, in0 %d, out %d, ws %zu need %zu); nothing launched\n", n_in, n_in > 0 ? in_sizes[0] : -1, out_size, ws_size, (size_t)WS_END);
            grid = -1; return; }
        int dev = 0, cus = 0, per_cu = 0;
        if (hipGetDevice(&dev) != hipSuccess || hipDeviceGetAttribute(&cus, hipDeviceAttributeMultiprocessorCount, dev) != hipSuccess) { grid = -1; return; }
        if (hipFuncSetAttribute((const void*)mk_fwd, hipFuncAttributeMaxDynamicSharedMemorySize, LDS_BYTES) != hipSuccess) { fprintf(stderr, "kernel_launch: hipFuncSetAttribute failed\n"); grid = -1; return; }
        if (hipOccupancyMaxActiveBlocksPerMultiprocessor(&per_cu, (const void*)mk_fwd, NTHR, LDS_BYTES) != hipSuccess || per_cu < 1) { fprintf(stderr, "kernel_launch: occupancy query says %d blocks/CU; nothing launched\n", per_cu); grid = -1; return; }
        (void)hipGetLastError();
        grid = cus;
    }
    if (grid < 0) return;
    if (hipMemsetAsync((char*)d_ws + WS_CTL, 0, CTL_ZERO_BYTES, stream) != hipSuccess) return;
    Params p{};
    for (int i = 0; i < N_IN; ++i) p.in[i] = (const float*)d_in[i];
    p.out = (float*)d_out; p.ws = (unsigned char*)d_ws;
    hipLaunchKernelGGL(mk_fwd, dim3(grid), dim3(NTHR), LDS_BYTES, stream, p);
}
```
